# Optimizing an MI355X kernel written in HIP

```python
import math
import jax, jax.numpy as jnp
from jax import lax
import numpy as np


D_MODEL = 1024
BATCH = 8
SEQ = 2048
DEPTH = 2

GRID_W = 64
CTX_LEN = 256
N_MOD = 6
EPS = 1e-6
CONV_WIDTH = 4
BRANCH_WIDTH = 512
N_BRANCHES = 3
GDN_HEADS = 4
GDN_HEAD_DIM = 128
GDN_CHUNK = 64
DIFF_HEADS = 4
DIFF_HEAD_DIM = 64
DIFF_V_DIM = 2 * DIFF_HEAD_DIM
Q_BLOCK = 128
ROPE_BASE = 10000.0
ROPE_PAIRS = DIFF_HEAD_DIM // 4
LRU_BLOCKS = 8
LRU_BLOCK_DIM = BRANCH_WIDTH // LRU_BLOCKS
LRU_C = 8.0
N_EXPERTS = 16
N_GROUPS = 4
TOP_K = 2
EXPERT_FF = 512
PROJ_SIZES = (3 * BRANCH_WIDTH,
              BRANCH_WIDTH,
              2 * GDN_HEADS,
              2 * GDN_HEADS,
              BRANCH_WIDTH,
              BRANCH_WIDTH,
              BRANCH_WIDTH,
              BRANCH_WIDTH,
              BRANCH_WIDTH,
              N_BRANCHES * D_MODEL)
PROJ_WIDTH = sum(PROJ_SIZES)

kernel_name = 'hybrid_gdn_diffattn_rglru_grouped_moe_dit'


def rms_norm(x, gain):
    xf = x.astype(jnp.float32)
    y = xf * lax.rsqrt(jnp.mean(xf * xf, axis=-1, keepdims=True) + EPS)
    return (y * gain.astype(jnp.float32)).astype(x.dtype)


def l2_norm(x):
    return x * lax.rsqrt(jnp.sum(x * x, axis=-1, keepdims=True) + EPS)


def modulate(h, shift, scale):
    return h * (1.0 + scale) + shift


def split_proj(p):
    return jnp.split(p, np.cumsum(PROJ_SIZES)[:-1].tolist(), axis=-1)


def centred_dwconv(x, w, bias=None):
    t = x.shape[1]
    left = CONV_WIDTH // 2
    xp = jnp.pad(x, ((0, 0), (left, CONV_WIDTH - 1 - left), (0, 0)))
    y = sum(xp[:, j:j + t] * w[j] for j in range(CONV_WIDTH))
    return y if bias is None else y + bias


def rope_2d(x, row_ang, col_ang):
    half = x.shape[-1] // 2

    def rot(xs, ang):
        cos = jnp.cos(ang).astype(x.dtype)[:, None, None, :]
        sin = jnp.sin(ang).astype(x.dtype)[:, None, None, :]
        x1, x2 = jnp.split(xs, 2, axis=-1)
        return jnp.concatenate([x1 * cos - x2 * sin, x2 * cos + x1 * sin], axis=-1)

    return jnp.concatenate([rot(x[..., :half], row_ang), rot(x[..., half:], col_ang)], axis=-1)


def gated_delta_chunked(q, k, v, g, beta, s0):
    b, h, t, _ = q.shape
    n = t // GDN_CHUNK
    rs = lambda a: a.reshape(b, h, n, GDN_CHUNK, *a.shape[3:])
    q, k, v, g, beta = rs(q), rs(k), rs(v), rs(g), rs(beta)
    g = jnp.cumsum(g, axis=-1)
    idx = jnp.arange(GDN_CHUNK)
    lower = idx[:, None] >= idx[None, :]
    strict = idx[:, None] > idx[None, :]
    decay = jnp.exp(jnp.where(lower, g[..., :, None] - g[..., None, :], -jnp.inf))
    k_beta = k * beta[..., None]
    a_mat = jnp.where(strict, jnp.einsum('bhnid,bhnjd->bhnij', k_beta, k) * decay, 0.0)
    eye = jnp.eye(GDN_CHUNK, dtype=q.dtype)
    t_mat = lax.linalg.triangular_solve(eye + a_mat, jnp.broadcast_to(eye, a_mat.shape),
                                        left_side=True, lower=True, unit_diagonal=True)
    u = jnp.einsum('bhnij,bhnje->bhnie', t_mat, v * beta[..., None])
    w = jnp.einsum('bhnij,bhnjd->bhnid', t_mat, k_beta * jnp.exp(g)[..., None])
    qk = jnp.einsum('bhnid,bhnjd->bhnij', q, k) * decay
    q_dec = q * jnp.exp(g)[..., None]
    k_dec = k * jnp.exp(g[..., -1:] - g)[..., None]
    g_last = jnp.exp(g[..., -1])

    def step(s, inp):
        u_i, w_i, qk_i, q_i, k_i, gl_i = inp
        v_new = u_i - jnp.einsum('bhid,bhde->bhie', w_i, s)
        o = jnp.einsum('bhid,bhde->bhie', q_i, s) + jnp.einsum('bhij,bhje->bhie', qk_i, v_new)
        s = s * gl_i[..., None, None] + jnp.einsum('bhid,bhie->bhde', k_i, v_new)
        return s, o

    mv = lambda a: jnp.moveaxis(a, 2, 0)
    s_fin, o = lax.scan(step, s0, (mv(u), mv(w), mv(qk), mv(q_dec), mv(k_dec), mv(g_last)))
    return jnp.moveaxis(o, 0, 2).reshape(b, h, t, -1), s_fin


def gdn_inputs(qkv, beta_raw, alpha_raw, conv_w, a_log, dt_bias):
    b, t, _ = qkv.shape
    qkv = jax.nn.silu(centred_dwconv(qkv.astype(jnp.float32), conv_w.astype(jnp.float32)))
    q, k, v = qkv.reshape(b, t, 3, GDN_HEADS, GDN_HEAD_DIM).transpose(2, 0, 3, 1, 4)
    q = l2_norm(q) * GDN_HEAD_DIM ** -0.5
    k = l2_norm(k)
    beta = jax.nn.sigmoid(beta_raw.astype(jnp.float32)).reshape(b, t, 2, GDN_HEADS).transpose(2, 0, 3, 1)
    alpha = alpha_raw.astype(jnp.float32).reshape(b, t, 2, GDN_HEADS).transpose(2, 0, 3, 1)
    g = -jnp.exp(a_log.astype(jnp.float32))[:, None, :, None] * jax.nn.softplus(
        alpha + dt_bias.astype(jnp.float32)[:, None, :, None])
    return q, k, v, beta, g


def gdn_branch(qkv_l, z_l, beta_l, alpha_l, qkv_c, z_c, beta_c, alpha_c,
               conv_w, a_log, dt_bias, out_gain, need_ctx_out):
    ql, kl, vl, bl, gl = gdn_inputs(qkv_l, beta_l, alpha_l, conv_w, a_log, dt_bias)
    qc, kc, vc, bc, gc = gdn_inputs(qkv_c, beta_c, alpha_c, conv_w, a_log, dt_bias)
    s0 = jnp.zeros(qc.shape[:2] + (GDN_HEAD_DIM, GDN_HEAD_DIM), jnp.float32)
    rev = lambda a: jnp.flip(a, axis=2)
    oc_f, sc_f = gated_delta_chunked(qc, kc, vc, gc[0], bc[0], s0)
    ol_f, _ = gated_delta_chunked(ql, kl, vl, gl[0], bl[0], sc_f)
    oc_b, sc_b = gated_delta_chunked(rev(qc), rev(kc), rev(vc), rev(gc[1]), rev(bc[1]), s0)
    ol_b, _ = gated_delta_chunked(rev(ql), rev(kl), rev(vl), rev(gl[1]), rev(bl[1]), sc_b)

    def post(o, z):
        o = o.transpose(0, 2, 1, 3)
        zz = z.astype(jnp.float32).reshape(o.shape)
        y = rms_norm(o, out_gain) * jax.nn.silu(zz)
        return y.reshape(o.shape[0], o.shape[1], BRANCH_WIDTH).astype(z.dtype)

    out_l = post(ol_f + rev(ol_b), z_l)
    out_c = post(oc_f + rev(oc_b), z_c) if need_ctx_out else None
    return out_l, out_c


def diff_softmax_attend(q, k, v, lam):
    s = jnp.einsum('bqhcd,bkhcd->bhcqk', q, k).astype(jnp.float32) * DIFF_HEAD_DIM ** -0.5
    p = jax.nn.softmax(s, axis=-1)
    p = p[:, :, 0] - lam * p[:, :, 1]
    return jnp.einsum('bhqk,bkhe->bqhe', p.astype(v.dtype), v)


def diff_branch(q_l, k_l, v_l, q_c, k_c, v_c, q_gain, k_gain, lam_vecs, out_gain, lam_init,
                row_ang, col_ang, need_ctx_out):
    b, s = q_l.shape[:2]
    heads = lambda p: p.reshape(p.shape[0], p.shape[1], DIFF_HEADS, 2, DIFF_HEAD_DIM)
    vals = lambda p: p.reshape(p.shape[0], p.shape[1], DIFF_HEADS, DIFF_V_DIM)
    ql = rope_2d(rms_norm(heads(q_l), q_gain), row_ang, col_ang)
    kl = rope_2d(rms_norm(heads(k_l), k_gain), row_ang, col_ang)
    kc = rms_norm(heads(k_c), k_gain)
    vc = vals(v_c)
    k_all = jnp.concatenate([kl, kc], axis=1)
    v_all = jnp.concatenate([vals(v_l), vc], axis=1)
    lv = lam_vecs.astype(jnp.float32)
    lam = jnp.exp(jnp.sum(lv[0] * lv[1])) - jnp.exp(jnp.sum(lv[2] * lv[3])) + lam_init
    n_blk = s // Q_BLOCK
    q_blocks = jnp.moveaxis(ql.reshape(b, n_blk, Q_BLOCK, DIFF_HEADS, 2, DIFF_HEAD_DIM), 1, 0)
    ol = lax.map(lambda qb: diff_softmax_attend(qb, k_all, v_all, lam), q_blocks)
    ol = jnp.moveaxis(ol, 0, 1).reshape(b, s, DIFF_HEADS, DIFF_V_DIM)

    def post(o):
        return (rms_norm(o, out_gain) * (1.0 - lam_init)).reshape(o.shape[0], o.shape[1], BRANCH_WIDTH)

    out_l = post(ol)
    out_c = post(diff_softmax_attend(rms_norm(heads(q_c), q_gain), kc, vc, lam)) if need_ctx_out else None
    return out_l, out_c


def lru_gates(xc, w_gate, b_gate, lam):
    b, t, _ = xc.shape
    pre = jnp.einsum('btnj,dgnjk->dgbtnk', xc.reshape(b, t, LRU_BLOCKS, LRU_BLOCK_DIM), w_gate)
    pre = pre.reshape(2, 2, b, t, BRANCH_WIDTH) + b_gate[:, :, None, None, :]
    r = jax.nn.sigmoid(pre[:, 0])
    i = jax.nn.sigmoid(pre[:, 1])
    log_a = -LRU_C * r * jax.nn.softplus(-lam)[:, None, None, :]
    return jnp.exp(log_a), jnp.sqrt(-jnp.expm1(2.0 * log_a)) * i * xc[None]


def linear_scan(a, b, h0):
    a_cum, b_cum = lax.associative_scan(lambda l, r: (l[0] * r[0], r[0] * l[1] + r[1]), (a, b), axis=1)
    h = a_cum * h0[:, None, :] + b_cum
    return h, h[:, -1]


def lru_branch(x_l, y_l, x_c, y_c, conv_w, conv_b, w_gate, b_gate, lam, need_ctx_out):
    f32 = jnp.float32
    cw, cb, wg, bg, lm = conv_w.astype(f32), conv_b.astype(f32), w_gate.astype(f32), b_gate.astype(f32), lam.astype(f32)
    xl = centred_dwconv(x_l.astype(f32), cw, cb)
    xc = centred_dwconv(x_c.astype(f32), cw, cb)
    al, bl = lru_gates(xl, wg, bg, lm)
    ac, bc = lru_gates(xc, wg, bg, lm)
    h0 = jnp.zeros((xc.shape[0], BRANCH_WIDTH), f32)
    rev = lambda a: jnp.flip(a, axis=1)
    hc_f, sc_f = linear_scan(ac[0], bc[0], h0)
    hl_f, _ = linear_scan(al[0], bl[0], sc_f)
    hc_b, sc_b = linear_scan(rev(ac[1]), rev(bc[1]), h0)
    hl_b, _ = linear_scan(rev(al[1]), rev(bl[1]), sc_b)
    out_l = ((hl_f + rev(hl_b)) * jax.nn.gelu(y_l.astype(f32))).astype(x_l.dtype)
    out_c = ((hc_f + rev(hc_b)) * jax.nn.gelu(y_c.astype(f32))).astype(x_c.dtype) if need_ctx_out else None
    return out_l, out_c


def merge_branches(ya, yb, yc, gates_raw, w_branch, w_out):
    y = jnp.einsum('btne,ned->btnd', jnp.stack([ya, yb, yc], axis=2), w_branch)
    g = jax.nn.sigmoid(gates_raw.reshape(y.shape))
    return jnp.sum(g * y, axis=2) @ w_out


def token_mixer(hl, hc, lam_init, row_ang, col_ang, need_ctx_out, w_in, gdn_conv_w, gdn_a_log, gdn_dt_bias,
                gdn_out_gain, diff_q_gain, diff_k_gain, diff_lambda, diff_out_gain, lru_conv_w, lru_conv_b,
                lru_w_gate, lru_b_gate, lru_lambda, w_branch, w_out):
    (a_qkv_l, a_z_l, a_b_l, a_a_l, b_q_l, b_k_l, b_v_l, c_x_l, c_y_l, gate_l) = split_proj(hl @ w_in)
    (a_qkv_c, a_z_c, a_b_c, a_a_c, b_q_c, b_k_c, b_v_c, c_x_c, c_y_c, gate_c) = split_proj(hc @ w_in)
    ya_l, ya_c = gdn_branch(a_qkv_l, a_z_l, a_b_l, a_a_l, a_qkv_c, a_z_c, a_b_c, a_a_c,
                            gdn_conv_w, gdn_a_log, gdn_dt_bias, gdn_out_gain, need_ctx_out)
    yb_l, yb_c = diff_branch(b_q_l, b_k_l, b_v_l, b_q_c, b_k_c, b_v_c, diff_q_gain, diff_k_gain,
                             diff_lambda, diff_out_gain, lam_init, row_ang, col_ang, need_ctx_out)
    yc_l, yc_c = lru_branch(c_x_l, c_y_l, c_x_c, c_y_c, lru_conv_w, lru_conv_b, lru_w_gate, lru_b_gate,
                            lru_lambda, need_ctx_out)
    out_l = merge_branches(ya_l, yb_l, yc_l, gate_l, w_branch, w_out)
    out_c = merge_branches(ya_c, yb_c, yc_c, gate_c, w_branch, w_out) if need_ctx_out else None
    return out_l, out_c


def moe_ffn(h, w_router, b_router, w_gate_up, w_down):
    probs = jax.nn.softmax((h @ w_router).astype(jnp.float32) + b_router.astype(jnp.float32), axis=-1)
    grouped = probs.reshape(*probs.shape[:-1], N_GROUPS, N_EXPERTS // N_GROUPS)
    group_score = jnp.sum(lax.top_k(grouped, TOP_K)[0], axis=-1)
    best = jnp.argmax(group_score, axis=-1)
    in_group = (best[..., None] == jnp.arange(N_GROUPS))[..., None]
    masked = jnp.where(in_group, grouped, -1.0).reshape(probs.shape)
    top_w, top_i = lax.top_k(masked, TOP_K)
    top_w = top_w / jnp.sum(top_w, axis=-1, keepdims=True)
    combine = jnp.einsum('btk,btke->bte', top_w, jax.nn.one_hot(top_i, N_EXPERTS, dtype=jnp.float32))
    out = jnp.zeros_like(h)
    for e in range(N_EXPERTS):
        gate, up = jnp.split(h @ w_gate_up[e], 2, axis=-1)
        out = out + combine[..., e:e + 1].astype(h.dtype) * ((jax.nn.silu(gate) * up) @ w_down[e])
    return out


def setup_inputs(seed: int = 0) -> dict:
    key = jax.random.key(seed)
    keys = jax.random.split(key, 32)
    f32 = jnp.float32
    L, D, W = DEPTH, D_MODEL, BRANCH_WIDTH

    def nrm(i, shape, scale):
        return jax.random.normal(keys[i], shape, f32) * scale

    def gain(i, shape):
        return 1.0 + nrm(i, shape, 0.02)

    dt = jnp.exp(jax.random.uniform(keys[11], (L, 2, GDN_HEADS), f32, math.log(1e-3), math.log(1e-1)))
    a_pow = jax.random.uniform(keys[21], (L, 2, W), f32, 0.9, 0.999)
    a_base = jnp.exp(jnp.log(a_pow) / LRU_C)
    return {
        'x': nrm(0, (BATCH, SEQ, D), 1.0),
        'c': nrm(1, (BATCH, D), 1.0),
        'ctx': nrm(2, (BATCH, CTX_LEN, D), 1.0),
        'c_ctx': nrm(3, (D,), 1.0),
        'w_mod': nrm(4, (L, D, N_MOD * D), D ** -0.5),
        'b_mod': nrm(5, (L, N_MOD * D), 0.01),
        'norm1_gain': gain(6, (L, D)),
        'norm2_gain': gain(7, (L, D)),
        'w_in': nrm(8, (L, D, PROJ_WIDTH), D ** -0.5),
        'gdn_conv_w': nrm(9, (L, CONV_WIDTH, 3 * W), CONV_WIDTH ** -0.5),
        'gdn_a_log': jnp.log(jax.random.uniform(keys[10], (L, 2, GDN_HEADS), f32, 1.0, 16.0)),
        'gdn_dt_bias': dt + jnp.log(-jnp.expm1(-dt)),
        'gdn_out_gain': gain(12, (L, GDN_HEAD_DIM)),
        'diff_q_gain': gain(13, (L, DIFF_HEAD_DIM)),
        'diff_k_gain': gain(14, (L, DIFF_HEAD_DIM)),
        'diff_lambda': nrm(15, (L, 4, DIFF_HEAD_DIM), 0.1),
        'diff_out_gain': gain(16, (L, DIFF_V_DIM)),
        'lru_conv_w': nrm(17, (L, CONV_WIDTH, W), CONV_WIDTH ** -0.5),
        'lru_conv_b': nrm(18, (L, W), 0.01),
        'lru_w_gate': nrm(19, (L, 2, 2, LRU_BLOCKS, LRU_BLOCK_DIM, LRU_BLOCK_DIM), LRU_BLOCK_DIM ** -0.5),
        'lru_b_gate': nrm(20, (L, 2, 2, W), 0.01),
        'lru_lambda': jnp.log(a_base) - jnp.log1p(-a_base),
        'w_branch': nrm(22, (L, N_BRANCHES, W, D), W ** -0.5),
        'w_out': nrm(23, (L, D, D), D ** -0.5),
        'w_router': nrm(24, (D, N_EXPERTS), D ** -0.5),
        'b_router': nrm(25, (N_EXPERTS,), 0.01),
        'w_gate_up': nrm(26, (L, N_EXPERTS, D, 2 * EXPERT_FF), D ** -0.5),
        'w_down': nrm(27, (L, N_EXPERTS, EXPERT_FF, D), EXPERT_FF ** -0.5),
    }


def reference(x, c, ctx, c_ctx, w_mod, b_mod, norm1_gain, norm2_gain, w_in, gdn_conv_w, gdn_a_log,
              gdn_dt_bias, gdn_out_gain, diff_q_gain, diff_k_gain, diff_lambda, diff_out_gain, lru_conv_w,
              lru_conv_b, lru_w_gate, lru_b_gate, lru_lambda, w_branch, w_out, w_router, b_router,
              w_gate_up, w_down):
    b, s, d = x.shape
    n_rows = s // GRID_W
    row_id = jnp.broadcast_to(jnp.arange(n_rows, dtype=jnp.float32)[:, None], (n_rows, GRID_W)).reshape(-1)
    col_id = jnp.broadcast_to(jnp.arange(GRID_W, dtype=jnp.float32)[None, :], (n_rows, GRID_W)).reshape(-1)
    inv_freq = jnp.power(ROPE_BASE, -jnp.arange(ROPE_PAIRS, dtype=jnp.float32) / ROPE_PAIRS)
    row_ang = row_id[:, None] * inv_freq
    col_ang = col_id[:, None] * inv_freq

    for layer in range(DEPTH):
        last = layer == DEPTH - 1
        lam_init = 0.8 - 0.6 * math.exp(-0.3 * layer)
        m_l = (jax.nn.silu(c) @ w_mod[layer] + b_mod[layer]).reshape(b, N_MOD, 1, d)
        m_c = (jax.nn.silu(c_ctx) @ w_mod[layer] + b_mod[layer]).reshape(N_MOD, d)
        hl = modulate(rms_norm(x, norm1_gain[layer]), m_l[:, 0], m_l[:, 1])
        hc = modulate(rms_norm(ctx, norm1_gain[layer]), m_c[0], m_c[1])
        out_l, out_c = token_mixer(
            hl, hc, lam_init, row_ang, col_ang, not last, w_in[layer], gdn_conv_w[layer], gdn_a_log[layer],
            gdn_dt_bias[layer], gdn_out_gain[layer], diff_q_gain[layer], diff_k_gain[layer], diff_lambda[layer],
            diff_out_gain[layer], lru_conv_w[layer], lru_conv_b[layer], lru_w_gate[layer], lru_b_gate[layer],
            lru_lambda[layer], w_branch[layer], w_out[layer])
        x = x + m_l[:, 2] * out_l
        h2l = modulate(rms_norm(x, norm2_gain[layer]), m_l[:, 3], m_l[:, 4])
        if last:
            x = x + m_l[:, 5] * moe_ffn(h2l, w_router, b_router, w_gate_up[layer], w_down[layer])
        else:
            ctx = ctx + m_c[2] * out_c
            h2c = modulate(rms_norm(ctx, norm2_gain[layer]), m_c[3], m_c[4])
            f = moe_ffn(jnp.concatenate([h2l, h2c], axis=1), w_router, b_router, w_gate_up[layer], w_down[layer])
            x = x + m_l[:, 5] * f[:, :s]
            ctx = ctx + m_c[5] * f[:, s:]
    return x
```

```cpp
#define MK_PER_PHASE 1
#include <hip/hip_runtime.h>
#include <hip/hip_cooperative_groups.h>
#include <cstdio>
namespace cg = cooperative_groups;

#define DI __device__ __forceinline__
#define LAS __attribute__((address_space(3)))
typedef unsigned short bf16_t;
typedef short bf16x8 __attribute__((ext_vector_type(8)));
typedef short s16x4 __attribute__((ext_vector_type(4)));
typedef float f32x4 __attribute__((ext_vector_type(4)));
typedef float f32x16 __attribute__((ext_vector_type(16)));
typedef unsigned u32x4 __attribute__((ext_vector_type(4)));
typedef unsigned u32x2 __attribute__((ext_vector_type(2)));

constexpr int NB = 8, SEQ = 2048, CTX = 256, TT = 2304, DM = 1024, MROWS = NB * TT, NLAYER = 2;
constexpr int PW = 7696;
constexpr int NT = 512;
constexpr float EPS = 1e-6f;
constexpr size_t SLOT_ELEMS = (size_t)MROWS * 512;
constexpr int MPAD = 40960;
constexpr int NLC = 72;

constexpr size_t W_IN = 0, W_BR = W_IN + (size_t)7680 * 1024, W_OUT = W_BR + (size_t)3 * 1024 * 512, W_GU = W_OUT + (size_t)1024 * 1024,
                 W_DN = W_GU + (size_t)16 * 1024 * 1024, W_LAYER = W_DN + (size_t)16 * 1024 * 512;

constexpr size_t WS_CTL = 0;
constexpr size_t WS_MOD = 65536;
constexpr size_t ZERO_BYTES = WS_MOD + (size_t)2 * 9 * 6144 * 4;
constexpr size_t WS_WSM = 524288;
constexpr size_t WS_WRT = WS_WSM + (size_t)2 * 16 * 1024 * 4;
constexpr size_t WS_BA = WS_WRT + (size_t)16 * 1024 * 4;
constexpr size_t WS_LRS = WS_BA + (size_t)MROWS * 16 * 4;
constexpr size_t WS_ROUTE = WS_LRS + (size_t)NB * 2 * NLC * 512 * 2 * 4;
constexpr size_t WS_WB = WS_ROUTE + (size_t)MROWS * 8 * 4;
constexpr size_t WS_XS = WS_WB + (size_t)2 * W_LAYER * 2;
constexpr size_t WS_H = WS_XS + (size_t)MROWS * 1024 * 4;
constexpr size_t WS_SLOT = WS_H + (size_t)MROWS * 1024 * 2;
constexpr size_t WS_END = WS_SLOT + (size_t)14 * SLOT_ELEMS * 2;

struct Params {
    const float* in[28];
    float* out;
    unsigned char* ws;
    int ph_lo, ph_hi;
};

struct Frame {
    const LAS unsigned long long* itab;
    float* out;
    unsigned char* ws;
    int tid, lane, wave, G, bid;
    DI const float* inp(int i) const { const unsigned long long v = itab[i];
        const unsigned lo = __builtin_amdgcn_readfirstlane((unsigned)v), hi = __builtin_amdgcn_readfirstlane((unsigned)(v >> 32));
        return (const float*)(((unsigned long long)hi << 32) | lo); }
    DI bf16_t* slot(int s) const { return (bf16_t*)(ws + WS_SLOT) + (size_t)s * SLOT_ELEMS; }
    DI bf16_t* wb(int L) const { return (bf16_t*)(ws + WS_WB) + (size_t)L * W_LAYER; }
    DI float* mod(int L, int mi) const { return (float*)(ws + WS_MOD) + (size_t)(L * 9 + mi) * 6144; }
    DI float* xs() const { return (float*)(ws + WS_XS); }
    DI bf16_t* h() const { return (bf16_t*)(ws + WS_H); }
    DI unsigned* ctl() const { return (unsigned*)(ws + WS_CTL); }
    DI unsigned* route() const { return (unsigned*)(ws + WS_ROUTE); }
};

DI float bf2f(bf16_t b) { return __uint_as_float(((unsigned)b) << 16); }
DI bf16_t f2bf(float f) { return __builtin_bit_cast(unsigned short, (__bf16)f); }
DI unsigned pack2(float a, float b) { typedef __bf16 v2 __attribute__((ext_vector_type(2))); v2 v; v[0] = (__bf16)a; v[1] = (__bf16)b; return __builtin_bit_cast(unsigned, v); }
DI float sigmoid_f(float x) { return 1.f / (1.f + __expf(-x)); }
DI float silu_f(float x) { return x / (1.f + __expf(-x)); }
DI float softplus_f(float x) { return fmaxf(x, 0.f) + log1pf(__expf(-fabsf(x))); }
DI float gelu_tanh_f(float x) { const float u = 0.7978845608028654f * (x + 0.044715f * x * x * x); return 0.5f * x * (1.f + tanhf(u)); }
DI float wave_sum(float v) {
#pragma unroll
    for (int o = 32; o >= 1; o >>= 1) v += __shfl_xor(v, o);
    return v;
}
DI int modidx(int r) { const int b = r / TT, t = r - b * TT; return t < CTX ? 8 : b; }
namespace pg8 {
constexpr int BM = 256, BK = 64, HALF = 128, HTB = HALF * BK * 2  , STAGE_BYTES = 8 * HTB, NXCD = 8, WGM = 8;

__host__ __device__ __forceinline__ int lds_byte(int r, int c) { const int st = (r >> 4) * 2 + (c >> 5), rr = r & 15, cc = c & 31, ob = rr * 64 + cc * 2; return st * 1024 + (ob ^ (((ob >> 9) & 1) << 5)); }
__host__ __device__ __forceinline__ void stage_rc(int b, int& R, int& C) { const int st = b / 1024, sb = b % 1024, swz = sb ^ (((sb >> 9) & 1) << 5); R = (st >> 1) * 16 + swz / 64; C = (st & 1) * 32 + (swz % 64) / 2; }
__host__ __device__ __forceinline__ int perm32(int rho) { const int n = rho >> 4, i = rho & 15; return 8 * (i >> 2) + 4 * n + (i & 3); }

struct Unit { int pm, pn; };
struct Gemm { const bf16_t* A; const bf16_t* Bt; int K; };

DI bool grid_unit(int nM, int nN, long L, Unit& u) {
    const int nwg = nM * nN; if (L >= nwg) return false;
    int wgid = (int)L; { const int q = nwg / NXCD, r = nwg % NXCD, xcd = wgid % NXCD, off = wgid / NXCD; wgid = (xcd < r ? xcd * (q + 1) : r * (q + 1) + (xcd - r) * q) + off; }
    const int nig = WGM * nN, gid = wgid / nig, fm = gid * WGM, gsz = (nM - fm) < WGM ? (nM - fm) : WGM;
    u.pm = fm + ((wgid % nig) % gsz); u.pn = (wgid % nig) / gsz; return true;
}
struct StaticOrder {
    int nM, nN, G, c;
    DI bool next(int i, Unit& u) const { return grid_unit(nM, nN, (long)i * G + c, u); }
};
struct MergeOrder {
    int G, c;
    DI bool next(int i, Unit& u) const {
        const int n = i % 3; Unit t; if (!grid_unit(72, 4, (long)(i / 3) * G + c, t)) return false;
        u.pm = n * 72 + t.pm; u.pn = n * 4 + t.pn; return true;
    }
};
struct MoeOrder {
    const LAS int* tb; int G, c;
    DI bool next(int i, Unit& u) const {
        const long L = (long)i * G + c; const int total = __builtin_amdgcn_readfirstlane(tb[16]) * 4; if (L >= total) return false;
        const int pm = (int)(L >> 2), j = (int)(L & 3); int e = 0;
#pragma unroll
        for (int q = 1; q < 16; ++q) e += (pm >= __builtin_amdgcn_readfirstlane(tb[q])) ? 1 : 0;
        u.pm = pm; u.pn = e * 4 + j; return true;
    }
};

typedef const f32x4 (&AccRef)[2][2][4][2];

struct EpiSlots {
    static constexpr bool PERM = true;
    bf16_t* base; int smap[9];
    DI void operator()(AccRef acc, const Unit& u, int wr, int wc, int fr, int fq) const {
        int sl = 0;
#pragma unroll
        for (int q = 0; q < 9; ++q) sl = ((u.pn >> 1) == q) ? smap[q] : sl;
        bf16_t* O = base + (size_t)sl * SLOT_ELEMS;
        const int row0 = u.pm * BM + wr * 64 + fr, col0 = (u.pn & 1) * 256 + wc * 32 + 8 * fq;
#pragma unroll
        for (int ai = 0; ai < 2; ++ai)
#pragma unroll
            for (int m = 0; m < 4; ++m) { bf16_t* rowp = O + (size_t)(row0 + ai * HALF + m * 16) * 512 + col0;
#pragma unroll
                for (int bj = 0; bj < 2; ++bj) { const f32x4 v0 = acc[ai][bj][m][0], v1 = acc[ai][bj][m][1];
                    u32x4 w; w.x = pack2(v0[0], v0[1]); w.y = pack2(v0[2], v0[3]); w.z = pack2(v1[0], v1[1]); w.w = pack2(v1[2], v1[3]);
                    *(u32x4*)(rowp + bj * HALF) = w; } }
    }
};
struct EpiMerge {
    static constexpr bool PERM = true;
    bf16_t* merged; const bf16_t* slots;
    DI void operator()(AccRef acc, const Unit& u, int wr, int wc, int fr, int fq) const {
        const int n = u.pm / 72, pm = u.pm - n * 72, pn = u.pn & 3;
        const int row0 = pm * BM + wr * 64 + fr, col0 = pn * 256 + wc * 32 + 8 * fq;
        const int j = 2 * n + (col0 >> 9);
        const int gs = j < 3 ? j : j + 6;
        const bf16_t* G = slots + (size_t)gs * SLOT_ELEMS;
        const int gcol0 = col0 & 511;
#pragma unroll
        for (int ai = 0; ai < 2; ++ai)
#pragma unroll
            for (int m = 0; m < 4; ++m) { const size_t row = (size_t)(row0 + ai * HALF + m * 16);
#pragma unroll
                for (int bj = 0; bj < 2; ++bj) {
                    const u32x4 gw = *(const u32x4*)(G + row * 512 + gcol0 + bj * HALF);
                    bf16_t* mp = merged + row * 1024 + col0 + bj * HALF;
                    float v[8];
#pragma unroll
                    for (int q = 0; q < 4; ++q) { v[q] = acc[ai][bj][m][0][q]; v[4 + q] = acc[ai][bj][m][1][q]; }
                    const unsigned gg[4] = {gw.x, gw.y, gw.z, gw.w};
#pragma unroll
                    for (int q = 0; q < 4; ++q) { v[2 * q] *= sigmoid_f(__uint_as_float(gg[q] << 16)); v[2 * q + 1] *= sigmoid_f(__uint_as_float(gg[q] & 0xffff0000u)); }
                    if (n > 0) { const u32x4 ow = *(const u32x4*)mp; const unsigned oo[4] = {ow.x, ow.y, ow.z, ow.w};
#pragma unroll
                        for (int q = 0; q < 4; ++q) { v[2 * q] += __uint_as_float(oo[q] << 16); v[2 * q + 1] += __uint_as_float(oo[q] & 0xffff0000u); } }
                    u32x4 w; w.x = pack2(v[0], v[1]); w.y = pack2(v[2], v[3]); w.z = pack2(v[4], v[5]); w.w = pack2(v[6], v[7]);
                    *(u32x4*)mp = w; } }
    }
};
struct EpiResid {
    static constexpr bool PERM = false;
    float* xs; const float* modL;
    DI void operator()(AccRef acc, const Unit& u, int wr, int wc, int fr, int fq) const {
        const int row0 = u.pm * BM + wr * 64 + fr, col0 = u.pn * BM + wc * 32 + 4 * fq;
#pragma unroll
        for (int ai = 0; ai < 2; ++ai)
#pragma unroll
            for (int m = 0; m < 4; ++m) { const int row = row0 + ai * HALF + m * 16; float* rowp = xs + (size_t)row * 1024 + col0;
                const float* g = modL + (size_t)modidx(row) * 6144 + 2048 + col0;
#pragma unroll
                for (int bj = 0; bj < 2; ++bj)
#pragma unroll
                    for (int n = 0; n < 2; ++n) { const f32x4 gv = *(const f32x4*)(g + bj * HALF + n * 16); f32x4 x = *(f32x4*)(rowp + bj * HALF + n * 16);
                        x += gv * acc[ai][bj][m][n]; *(f32x4*)(rowp + bj * HALF + n * 16) = x; } }
    }
};
struct EpiMoe1 {
    static constexpr bool PERM = true;
    bf16_t* act;
    DI void operator()(AccRef acc, const Unit& u, int wr, int wc, int fr, int fq) const {
        const int row0 = u.pm * BM + wr * 64 + fr, col0 = (u.pn & 3) * 128 + wc * 32 + 8 * fq;
#pragma unroll
        for (int ai = 0; ai < 2; ++ai)
#pragma unroll
            for (int m = 0; m < 4; ++m) { bf16_t* rowp = act + (size_t)(row0 + ai * HALF + m * 16) * 512 + col0;
                float v[8];
#pragma unroll
                for (int q = 0; q < 4; ++q) { v[q] = silu_f(acc[ai][0][m][0][q]) * acc[ai][1][m][0][q]; v[4 + q] = silu_f(acc[ai][0][m][1][q]) * acc[ai][1][m][1][q]; }
                u32x4 w; w.x = pack2(v[0], v[1]); w.y = pack2(v[2], v[3]); w.z = pack2(v[4], v[5]); w.w = pack2(v[6], v[7]);
                *(u32x4*)rowp = w; }
    }
};
struct EpiMoe2 {
    static constexpr bool PERM = true;
    bf16_t* ys;
    DI void operator()(AccRef acc, const Unit& u, int wr, int wc, int fr, int fq) const {
        const int row0 = u.pm * BM + wr * 64 + fr, col0 = (u.pn & 3) * 256 + wc * 32 + 8 * fq;
#pragma unroll
        for (int ai = 0; ai < 2; ++ai)
#pragma unroll
            for (int m = 0; m < 4; ++m) { bf16_t* rowp = ys + (size_t)(row0 + ai * HALF + m * 16) * 1024 + col0;
#pragma unroll
                for (int bj = 0; bj < 2; ++bj) { const f32x4 v0 = acc[ai][bj][m][0], v1 = acc[ai][bj][m][1];
                    u32x4 w; w.x = pack2(v0[0], v0[1]); w.y = pack2(v0[2], v0[3]); w.z = pack2(v1[0], v1[1]); w.w = pack2(v1[2], v1[3]);
                    *(u32x4*)(rowp + bj * HALF) = w; } }
    }
};

template <class Epi, class Sched>
DI void gemm_phase(LAS unsigned char* lds, const Gemm g, const Sched& S, const Epi& E, const int tid) {
    const int wid = __builtin_amdgcn_readfirstlane(tid >> 6), lane = tid & 63, wr = wid >> 2, wc = wid & 3, fr = lane & 15, fq = lane >> 4;
    const int K = g.K, nt = K / BK;
    unsigned voffA[2], voffB[2];
#pragma unroll
    for (int i = 0; i < 2; ++i) { int R, C; stage_rc(tid * 16 + i * 8192, R, C); const int Rb = Epi::PERM ? ((R & ~31) + perm32(R & 31)) : R;
        voffA[i] = (unsigned)(R * K + C) * 2u; voffB[i] = (unsigned)(Rb * K + C) * 2u; }
    const size_t kstep = (size_t)(BK * 2);
    const size_t hstep = (size_t)HALF * K * 2;
    const size_t tstep = 2 * hstep;
    const unsigned ldsw = (unsigned)wid * 1024u;
    const int aoff = lds_byte(wr * 64 + fr, fq * 8), boff = lds_byte(wc * 32 + fr, fq * 8);
#define PG8_SA(b, h) (((b) * 2 + (h)) * HTB)
#define PG8_SB(b, h) ((4 + (b) * 2 + (h)) * HTB)
#define PG8_STAGE(bufoff, gbase, voff) do { _Pragma("unroll") for (int _i = 0; _i < 2; ++_i) \
        __builtin_amdgcn_global_load_lds((const unsigned*)((const char*)(gbase) + (voff)[_i]), (LAS unsigned*)(lds + (bufoff) + ldsw + _i * 8192), 16, 0, 0); } while (0)
#define PG8_LDA(dst, b, h) do { _Pragma("unroll") for (int m = 0; m < 4; ++m) _Pragma("unroll") for (int k = 0; k < 2; ++k) dst[m][k] = *(const LAS bf16x8*)(lds + PG8_SA(b, h) + aoff + m * 2048 + k * 1024); } while (0)
#define PG8_LDB(dst, b, h) do { _Pragma("unroll") for (int n = 0; n < 2; ++n) _Pragma("unroll") for (int k = 0; k < 2; ++k) dst[n][k] = *(const LAS bf16x8*)(lds + PG8_SB(b, h) + boff + n * 2048 + k * 1024); } while (0)
#define PG8_MMA(ai, bj, At, Bt) do { __builtin_amdgcn_s_setprio(1); _Pragma("unroll") for (int m = 0; m < 4; ++m) _Pragma("unroll") for (int n = 0; n < 2; ++n) _Pragma("unroll") for (int k = 0; k < 2; ++k) \
        acc[ai][bj][m][n] = __builtin_amdgcn_mfma_f32_16x16x32_bf16(Bt[n][k], At[m][k], acc[ai][bj][m][n], 0, 0, 0); __builtin_amdgcn_s_setprio(0); } while (0)
#define PG8_WAIT_V(n) asm volatile("s_waitcnt vmcnt(" #n ")" ::: "memory")
#define PG8_WAIT_L(n) asm volatile("s_waitcnt lgkmcnt(" #n ")" ::: "memory")
#define PG8_BAR __builtin_amdgcn_s_barrier()
#define PG8_SCHED __builtin_amdgcn_sched_barrier(0)
    Unit cur, nxt; int ui = 0;
    if (!S.next(0, cur)) return;
    f32x4 acc[2][2][4][2];
#pragma unroll
    for (int a = 0; a < 2; ++a)
#pragma unroll
        for (int b = 0; b < 2; ++b)
#pragma unroll
            for (int m = 0; m < 4; ++m)
#pragma unroll
                for (int n = 0; n < 2; ++n) acc[a][b][m][n] = (f32x4){0.f, 0.f, 0.f, 0.f};
    bf16x8 At[4][2], B0[2][2], B1[2][2];
    const char* cA = (const char*)g.A + (size_t)cur.pm * tstep; const char* cB = (const char*)g.Bt + (size_t)cur.pn * tstep;
    PG8_STAGE(PG8_SB(0, 0), cB, voffB); PG8_STAGE(PG8_SA(0, 0), cA, voffA); PG8_STAGE(PG8_SB(0, 1), cB + hstep, voffB); PG8_STAGE(PG8_SA(0, 1), cA + hstep, voffA);
    if (wr == 1) PG8_BAR;
    PG8_WAIT_V(4); PG8_BAR;
    PG8_STAGE(PG8_SB(1, 0), cB + kstep, voffB); PG8_STAGE(PG8_SA(1, 0), cA + kstep, voffA); PG8_STAGE(PG8_SB(1, 1), cB + hstep + kstep, voffB);
    PG8_WAIT_V(6); PG8_BAR;
    for (;;) {
        const bool has_next = S.next(ui + 1, nxt);
        const char* nA = has_next ? (const char*)g.A + (size_t)nxt.pm * tstep : cA; const char* nB = has_next ? (const char*)g.Bt + (size_t)nxt.pn * tstep : cB;
        for (int t = 0; t < nt; t += 2) {
            const bool last = (t == nt - 2);
            const char* a1 = cA + (size_t)(t + 1) * kstep;
            const char* a2 = last ? nA : cA + (size_t)(t + 2) * kstep; const char* b2 = last ? nB : cB + (size_t)(t + 2) * kstep;
            const char* a3 = a2 + kstep; const char* b3 = b2 + kstep;
            PG8_LDB(B0, 0, 0); PG8_SCHED; PG8_LDA(At, 0, 0); PG8_STAGE(PG8_SA(1, 1), a1 + hstep, voffA);
            PG8_WAIT_L(8); PG8_BAR; PG8_WAIT_L(0); PG8_MMA(0, 0, At, B0); PG8_BAR; PG8_SCHED;
            PG8_LDB(B1, 0, 1); PG8_STAGE(PG8_SB(0, 0), b2, voffB);
            PG8_BAR; PG8_WAIT_L(0); PG8_MMA(0, 1, At, B1); PG8_BAR;
            PG8_LDA(At, 0, 1); PG8_STAGE(PG8_SA(0, 0), a2, voffA);
            PG8_BAR; PG8_WAIT_L(0); PG8_MMA(1, 0, At, B0); PG8_BAR; PG8_SCHED;
            PG8_STAGE(PG8_SB(0, 1), b2 + hstep, voffB);
            PG8_WAIT_V(6); PG8_BAR; PG8_MMA(1, 1, At, B1); PG8_BAR;
            PG8_LDB(B0, 1, 0); PG8_SCHED; PG8_LDA(At, 1, 0); PG8_STAGE(PG8_SA(0, 1), a2 + hstep, voffA);
            PG8_WAIT_L(8); PG8_BAR; PG8_WAIT_L(0); PG8_MMA(0, 0, At, B0); PG8_BAR; PG8_SCHED;
            PG8_LDB(B1, 1, 1); PG8_STAGE(PG8_SB(1, 0), b3, voffB);
            PG8_BAR; PG8_WAIT_L(0); PG8_MMA(0, 1, At, B1); PG8_BAR;
            PG8_LDA(At, 1, 1); PG8_STAGE(PG8_SA(1, 0), a3, voffA);
            PG8_BAR; PG8_WAIT_L(0); PG8_MMA(1, 0, At, B0); PG8_BAR; PG8_SCHED;
            PG8_STAGE(PG8_SB(1, 1), b3 + hstep, voffB);
            PG8_WAIT_V(6); PG8_BAR; PG8_MMA(1, 1, At, B1); PG8_BAR;
        }
        E(acc, cur, wr, wc, fr, fq);
        if (!has_next) break;
#pragma unroll
        for (int a = 0; a < 2; ++a)
#pragma unroll
            for (int b = 0; b < 2; ++b)
#pragma unroll
                for (int m = 0; m < 4; ++m)
#pragma unroll
                    for (int n = 0; n < 2; ++n) acc[a][b][m][n] = (f32x4){0.f, 0.f, 0.f, 0.f};
        cur = nxt; cA = nA; cB = nB; ++ui;
    }
    PG8_WAIT_V(0);
    if (wr == 0) PG8_BAR;
    PG8_BAR;
#undef PG8_SA
#undef PG8_SB
#undef PG8_STAGE
#undef PG8_LDA
#undef PG8_LDB
#undef PG8_MMA
#undef PG8_WAIT_V
#undef PG8_WAIT_L
#undef PG8_BAR
#undef PG8_SCHED
}
}
constexpr int LDS_BYTES = 139264;
constexpr int LDS_MISC = 131072;

DI void tr_tile(const Frame& F, const float* src, int ld, int k0, int c0, bf16_t* dst, int K, int n0, LAS float* tile) {
    const int kr = F.tid >> 4, c4 = (F.tid & 15) * 4;
#pragma unroll
    for (int ps = 0; ps < 2; ++ps) { const int k = kr + 32 * ps; const f32x4 v = *(const f32x4*)(src + (size_t)(k0 + k) * ld + c0 + c4);
        tile[k * 65 + c4] = v[0]; tile[k * 65 + c4 + 1] = v[1]; tile[k * 65 + c4 + 2] = v[2]; tile[k * 65 + c4 + 3] = v[3]; }
    __syncthreads();
    const int n = F.tid >> 3, kc = (F.tid & 7) * 8;
    float v[8];
#pragma unroll
    for (int i = 0; i < 8; ++i) v[i] = tile[(kc + i) * 65 + n];
    u32x4 w; w.x = pack2(v[0], v[1]); w.y = pack2(v[2], v[3]); w.z = pack2(v[4], v[5]); w.w = pack2(v[6], v[7]);
    *(u32x4*)(dst + (size_t)(n0 + n) * K + k0 + kc) = w;
    __syncthreads();
}

DI void phase0(const Frame& F, LAS unsigned char* lds) {
    const int G = F.G, bid = F.bid;
    { float* wsm = (float*)(F.ws + WS_WSM); float* wrt = (float*)(F.ws + WS_WRT);
      for (int idx = bid * NT + F.tid; idx < 2 * 16 * 1024 + 16 * 1024; idx += G * NT) {
          if (idx < 2 * 16 * 1024) { const int L = idx >> 14, j = (idx >> 10) & 15, k = idx & 1023; wsm[idx] = F.inp(8)[((size_t)L * 1024 + k) * PW + 2048 + j]; }
          else { const int q = idx - 2 * 16 * 1024, j = q >> 10, k = q & 1023; wrt[q] = F.inp(24)[k * 16 + j]; } } }
    { LAS float* sil = (LAS float*)lds; LAS float* red = sil + 9 * 1024;
      for (int it = bid; it < 96; it += G) {
          const int L = it / 48, cb = it % 48;
          __syncthreads();
          for (int i = F.tid; i < 9 * 1024; i += NT) { const int r = i >> 10, k = i & 1023; const float c = r < 8 ? F.inp(1)[r * 1024 + k] : F.inp(3)[k]; sil[i] = silu_f(c); }
          __syncthreads();
          const int cl = F.tid & 127, kq = F.tid >> 7, col = cb * 128 + cl; const float* wm = F.inp(4) + (size_t)L * 1024 * 6144 + (size_t)(kq * 256) * 6144 + col;
          float acc[9];
#pragma unroll
          for (int r = 0; r < 9; ++r) acc[r] = 0.f;
          for (int k = 0; k < 256; ++k) { const float w = wm[(size_t)k * 6144];
#pragma unroll
              for (int r = 0; r < 9; ++r) acc[r] += sil[r * 1024 + kq * 256 + k] * w; }
#pragma unroll
          for (int r = 0; r < 9; ++r) red[(kq * 9 + r) * 128 + cl] = acc[r];
          __syncthreads();
          if (kq == 0) { const float bias = F.inp(5)[L * 6144 + col];
#pragma unroll
              for (int r = 0; r < 9; ++r) F.mod(L, r)[col] = ((red[(0 * 9 + r) * 128 + cl] + red[(1 * 9 + r) * 128 + cl]) + (red[(2 * 9 + r) * 128 + cl] + red[(3 * 9 + r) * 128 + cl])) + bias; }
      }
      __syncthreads(); }
    { LAS float* tile = (LAS float*)lds;
      for (int it = bid; it < 17408; it += G) {
          const int L = it / 8704; int q = it % 8704; bf16_t* wb = F.wb(L);
          if (q < 1920) { const int kt = q / 120, nt = q % 120, n0 = nt * 64, c0 = n0 < 2048 ? n0 : n0 + 16;
              tr_tile(F, F.inp(8) + (size_t)L * 1024 * PW, PW, kt * 64, c0, wb + W_IN, 1024, n0, tile); continue; }
          q -= 1920;
          if (q < 384) { const int br = q >> 7, r = q & 127, kt = r >> 4, nt = r & 15;
              tr_tile(F, F.inp(22) + (size_t)(L * 3 + br) * 512 * 1024, 1024, kt * 64, nt * 64, wb + W_BR + (size_t)br * 1024 * 512, 512, nt * 64, tile); continue; }
          q -= 384;
          if (q < 256) { const int kt = q >> 4, nt = q & 15;
              tr_tile(F, F.inp(23) + (size_t)L * 1024 * 1024, 1024, kt * 64, nt * 64, wb + W_OUT, 1024, nt * 64, tile); continue; }
          q -= 256;
          if (q < 4096) { const int e = q >> 8, r = q & 255, kt = r >> 4, nt = r & 15, n0 = nt * 64, t256 = n0 >> 8, wi = n0 & 255;
              const int c0 = wi < 128 ? t256 * 128 + wi : 512 + t256 * 128 + (wi - 128);
              tr_tile(F, F.inp(26) + (size_t)(L * 16 + e) * 1024 * 1024, 1024, kt * 64, c0, wb + W_GU + (size_t)e * 1024 * 1024, 1024, n0, tile); continue; }
          q -= 4096;
          { const int e = q >> 7, r = q & 127, kt = r >> 4, nt = r & 15;
              tr_tile(F, F.inp(27) + (size_t)(L * 16 + e) * 512 * 1024, 1024, kt * 64, nt * 64, wb + W_DN + (size_t)e * 1024 * 512, 512, nt * 64, tile); }
      } }
}

DI void norm_phase(const Frame& F, int L, int which) {
    const int G = F.G;
    const float* gain = (which == 1 ? F.inp(6) : F.inp(7)) + L * 1024;
    const float* wsm = (const float*)(F.ws + WS_WSM) + (size_t)L * 16 * 1024;
    const float* wrt = (const float*)(F.ws + WS_WRT);
    float* xs = F.xs(); bf16_t* H = F.h(); unsigned* route = F.route();
    const bf16_t* ys = F.slot(8);
    for (int r = F.bid * 8 + F.wave; r < MROWS; r += G * 8) {
        const int b = r / TT, t = r - b * TT, mi = t < CTX ? 8 : b;
        f32x4 x[4];
        if (which == 1 && L == 0) {
            const float* src = t < CTX ? F.inp(2) + ((size_t)b * CTX + t) * 1024 : F.inp(0) + ((size_t)b * SEQ + (t - CTX)) * 1024;
#pragma unroll
            for (int i = 0; i < 4; ++i) x[i] = *(const f32x4*)(src + F.lane * 4 + 256 * i);
        } else {
#pragma unroll
            for (int i = 0; i < 4; ++i) x[i] = *(const f32x4*)(xs + (size_t)r * 1024 + F.lane * 4 + 256 * i);
        }
        if (which == 1 && L > 0) {
            const unsigned* rt = route + (size_t)r * 8;
            const float w0 = __uint_as_float(rt[2]), w1 = __uint_as_float(rt[3]); const int p0 = (int)rt[4], p1 = (int)rt[5];
            const float* m5 = F.mod(L - 1, mi) + 5 * 1024;
#pragma unroll
            for (int i = 0; i < 4; ++i) { const int c = F.lane * 4 + 256 * i;
                const u32x2 a = *(const u32x2*)(ys + (size_t)p0 * 1024 + c), bq = *(const u32x2*)(ys + (size_t)p1 * 1024 + c); const f32x4 g = *(const f32x4*)(m5 + c);
                x[i][0] += g[0] * (w0 * __uint_as_float(a.x << 16) + w1 * __uint_as_float(bq.x << 16));
                x[i][1] += g[1] * (w0 * __uint_as_float(a.x & 0xffff0000u) + w1 * __uint_as_float(bq.x & 0xffff0000u));
                x[i][2] += g[2] * (w0 * __uint_as_float(a.y << 16) + w1 * __uint_as_float(bq.y << 16));
                x[i][3] += g[3] * (w0 * __uint_as_float(a.y & 0xffff0000u) + w1 * __uint_as_float(bq.y & 0xffff0000u)); }
        }
        if (which == 1) {
#pragma unroll
            for (int i = 0; i < 4; ++i) *(f32x4*)(xs + (size_t)r * 1024 + F.lane * 4 + 256 * i) = x[i];
        }
        float ss = 0.f;
#pragma unroll
        for (int i = 0; i < 4; ++i) ss += x[i][0] * x[i][0] + x[i][1] * x[i][1] + x[i][2] * x[i][2] + x[i][3] * x[i][3];
        ss = wave_sum(ss);
        const float rstd = rsqrtf(ss * (1.f / 1024.f) + EPS);
        const float* mv = F.mod(L, mi) + (which == 1 ? 0 : 3 * 1024);
        f32x4 hh[4];
#pragma unroll
        for (int i = 0; i < 4; ++i) { const int c = F.lane * 4 + 256 * i; const f32x4 g = *(const f32x4*)(gain + c), sh = *(const f32x4*)(mv + c), sc = *(const f32x4*)(mv + 1024 + c);
#pragma unroll
            for (int q = 0; q < 4; ++q) hh[i][q] = (x[i][q] * rstd * g[q]) * (1.f + sc[q]) + sh[q];
            u32x2 w; w.x = pack2(hh[i][0], hh[i][1]); w.y = pack2(hh[i][2], hh[i][3]);
            *(u32x2*)(H + (size_t)r * 1024 + c) = w; }
        const float* sw = which == 1 ? wsm : wrt;
        float dv = 0.f;
#pragma unroll 1
        for (int j = 0; j < 16; ++j) { float a = 0.f;
#pragma unroll
            for (int i = 0; i < 4; ++i) { const f32x4 w = *(const f32x4*)(sw + j * 1024 + F.lane * 4 + 256 * i); a += hh[i][0] * w[0] + hh[i][1] * w[1] + hh[i][2] * w[2] + hh[i][3] * w[3]; }
            a = wave_sum(a); dv = (F.lane == j) ? a : dv; }
        if (which == 1) {
            float* ba = (float*)(F.ws + WS_BA) + (size_t)r * 16;
            if (F.lane < 16) ba[F.lane] = dv;
        } else {
            float p[16], mx = -3.0e38f;
#pragma unroll
            for (int j = 0; j < 16; ++j) { p[j] = __shfl(dv, j) + F.inp(25)[j]; mx = fmaxf(mx, p[j]); }
            float sum = 0.f;
#pragma unroll
            for (int j = 0; j < 16; ++j) { p[j] = __expf(p[j] - mx); sum += p[j]; }
            const float inv = 1.f / sum;
            float bs = -1.f, bp0 = 0.f, bp1 = 0.f; int be0 = 0, be1 = 1;
#pragma unroll
            for (int g = 0; g < 4; ++g) { float a = -1.f, c2 = -1.f; int ia = 0, ib = 0;
#pragma unroll
                for (int i = 0; i < 4; ++i) { const float v = p[g * 4 + i] * inv; if (v > a) { c2 = a; ib = ia; a = v; ia = i; } else if (v > c2) { c2 = v; ib = i; } }
                const float sc = a + c2; if (sc > bs) { bs = sc; bp0 = a; bp1 = c2; be0 = g * 4 + ia; be1 = g * 4 + ib; } }
            if (F.lane == 0) {
                unsigned* cnt = F.ctl() + L * 16;
                const int pos0 = (int)atomicAdd(cnt + be0, 1u), pos1 = (int)atomicAdd(cnt + be1, 1u);
                unsigned* rt = route + (size_t)r * 8; const float wsum = bp0 + bp1;
                rt[0] = (unsigned)be0; rt[1] = (unsigned)be1; rt[2] = __float_as_uint(bp0 / wsum); rt[3] = __float_as_uint(bp1 / wsum); rt[6] = (unsigned)pos0; rt[7] = (unsigned)pos1;
            }
        }
    }
}

DI void moe_tile_bases(const Frame& F, int L, LAS int* tb) {
    if (F.tid == 0) { const unsigned* cnt = F.ctl() + L * 16; int acc = 0;
        for (int e = 0; e < 16; ++e) { tb[e] = acc; acc += (int)((cnt[e] + 255u) >> 8); }
        tb[16] = acc; }
    __syncthreads();
}

DI void sort_phase(const Frame& F, int L, LAS int* tb) {
    moe_tile_bases(F, L, tb);
    const int G = F.G; const bf16_t* H = F.h(); bf16_t* h2s = F.slot(0); unsigned* route = F.route();
    for (int r = F.bid * 8 + F.wave; r < MROWS; r += G * 8) {
        unsigned* rt = route + (size_t)r * 8;
        const int e0 = (int)rt[0], e1 = (int)rt[1]; const int d0 = tb[e0] * 256 + (int)rt[6], d1 = tb[e1] * 256 + (int)rt[7];
        const u32x4 a = *(const u32x4*)(H + (size_t)r * 1024 + F.lane * 8), c = *(const u32x4*)(H + (size_t)r * 1024 + 512 + F.lane * 8);
        *(u32x4*)(h2s + (size_t)d0 * 1024 + F.lane * 8) = a; *(u32x4*)(h2s + (size_t)d0 * 1024 + 512 + F.lane * 8) = c;
        *(u32x4*)(h2s + (size_t)d1 * 1024 + F.lane * 8) = a; *(u32x4*)(h2s + (size_t)d1 * 1024 + 512 + F.lane * 8) = c;
        if (F.lane == 0) { rt[4] = (unsigned)d0; rt[5] = (unsigned)d1; }
    }
}

DI void final_phase(const Frame& F) {
    const int G = F.G; const float* xs = F.xs(); const bf16_t* ys = F.slot(8); const unsigned* route = F.route();
    for (int o = F.bid * 8 + F.wave; o < NB * SEQ; o += G * 8) {
        const int b = o / SEQ, s = o - b * SEQ, r = b * TT + CTX + s;
        const unsigned* rt = route + (size_t)r * 8;
        const float w0 = __uint_as_float(rt[2]), w1 = __uint_as_float(rt[3]); const int p0 = (int)rt[4], p1 = (int)rt[5];
        const float* m5 = F.mod(1, b) + 5 * 1024;
#pragma unroll
        for (int i = 0; i < 4; ++i) { const int c = F.lane * 4 + 256 * i;
            f32x4 x = *(const f32x4*)(xs + (size_t)r * 1024 + c);
            const u32x2 a = *(const u32x2*)(ys + (size_t)p0 * 1024 + c), bq = *(const u32x2*)(ys + (size_t)p1 * 1024 + c); const f32x4 g = *(const f32x4*)(m5 + c);
            x[0] += g[0] * (w0 * __uint_as_float(a.x << 16) + w1 * __uint_as_float(bq.x << 16));
            x[1] += g[1] * (w0 * __uint_as_float(a.x & 0xffff0000u) + w1 * __uint_as_float(bq.x & 0xffff0000u));
            x[2] += g[2] * (w0 * __uint_as_float(a.y << 16) + w1 * __uint_as_float(bq.y << 16));
            x[3] += g[3] * (w0 * __uint_as_float(a.y & 0xffff0000u) + w1 * __uint_as_float(bq.y & 0xffff0000u));
            *(f32x4*)(F.out + (size_t)o * 1024 + c) = x; }
    }
}
DI void attn_prep_item(const Frame& F, int L, int b, int tt, LAS unsigned char* lds) {
    const int t0 = tt * 64;
    const bf16_t* Pq = F.slot(4); const bf16_t* Pk = F.slot(5); const bf16_t* Pv = F.slot(6);
    bf16_t* Qn = F.slot(9); bf16_t* Kn = F.slot(10); bf16_t* Vt = F.slot(11);
    const int d = F.lane;
    const float gq = F.inp(13)[L * 64 + d], gk = F.inp(14)[L * 64 + d];
    const int half = d >> 5, idx = d & 31, fi = idx & 15;
    const float inv_freq = exp2f(-(float)fi * (13.287712379549449f / 16.f));
    for (int task = F.wave; task < 1024; task += 8) {
        const int tok = task >> 4, rest = task & 15, qk = rest >> 3, hd = (rest >> 1) & 3, c = rest & 1;
        const int t = t0 + tok; const size_t r = (size_t)b * TT + t;
        const float x = bf2f((qk ? Pk : Pq)[r * 512 + hd * 128 + c * 64 + d]);
        const float ss = wave_sum(x * x);
        float y = x * rsqrtf(ss * (1.f / 64.f) + EPS) * (qk ? gk : gq);
        if (t >= CTX) {
            const int pos = t - CTX; const float id = half ? (float)(pos & 63) : (float)(pos >> 6);
            const float ang = id * inv_freq; float sn, cs; sincosf(ang, &sn, &cs);
            const float other = __shfl_xor(y, 16);
            y = idx < 16 ? y * cs - other * sn : y * cs + other * sn;
        }
        if (!qk) y *= 0.125f * 1.4426950408889634f;
        (qk ? Kn : Qn)[((size_t)((b * 4 + hd) * 2 + c) * TT + t) * 64 + d] = f2bf(y);
    }
    LAS bf16_t* tl = (LAS bf16_t*)lds;
    __syncthreads();
    for (int ch = F.tid; ch < 4096; ch += NT) { const int tok = ch >> 6, c8 = (ch & 63) * 8;
        *(LAS u32x4*)(tl + tok * 520 + c8) = *(const u32x4*)(Pv + ((size_t)b * TT + t0 + tok) * 512 + c8); }
    __syncthreads();
    { const int col = F.tid; bf16_t* dst = Vt + ((size_t)b * 512 + col) * TT + t0;
#pragma unroll
      for (int g = 0; g < 8; ++g) { unsigned w[4];
#pragma unroll
          for (int q = 0; q < 4; ++q) w[q] = (unsigned)tl[(g * 8 + 2 * q) * 520 + col] | ((unsigned)tl[(g * 8 + 2 * q + 1) * 520 + col] << 16);
          u32x4 v; v.x = w[0]; v.y = w[1]; v.z = w[2]; v.w = w[3];
          *(u32x4*)(dst + g * 8) = v; } }
    __syncthreads();
}

DI void lru_chunk(const Frame& F, int L, int b, int c32, int mode, LAS unsigned char* lds) {
    LAS float* xcs = (LAS float*)lds;
    const int t0 = c32 * 32, seg_lo = t0 < CTX ? 0 : CTX, seg_hi = t0 < CTX ? CTX : TT;
    const int ch = F.tid, n = ch >> 6, k = ch & 63;
    const bf16_t* Px = F.slot(7); const bf16_t* Py = F.slot(8); bf16_t* Yc = F.slot(6);
    float* lrs = (float*)(F.ws + WS_LRS);
    __syncthreads();
    { const float w0 = F.inp(17)[(L * 4 + 0) * 512 + ch], w1 = F.inp(17)[(L * 4 + 1) * 512 + ch], w2 = F.inp(17)[(L * 4 + 2) * 512 + ch], w3 = F.inp(17)[(L * 4 + 3) * 512 + ch], cb = F.inp(18)[L * 512 + ch];
      auto raw = [&](int t) -> float { return (t >= seg_lo && t < seg_hi) ? bf2f(Px[((size_t)b * TT + t) * 512 + ch]) : 0.f; };
      float r0 = raw(t0 - 2), r1 = raw(t0 - 1), r2 = raw(t0);
      for (int tok = 0; tok < 32; ++tok) { const float r3 = raw(t0 + tok + 1);
          xcs[tok * 512 + ch] = w0 * r0 + w1 * r1 + w2 * r2 + w3 * r3 + cb; r0 = r1; r1 = r2; r2 = r3; } }
    __syncthreads();
    LAS float* hfs = xcs + 32 * 512;
#pragma unroll
    for (int dir = 0; dir < 2; ++dir) {
        float la[32], acc[32];
        const float sp = softplus_f(-F.inp(21)[(L * 2 + dir) * 512 + ch]);
#pragma unroll
        for (int gate = 0; gate < 2; ++gate) {
            const float bg = F.inp(20)[((L * 2 + dir) * 2 + gate) * 512 + ch];
            const float* wg = F.inp(19) + ((size_t)(((L * 2 + dir) * 2 + gate) * 8 + n) * 64) * 64 + k;
#pragma unroll
            for (int th = 0; th < 2; ++th) {
                float a16[16];
#pragma unroll
                for (int tok = 0; tok < 16; ++tok) a16[tok] = bg;
#pragma unroll 1
                for (int j = 0; j < 64; j += 4) {
                    const float wa = wg[(j + 0) * 64], wb2 = wg[(j + 1) * 64], wc = wg[(j + 2) * 64], wd = wg[(j + 3) * 64];
#pragma unroll
                    for (int tok = 0; tok < 16; ++tok) { const f32x4 xv = *(const LAS f32x4*)(xcs + (th * 16 + tok) * 512 + n * 64 + j);
                        a16[tok] += xv[0] * wa + xv[1] * wb2 + xv[2] * wc + xv[3] * wd; }
                }
#pragma unroll
                for (int tok = 0; tok < 16; ++tok) { if (gate == 0) la[th * 16 + tok] = -8.f * sigmoid_f(a16[tok]) * sp; else acc[th * 16 + tok] = a16[tok]; }
            }
        }
        float h = 0.f, ap = 1.f;
        if (mode == 1) {
            const float* s = lrs + ((size_t)((b * 2 + dir) * NLC) * 512 + ch) * 2;
            if (dir == 0) { for (int cc = 0; cc < c32; ++cc) { const float A = s[(size_t)cc * 1024], Bv = s[(size_t)cc * 1024 + 1]; h = A * h + Bv; } }
            else { const int stop = c32 < 8 ? c32 : -1;
                for (int cc = 7; cc > stop; --cc) { const float A = s[(size_t)cc * 1024], Bv = s[(size_t)cc * 1024 + 1]; h = A * h + Bv; }
                if (c32 >= 8) for (int cc = NLC - 1; cc > c32; --cc) { const float A = s[(size_t)cc * 1024], Bv = s[(size_t)cc * 1024 + 1]; h = A * h + Bv; } }
        }
#pragma unroll
        for (int i = 0; i < 32; ++i) { const int tok = dir ? 31 - i : i;
            const float a = __expf(la[tok]); const float mult = sqrtf(fmaxf(-expm1f(2.f * la[tok]), 0.f));
            const float bb = mult * sigmoid_f(acc[tok]) * xcs[tok * 512 + ch];
            h = a * h + bb; ap *= a;
            if (mode == 1) { if (dir == 0) hfs[tok * 512 + ch] = h;
                else { const size_t r = (size_t)b * TT + t0 + tok; Yc[r * 512 + ch] = f2bf((hfs[tok * 512 + ch] + h) * gelu_tanh_f(bf2f(Py[r * 512 + ch]))); } }
        }
        if (mode == 0) { float* s = lrs + ((size_t)((b * 2 + dir) * NLC + c32) * 512 + ch) * 2; s[0] = ap; s[1] = h; }
    }
}

DI float row16_sum(float v) {
#pragma unroll
    for (int o = 8; o >= 1; o >>= 1) v += __shfl_xor(v, o);
    return v;
}
DI void gdn_item(const Frame& F, int L, int b, int hd, int dir, int eq, LAS unsigned char* lds) {
    LAS float* qk = (LAS float*)lds;
    LAS float* vv = qk + 64 * 256;
    LAS float* ob = vv + 64 * 32;
    LAS float* sc = ob + 64 * 32;
    const bf16_t* Pq = F.slot(0); const bf16_t* Pk = F.slot(1); const bf16_t* Pv = F.slot(2);
    bf16_t* og = F.slot(12 + dir);
    const float* ba = (const float*)(F.ws + WS_BA);
    const float* cw = F.inp(9) + (size_t)L * 4 * 1536;
    const float neg_a = -__expf(F.inp(10)[(L * 2 + dir) * 4 + hd]), dtb = F.inp(11)[(L * 2 + dir) * 4 + hd];
    const int col = F.lane >> 4, ds = F.lane & 15, el = 4 * F.wave + col;
    float S[8];
#pragma unroll
    for (int i = 0; i < 8; ++i) S[i] = 0.f;
    for (int step = 0; step < 36; ++step) {
        const int tt = dir == 0 ? step : (step < 4 ? 3 - step : 39 - step);
        const int t0 = tt * 64, seg_lo = t0 < CTX ? 0 : CTX, seg_hi = t0 < CTX ? CTX : TT;
        __syncthreads();
        {
            const int c2 = F.tid & 255, th = F.tid >> 8, isk = c2 >> 7, dd = c2 & 127;
            const bf16_t* P = isk ? Pk : Pq; const int pc = hd * 128 + dd, wcn = isk * 512 + pc;
            const float w0 = cw[0 * 1536 + wcn], w1 = cw[1 * 1536 + wcn], w2 = cw[2 * 1536 + wcn], w3 = cw[3 * 1536 + wcn];
            auto raw = [&](int t) -> float { return (t >= seg_lo && t < seg_hi) ? bf2f(P[((size_t)b * TT + t) * 512 + pc]) : 0.f; };
            const int ts = t0 + th * 32;
            float r0 = raw(ts - 2), r1 = raw(ts - 1), r2 = raw(ts);
            for (int i = 0; i < 32; ++i) { const float r3 = raw(ts + i + 1);
                qk[(th * 32 + i) * 256 + c2] = silu_f(w0 * r0 + w1 * r1 + w2 * r2 + w3 * r3); r0 = r1; r1 = r2; r2 = r3; }
        }
        {
            const int tl = F.tid >> 3, c4 = (F.tid & 7) * 4, t = t0 + tl;
#pragma unroll
            for (int cc = 0; cc < 4; ++cc) { const int pc = hd * 128 + eq * 32 + c4 + cc, wcn = 1024 + pc; float a = 0.f;
#pragma unroll
                for (int j = 0; j < 4; ++j) { const int ts = t - 2 + j; if (ts >= seg_lo && ts < seg_hi) a += cw[j * 1536 + wcn] * bf2f(Pv[((size_t)b * TT + ts) * 512 + pc]); }
                vv[tl * 32 + c4 + cc] = silu_f(a); }
        }
        if (F.tid < 64) { const size_t r = (size_t)b * TT + t0 + F.tid;
            sc[F.tid * 4 + 2] = sigmoid_f(ba[r * 16 + dir * 4 + hd]);
            sc[F.tid * 4 + 3] = __expf(neg_a * softplus_f(ba[r * 16 + 8 + dir * 4 + hd] + dtb)); }
        __syncthreads();
        {
            const int pair = F.tid >> 2, part = F.tid & 3, tl = pair >> 1, isk = pair & 1; float a = 0.f;
            for (int i = 0; i < 32; ++i) { const float x = qk[tl * 256 + isk * 128 + part * 32 + ((i + pair) & 31)]; a += x * x; }
            a += __shfl_xor(a, 1); a += __shfl_xor(a, 2);
            if (part == 0) sc[tl * 4 + isk] = rsqrtf(a + EPS) * (isk ? 1.f : 0.08838834764831845f);
        }
        __syncthreads();
        for (int i = 0; i < 64; ++i) {
            const int tl = dir ? 63 - i : i;
            const f32x4 s4 = *(const LAS f32x4*)(sc + tl * 4);
            const f32x4 ka = *(const LAS f32x4*)(qk + tl * 256 + 128 + ds * 8), kb = *(const LAS f32x4*)(qk + tl * 256 + 128 + ds * 8 + 4);
            const f32x4 qa = *(const LAS f32x4*)(qk + tl * 256 + ds * 8), qb = *(const LAS f32x4*)(qk + tl * 256 + ds * 8 + 4);
            const float vval = vv[tl * 32 + el];
            float ks = ka[0] * S[0] + ka[1] * S[1] + ka[2] * S[2] + ka[3] * S[3] + kb[0] * S[4] + kb[1] * S[5] + kb[2] * S[6] + kb[3] * S[7];
            ks = row16_sum(ks);
            const float vn = s4[2] * (vval - s4[3] * s4[1] * ks);
            const float kv = s4[1] * vn;
            S[0] = s4[3] * S[0] + ka[0] * kv; S[1] = s4[3] * S[1] + ka[1] * kv; S[2] = s4[3] * S[2] + ka[2] * kv; S[3] = s4[3] * S[3] + ka[3] * kv;
            S[4] = s4[3] * S[4] + kb[0] * kv; S[5] = s4[3] * S[5] + kb[1] * kv; S[6] = s4[3] * S[6] + kb[2] * kv; S[7] = s4[3] * S[7] + kb[3] * kv;
            float o = qa[0] * S[0] + qa[1] * S[1] + qa[2] * S[2] + qa[3] * S[3] + qb[0] * S[4] + qb[1] * S[5] + qb[2] * S[6] + qb[3] * S[7];
            o = row16_sum(o);
            if (ds == 0) ob[tl * 32 + el] = s4[0] * o;
        }
        __syncthreads();
        { const int tl = F.tid >> 3, c4 = (F.tid & 7) * 4; const f32x4 o4 = *(const LAS f32x4*)(ob + tl * 32 + c4);
          u32x2 w; w.x = pack2(o4[0], o4[1]); w.y = pack2(o4[2], o4[3]);
          *(u32x2*)(og + ((size_t)b * TT + t0 + tl) * 512 + hd * 128 + eq * 32 + c4) = w; }
    }
}

DI void gdn_post(const Frame& F, int L) {
    const int G = F.G; const bf16_t* of = F.slot(12); const bf16_t* obk = F.slot(13); const bf16_t* Pz = F.slot(3); bf16_t* Ya = F.slot(4);
    const float* gain = F.inp(12) + L * 128;
    for (int r = F.bid * 8 + F.wave; r < MROWS; r += G * 8) {
        const size_t off = (size_t)r * 512 + F.lane * 8;
        const u32x4 a = *(const u32x4*)(of + off), c = *(const u32x4*)(obk + off), z = *(const u32x4*)(Pz + off);
        const unsigned aa[4] = {a.x, a.y, a.z, a.w}, cc[4] = {c.x, c.y, c.z, c.w}, zz[4] = {z.x, z.y, z.z, z.w};
        float o[8]; float ss = 0.f;
#pragma unroll
        for (int q = 0; q < 4; ++q) { o[2 * q] = __uint_as_float(aa[q] << 16) + __uint_as_float(cc[q] << 16); o[2 * q + 1] = __uint_as_float(aa[q] & 0xffff0000u) + __uint_as_float(cc[q] & 0xffff0000u);
            ss += o[2 * q] * o[2 * q] + o[2 * q + 1] * o[2 * q + 1]; }
        ss = row16_sum(ss);
        const float rstd = rsqrtf(ss * (1.f / 128.f) + EPS);
        const int e0 = (F.lane & 15) * 8;
        float y[8];
#pragma unroll
        for (int q = 0; q < 4; ++q) { y[2 * q] = o[2 * q] * rstd * gain[e0 + 2 * q] * silu_f(__uint_as_float(zz[q] << 16)); y[2 * q + 1] = o[2 * q + 1] * rstd * gain[e0 + 2 * q + 1] * silu_f(__uint_as_float(zz[q] & 0xffff0000u)); }
        u32x4 w; w.x = pack2(y[0], y[1]); w.y = pack2(y[2], y[3]); w.z = pack2(y[4], y[5]); w.w = pack2(y[6], y[7]);
        *(u32x4*)(Ya + off) = w;
    }
}
#define MFMA32(a, b, c) __builtin_amdgcn_mfma_f32_32x32x16_bf16((a), (b), (c), 0, 0, 0)
DI bf16x8 pack8(const f32x16& x, int s) {
    u32x4 p; p.x = pack2(x[8 * s], x[8 * s + 1]); p.y = pack2(x[8 * s + 2], x[8 * s + 3]); p.z = pack2(x[8 * s + 4], x[8 * s + 5]); p.w = pack2(x[8 * s + 6], x[8 * s + 7]);
    return __builtin_bit_cast(bf16x8, p);
}
constexpr int AK_PITCH = 272, AV_PITCH = 136, AK_BYTES = 64 * AK_PITCH, AV_BYTES = 128 * AV_PITCH;

DI void attn_item(const Frame& F, int L, int b, int hd, int qt, float lam, float lam_init, float bound2, LAS unsigned char* lds) {
    const bf16_t* Qn = F.slot(9); const bf16_t* Kn = F.slot(10); const bf16_t* Vt = F.slot(11); bf16_t* Yb = F.slot(5);
    const int qbase = qt < 8 ? CTX + qt * 256 : 0, nkt = qt < 8 ? 36 : 4;
    int tid_ = F.tid; asm volatile("" : "+v"(tid_));
    const int lane_ = tid_ & 63, l31 = lane_ & 31, hh = lane_ >> 5;
    const int tq = qbase + 32 * F.wave + l31;
    LAS unsigned char* Kl = lds; LAS unsigned char* Vl = lds + AK_BYTES;
    LAS unsigned char* Ql = lds + AK_BYTES + AV_BYTES + F.wave * 8192 + lane_ * 16;
    __syncthreads();
#pragma unroll
    for (int c = 0; c < 2; ++c)
#pragma unroll
        for (int s = 0; s < 4; ++s) *(LAS bf16x8*)(Ql + (c * 4 + s) * 1024) = *(const bf16x8*)(Qn + ((size_t)((b * 4 + hd) * 2 + c) * TT + tq) * 64 + 16 * s + 8 * hh);
    f32x16 O[2][4];
#pragma unroll
    for (int c = 0; c < 2; ++c)
#pragma unroll
        for (int e = 0; e < 4; ++e)
#pragma unroll
            for (int i = 0; i < 16; ++i) O[c][e][i] = 0.f;
    float lsum[2] = {0.f, 0.f};
    const int kkey = tid_ >> 3, kch = tid_ & 7;
    const bf16_t* kb = Kn + (size_t)((b * 4 + hd) * 2) * TT * 64;
    const bf16_t* vbs = Vt + (size_t)(b * 4 + hd) * 128 * TT;
    const unsigned koff = (unsigned)(kkey * 64 + kch * 8);
    const int ve0 = tid_ >> 3, ve1 = ve0 + 64, vch = tid_ & 7;
    const unsigned voff = (unsigned)(ve0 * TT + vch * 8);
    u32x4 rk0, rk1, rv0, rv1;
    rk0 = *(const u32x4*)(kb + koff); rk1 = *(const u32x4*)(kb + TT * 64 + koff); rv0 = *(const u32x4*)(vbs + voff); rv1 = *(const u32x4*)(vbs + 64 * TT + voff);
    for (int kt = 0; kt < nkt; ++kt) {
        __syncthreads();
        *(LAS u32x4*)(Kl + kkey * AK_PITCH + kch * 16) = rk0;
        *(LAS u32x4*)(Kl + kkey * AK_PITCH + 128 + kch * 16) = rk1;
        { u32x2 a; a.x = rv0.x; a.y = rv0.y; u32x2 c; c.x = rv0.z; c.y = rv0.w; *(LAS u32x2*)(Vl + ve0 * AV_PITCH + vch * 16) = a; *(LAS u32x2*)(Vl + ve0 * AV_PITCH + vch * 16 + 8) = c; }
        { u32x2 a; a.x = rv1.x; a.y = rv1.y; u32x2 c; c.x = rv1.z; c.y = rv1.w; *(LAS u32x2*)(Vl + ve1 * AV_PITCH + vch * 16) = a; *(LAS u32x2*)(Vl + ve1 * AV_PITCH + vch * 16 + 8) = c; }
        __syncthreads();
        if (kt + 1 < nkt) { const bf16_t* kn = kb + (kt + 1) * 4096; const bf16_t* vn = vbs + (kt + 1) * 64;
            rk0 = *(const u32x4*)(kn + koff); rk1 = *(const u32x4*)(kn + TT * 64 + koff); rv0 = *(const u32x4*)(vn + voff); rv1 = *(const u32x4*)(vn + 64 * TT + voff); }
#pragma unroll 1
        for (int u = 0; u < 2; ++u) {
            bf16x8 Pf[2][2];
#pragma unroll
            for (int c = 0; c < 2; ++c) {
                f32x16 S;
#pragma unroll
                for (int i = 0; i < 16; ++i) S[i] = 0.f;
#pragma unroll
                for (int s = 0; s < 4; ++s) { const bf16x8 A = *(const LAS bf16x8*)(Kl + (32 * u + l31) * AK_PITCH + c * 128 + (16 * s + 8 * hh) * 2); const bf16x8 Bq = *(const LAS bf16x8*)(Ql + (c * 4 + s) * 1024); S = MFMA32(A, Bq, S); }
#pragma unroll
                for (int i = 0; i < 16; ++i) { S[i] = __builtin_amdgcn_exp2f(S[i] - bound2); lsum[c] += S[i]; }
                Pf[c][0] = pack8(S, 0); Pf[c][1] = pack8(S, 1);
            }
#pragma unroll
            for (int s = 0; s < 2; ++s) {
                __builtin_amdgcn_sched_barrier(0);
#pragma unroll
                for (int e = 0; e < 4; ++e) {
                    const LAS unsigned char* vb = Vl + (32 * e + l31) * AV_PITCH + (32 * u + 16 * s + 4 * hh) * 2;
                    const s16x4 lo = *(const LAS s16x4*)vb, hi = *(const LAS s16x4*)(vb + 16);
                    const bf16x8 A = __builtin_shufflevector(lo, hi, 0, 1, 2, 3, 4, 5, 6, 7);
                    O[0][e] = MFMA32(A, Pf[0][s], O[0][e]); O[1][e] = MFMA32(A, Pf[1][s], O[1][e]);
                }
            }
            __builtin_amdgcn_sched_barrier(0);
        }
    }
    const float l0 = lsum[0] + __shfl_xor(lsum[0], 32), l1 = lsum[1] + __shfl_xor(lsum[1], 32);
    const float i0 = 1.f / l0, i1 = lam / l1;
    float ss = 0.f;
#pragma unroll
    for (int e = 0; e < 4; ++e)
#pragma unroll
        for (int i = 0; i < 16; ++i) { const float o = O[0][e][i] * i0 - O[1][e][i] * i1; O[0][e][i] = o; ss += o * o; }
    ss += __shfl_xor(ss, 32);
    const float rstd = rsqrtf(ss * (1.f / 128.f) + EPS) * (1.f - lam_init);
    const float* og = F.inp(16) + L * 128;
    bf16_t* dst = Yb + ((size_t)b * TT + tq) * 512 + hd * 128;
#pragma unroll
    for (int e = 0; e < 4; ++e)
#pragma unroll
        for (int g = 0; g < 4; ++g) { const int e0 = 32 * e + 8 * g + 4 * hh; const f32x4 gv = *(const f32x4*)(og + e0);
            u32x2 w; w.x = pack2(O[0][e][4 * g] * rstd * gv[0], O[0][e][4 * g + 1] * rstd * gv[1]); w.y = pack2(O[0][e][4 * g + 2] * rstd * gv[2], O[0][e][4 * g + 3] * rstd * gv[3]);
            *(u32x2*)(dst + e0) = w; }
}

__global__ void __launch_bounds__(NT) mk_fwd(Params p) {
    extern __shared__ __attribute__((aligned(16))) unsigned char lds_raw[];
    LAS unsigned char* lds = (LAS unsigned char*)lds_raw;
    cg::grid_group grid = cg::this_grid();
    LAS int* tb = (LAS int*)(lds + LDS_MISC);
    LAS unsigned long long* itab = (LAS unsigned long long*)(lds + LDS_MISC + 256);
    LAS unsigned* scal = (LAS unsigned*)(lds + LDS_MISC + 512);
    if (threadIdx.x < 28) itab[threadIdx.x] = (unsigned long long)p.in[threadIdx.x];
    if (threadIdx.x == 0) { const unsigned long long w = (unsigned long long)p.ws, o = (unsigned long long)p.out;
        scal[0] = (unsigned)w; scal[1] = (unsigned)(w >> 32); scal[2] = (unsigned)o; scal[3] = (unsigned)(o >> 32); scal[4] = gridDim.x; scal[5] = blockIdx.x; }
    __syncthreads();
    for (int ph = p.ph_lo; ph < p.ph_hi; ++ph) {
        int tid_ = threadIdx.x; asm volatile("" : "+v"(tid_));
        const unsigned w0 = __builtin_amdgcn_readfirstlane(scal[0]), w1 = __builtin_amdgcn_readfirstlane(scal[1]), o0 = __builtin_amdgcn_readfirstlane(scal[2]), o1 = __builtin_amdgcn_readfirstlane(scal[3]);
        unsigned char* ws_ = (unsigned char*)(((unsigned long long)w1 << 32) | w0); float* out_ = (float*)(((unsigned long long)o1 << 32) | o0);
        const int G = __builtin_amdgcn_readfirstlane(scal[4]), bid = __builtin_amdgcn_readfirstlane(scal[5]);
        Frame F; F.itab = itab; F.out = out_; F.ws = ws_; F.tid = tid_; F.lane = tid_ & 63; F.wave = __builtin_amdgcn_readfirstlane(tid_ >> 6); F.G = G; F.bid = bid;
        if (ph == 0) phase0(F, lds);
        else if (ph == 23) final_phase(F);
        else {
            const int L = (ph - 1) / 11, k = (ph - 1) % 11;
            bf16_t* wb = F.wb(L);
            if (k == 0) norm_phase(F, L, 1);
            else if (k == 1) {
                pg8::Gemm g{F.h(), wb + W_IN, 1024}; pg8::StaticOrder S{72, 18, G, bid};
                pg8::EpiSlots E{F.slot(0), {0, 1, 2, 3, 4, 5, 6, 7, 8}};
                pg8::gemm_phase(lds, g, S, E, F.tid);
            } else if (k == 2) {
                for (int it = bid; it < 288; it += G) attn_prep_item(F, L, it / 36, it % 36, lds);
                for (int it = bid; it < NB * NLC; it += G) lru_chunk(F, L, it / NLC, it % NLC, 0, lds);
            } else if (k == 3) {
                for (int it = bid; it < 256; it += G) gdn_item(F, L, it >> 5, (it >> 3) & 3, (it >> 2) & 1, it & 3, lds);
                { const float* lv = F.inp(15) + L * 256; float s01 = 0.f, s23 = 0.f;
                  for (int i = 0; i < 64; ++i) { s01 += lv[i] * lv[64 + i]; s23 += lv[128 + i] * lv[192 + i]; }
                  const float lam_init = 0.8f - 0.6f * expf(-0.3f * (float)L);
                  const float lam = expf(s01) - expf(s23) + lam_init;
                  float mq = 0.f, mk = 0.f;
                  for (int i = 0; i < 64; ++i) { mq = fmaxf(mq, fabsf(F.inp(13)[L * 64 + i])); mk = fmaxf(mk, fabsf(F.inp(14)[L * 64 + i])); }
                  const float bound2 = 8.f * mq * mk * 1.4426950408889634f;
                  const int nat = L == 0 ? 288 : 256;
                  for (int it = bid; it < nat; it += G) { if (it < 256) attn_item(F, L, it >> 5, (it >> 3) & 3, it & 7, lam, lam_init, bound2, lds);
                      else attn_item(F, L, (it - 256) >> 2, (it - 256) & 3, 8, lam, lam_init, bound2, lds); } }
                for (int it = bid; it < NB * NLC; it += G) lru_chunk(F, L, it / NLC, it % NLC, 1, lds);
            } else if (k == 4) {
                gdn_post(F, L);
                pg8::Gemm g{F.h(), wb + W_IN + (size_t)4608 * 1024, 1024}; pg8::StaticOrder S{72, 12, G, bid};
                pg8::EpiSlots E{F.slot(0), {0, 1, 2, 9, 10, 11, 0, 0, 0}};
                pg8::gemm_phase(lds, g, S, E, F.tid);
            } else if (k == 5) {
                pg8::Gemm g{F.slot(4), wb + W_BR, 512}; pg8::MergeOrder S{G, bid};
                pg8::EpiMerge E{F.h(), F.slot(0)};
                pg8::gemm_phase(lds, g, S, E, F.tid);
            } else if (k == 6) {
                pg8::Gemm g{F.h(), wb + W_OUT, 1024}; pg8::StaticOrder S{72, 4, G, bid};
                pg8::EpiResid E{F.xs(), F.mod(L, 0)};
                pg8::gemm_phase(lds, g, S, E, F.tid);
            } else if (k == 7) norm_phase(F, L, 2);
            else if (k == 8) sort_phase(F, L, tb);
            else if (k == 9) {
                moe_tile_bases(F, L, tb);
                pg8::Gemm g{F.slot(0), wb + W_GU, 1024}; pg8::MoeOrder S{tb, G, bid};
                pg8::EpiMoe1 E{F.slot(5)};
                pg8::gemm_phase(lds, g, S, E, F.tid);
            } else {
                moe_tile_bases(F, L, tb);
                pg8::Gemm g{F.slot(5), wb + W_DN, 512}; pg8::MoeOrder S{tb, G, bid};
                pg8::EpiMoe2 E{F.slot(8)};
                pg8::gemm_phase(lds, g, S, E, F.tid);
            }
        }
        if (ph + 1 < p.ph_hi) grid.sync();
    }
}

extern "C" void kernel_launch(void* const* d_in, const int* in_sizes, int n_in, void* d_out, int out_size, void* d_ws, size_t ws_size, hipStream_t stream) {
    static int grid = 0;
    if (grid == 0) {
        if (n_in != 28 || out_size != NB * SEQ * DM || ws_size < WS_END) { fprintf(stderr, "kernel_launch: unexpected shapes (n_in %d out %d ws %zu need %zu)\n", n_in, out_size, ws_size, (size_t)WS_END); grid = -1; return; }
        int dev = 0, cus = 0, per_cu = 0;
        hipGetDevice(&dev); hipDeviceGetAttribute(&cus, hipDeviceAttributeMultiprocessorCount, dev);
        hipFuncSetAttribute((const void*)mk_fwd, hipFuncAttributeMaxDynamicSharedMemorySize, LDS_BYTES);
        hipOccupancyMaxActiveBlocksPerMultiprocessor(&per_cu, (const void*)mk_fwd, NT, LDS_BYTES);
        if (per_cu < 1) { fprintf(stderr, "kernel_launch: occupancy query says %d blocks per CU\n", per_cu); per_cu = 1; }
        grid = cus;
        (void)hipGetLastError();
    }
    if (grid < 0) return;
    hipMemsetAsync((char*)d_ws + WS_CTL, 0, ZERO_BYTES, stream);
    Params p{};
    for (int i = 0; i < 28; ++i) p.in[i] = (const float*)d_in[i];
    p.out = (float*)d_out; p.ws = (unsigned char*)d_ws;
#if defined(MK_PER_PHASE)
    for (int ph = 0; ph < 24; ++ph) { p.ph_lo = ph; p.ph_hi = ph + 1; hipLaunchKernelGGL(mk_fwd, dim3(grid), dim3(NT), LDS_BYTES, stream, p); }
#else
    p.ph_lo = 0; p.ph_hi = 24;
    void* args[] = {&p};
    hipError_t e = hipLaunchCooperativeKernel((const void*)mk_fwd, dim3(grid), dim3(NT), args, LDS_BYTES, stream);
    if (e != hipSuccess) fprintf(stderr, "cooperative launch failed: %s (grid %d)\n", hipGetErrorString(e), grid);
#endif
}
```

```cpp
#include <hip/hip_runtime.h>
#include <hip/hip_cooperative_groups.h>
#include <cstdio>
namespace cg = cooperative_groups;

#define DI __device__ __forceinline__
#define LAS __attribute__((address_space(3)))
typedef unsigned short bf16_t;
typedef short bf16x8 __attribute__((ext_vector_type(8)));
typedef short s16x4 __attribute__((ext_vector_type(4)));
typedef float f32x4 __attribute__((ext_vector_type(4)));
typedef float f32x16 __attribute__((ext_vector_type(16)));
typedef unsigned u32x4 __attribute__((ext_vector_type(4)));
typedef unsigned u32x2 __attribute__((ext_vector_type(2)));

constexpr int NB = 8, SEQ = 2048, CTX = 256, TT = 2304, DM = 1024, MROWS = NB * TT, NLAYER = 2;
constexpr int PW = 7696;
constexpr int NT = 512;
constexpr float EPS = 1e-6f;
constexpr size_t SLOT_ELEMS = (size_t)MROWS * 512;
constexpr int MPAD = 40960;
constexpr int NLC = 72;

constexpr size_t W_IN = 0, W_BR = W_IN + (size_t)7680 * 1024, W_OUT = W_BR + (size_t)3 * 1024 * 512, W_GU = W_OUT + (size_t)1024 * 1024,
                 W_DN = W_GU + (size_t)16 * 1024 * 1024, W_LAYER = W_DN + (size_t)16 * 1024 * 512;

constexpr size_t WS_CTL = 0;
constexpr size_t WS_MOD = 65536;
constexpr size_t ZERO_BYTES = WS_MOD + (size_t)2 * 9 * 6144 * 4;
constexpr size_t WS_WSM = 524288;
constexpr size_t WS_WRT = WS_WSM + (size_t)2 * 16 * 1024 * 4;
constexpr size_t WS_BA = WS_WRT + (size_t)16 * 1024 * 4;
constexpr size_t WS_LRS = WS_BA + (size_t)MROWS * 16 * 4;
constexpr size_t WS_ROUTE = WS_LRS + (size_t)NB * 2 * NLC * 512 * 2 * 4;
constexpr size_t WS_WB = WS_ROUTE + (size_t)MROWS * 8 * 4;
constexpr size_t WS_XS = WS_WB + (size_t)2 * W_LAYER * 2;
constexpr size_t WS_H = WS_XS + (size_t)MROWS * 1024 * 4;
constexpr size_t WS_SLOT = WS_H + (size_t)MROWS * 1024 * 2;
constexpr size_t WS_END = WS_SLOT + (size_t)14 * SLOT_ELEMS * 2;

struct Params {
    const float* in[28];
    float* out;
    unsigned char* ws;
    int ph_lo, ph_hi;
};

struct Frame {
    const LAS unsigned long long* itab;
    float* out;
    unsigned char* ws;
    int tid, lane, wave, G, bid;
    DI const float* inp(int i) const { const unsigned long long v = itab[i];
        const unsigned lo = __builtin_amdgcn_readfirstlane((unsigned)v), hi = __builtin_amdgcn_readfirstlane((unsigned)(v >> 32));
        return (const float*)(((unsigned long long)hi << 32) | lo); }
    DI bf16_t* slot(int s) const { return (bf16_t*)(ws + WS_SLOT) + (size_t)s * SLOT_ELEMS; }
    DI bf16_t* wb(int L) const { return (bf16_t*)(ws + WS_WB) + (size_t)L * W_LAYER; }
    DI float* mod(int L, int mi) const { return (float*)(ws + WS_MOD) + (size_t)(L * 9 + mi) * 6144; }
    DI float* xs() const { return (float*)(ws + WS_XS); }
    DI bf16_t* h() const { return (bf16_t*)(ws + WS_H); }
    DI unsigned* ctl() const { return (unsigned*)(ws + WS_CTL); }
    DI unsigned* route() const { return (unsigned*)(ws + WS_ROUTE); }
};

DI float bf2f(bf16_t b) { return __uint_as_float(((unsigned)b) << 16); }
DI bf16_t f2bf(float f) { return __builtin_bit_cast(unsigned short, (__bf16)f); }
DI unsigned pack2(float a, float b) { typedef __bf16 v2 __attribute__((ext_vector_type(2))); v2 v; v[0] = (__bf16)a; v[1] = (__bf16)b; return __builtin_bit_cast(unsigned, v); }
DI float sigmoid_f(float x) { return 1.f / (1.f + __expf(-x)); }
DI float silu_f(float x) { return x / (1.f + __expf(-x)); }
DI float softplus_f(float x) { return fmaxf(x, 0.f) + log1pf(__expf(-fabsf(x))); }
DI float gelu_tanh_f(float x) { const float u = 0.7978845608028654f * (x + 0.044715f * x * x * x); return 0.5f * x * (1.f + tanhf(u)); }
DI float wave_sum(float v) {
#pragma unroll
    for (int o = 32; o >= 1; o >>= 1) v += __shfl_xor(v, o);
    return v;
}
DI int modidx(int r) { const int b = r / TT, t = r - b * TT; return t < CTX ? 8 : b; }
namespace pg8 {
constexpr int BM = 256, BK = 64, HALF = 128, HTB = HALF * BK * 2  , STAGE_BYTES = 8 * HTB, NXCD = 8, WGM = 8;

__host__ __device__ __forceinline__ int lds_byte(int r, int c) { const int st = (r >> 4) * 2 + (c >> 5), rr = r & 15, cc = c & 31, ob = rr * 64 + cc * 2; return st * 1024 + (ob ^ (((ob >> 9) & 1) << 5)); }
__host__ __device__ __forceinline__ void stage_rc(int b, int& R, int& C) { const int st = b / 1024, sb = b % 1024, swz = sb ^ (((sb >> 9) & 1) << 5); R = (st >> 1) * 16 + swz / 64; C = (st & 1) * 32 + (swz % 64) / 2; }
__host__ __device__ __forceinline__ int perm32(int rho) { const int n = rho >> 4, i = rho & 15; return 8 * (i >> 2) + 4 * n + (i & 3); }

struct Unit { int pm, pn; };
struct Gemm { const bf16_t* A; const bf16_t* Bt; int K; };

DI bool grid_unit(int nM, int nN, long L, Unit& u) {
    const int nwg = nM * nN; if (L >= nwg) return false;
    int wgid = (int)L; { const int q = nwg / NXCD, r = nwg % NXCD, xcd = wgid % NXCD, off = wgid / NXCD; wgid = (xcd < r ? xcd * (q + 1) : r * (q + 1) + (xcd - r) * q) + off; }
    const int nig = WGM * nN, gid = wgid / nig, fm = gid * WGM, gsz = (nM - fm) < WGM ? (nM - fm) : WGM;
    u.pm = fm + ((wgid % nig) % gsz); u.pn = (wgid % nig) / gsz; return true;
}
struct StaticOrder {
    int nM, nN, G, c;
    DI bool next(int i, Unit& u) const { return grid_unit(nM, nN, (long)i * G + c, u); }
};
struct MergeOrder {
    int G, c;
    DI bool next(int i, Unit& u) const {
        const int n = i % 3; Unit t; if (!grid_unit(72, 4, (long)(i / 3) * G + c, t)) return false;
        u.pm = n * 72 + t.pm; u.pn = n * 4 + t.pn; return true;
    }
};
struct MoeOrder {
    const LAS int* tb; int G, c;
    DI bool next(int i, Unit& u) const {
        const long L = (long)i * G + c; const int total = __builtin_amdgcn_readfirstlane(tb[16]) * 4; if (L >= total) return false;
        const int pm = (int)(L >> 2), j = (int)(L & 3); int e = 0;
#pragma unroll
        for (int q = 1; q < 16; ++q) e += (pm >= __builtin_amdgcn_readfirstlane(tb[q])) ? 1 : 0;
        u.pm = pm; u.pn = e * 4 + j; return true;
    }
};

typedef const f32x4 (&AccRef)[2][2][4][2];

struct EpiSlots {
    static constexpr bool PERM = true;
    bf16_t* base; int smap[9];
    DI void operator()(AccRef acc, const Unit& u, int wr, int wc, int fr, int fq) const {
        int sl = 0;
#pragma unroll
        for (int q = 0; q < 9; ++q) sl = ((u.pn >> 1) == q) ? smap[q] : sl;
        bf16_t* O = base + (size_t)sl * SLOT_ELEMS;
        const int row0 = u.pm * BM + wr * 64 + fr, col0 = (u.pn & 1) * 256 + wc * 32 + 8 * fq;
#pragma unroll
        for (int ai = 0; ai < 2; ++ai)
#pragma unroll
            for (int m = 0; m < 4; ++m) { bf16_t* rowp = O + (size_t)(row0 + ai * HALF + m * 16) * 512 + col0;
#pragma unroll
                for (int bj = 0; bj < 2; ++bj) { const f32x4 v0 = acc[ai][bj][m][0], v1 = acc[ai][bj][m][1];
                    u32x4 w; w.x = pack2(v0[0], v0[1]); w.y = pack2(v0[2], v0[3]); w.z = pack2(v1[0], v1[1]); w.w = pack2(v1[2], v1[3]);
                    *(u32x4*)(rowp + bj * HALF) = w; } }
    }
};
struct EpiMerge {
    static constexpr bool PERM = true;
    bf16_t* merged; const bf16_t* slots;
    DI void operator()(AccRef acc, const Unit& u, int wr, int wc, int fr, int fq) const {
        const int n = u.pm / 72, pm = u.pm - n * 72, pn = u.pn & 3;
        const int row0 = pm * BM + wr * 64 + fr, col0 = pn * 256 + wc * 32 + 8 * fq;
        const int j = 2 * n + (col0 >> 9);
        const int gs = j < 3 ? j : j + 6;
        const bf16_t* G = slots + (size_t)gs * SLOT_ELEMS;
        const int gcol0 = col0 & 511;
#pragma unroll
        for (int ai = 0; ai < 2; ++ai)
#pragma unroll
            for (int m = 0; m < 4; ++m) { const size_t row = (size_t)(row0 + ai * HALF + m * 16);
#pragma unroll
                for (int bj = 0; bj < 2; ++bj) {
                    const u32x4 gw = *(const u32x4*)(G + row * 512 + gcol0 + bj * HALF);
                    bf16_t* mp = merged + row * 1024 + col0 + bj * HALF;
                    float v[8];
#pragma unroll
                    for (int q = 0; q < 4; ++q) { v[q] = acc[ai][bj][m][0][q]; v[4 + q] = acc[ai][bj][m][1][q]; }
                    const unsigned gg[4] = {gw.x, gw.y, gw.z, gw.w};
#pragma unroll
                    for (int q = 0; q < 4; ++q) { v[2 * q] *= sigmoid_f(__uint_as_float(gg[q] << 16)); v[2 * q + 1] *= sigmoid_f(__uint_as_float(gg[q] & 0xffff0000u)); }
                    if (n > 0) { const u32x4 ow = *(const u32x4*)mp; const unsigned oo[4] = {ow.x, ow.y, ow.z, ow.w};
#pragma unroll
                        for (int q = 0; q < 4; ++q) { v[2 * q] += __uint_as_float(oo[q] << 16); v[2 * q + 1] += __uint_as_float(oo[q] & 0xffff0000u); } }
                    u32x4 w; w.x = pack2(v[0], v[1]); w.y = pack2(v[2], v[3]); w.z = pack2(v[4], v[5]); w.w = pack2(v[6], v[7]);
                    *(u32x4*)mp = w; } }
    }
};
struct EpiResid {
    static constexpr bool PERM = false;
    float* xs; const float* modL;
    DI void operator()(AccRef acc, const Unit& u, int wr, int wc, int fr, int fq) const {
        const int row0 = u.pm * BM + wr * 64 + fr, col0 = u.pn * BM + wc * 32 + 4 * fq;
#pragma unroll
        for (int ai = 0; ai < 2; ++ai)
#pragma unroll
            for (int m = 0; m < 4; ++m) { const int row = row0 + ai * HALF + m * 16; float* rowp = xs + (size_t)row * 1024 + col0;
                const float* g = modL + (size_t)modidx(row) * 6144 + 2048 + col0;
#pragma unroll
                for (int bj = 0; bj < 2; ++bj)
#pragma unroll
                    for (int n = 0; n < 2; ++n) { const f32x4 gv = *(const f32x4*)(g + bj * HALF + n * 16); f32x4 x = *(f32x4*)(rowp + bj * HALF + n * 16);
                        x += gv * acc[ai][bj][m][n]; *(f32x4*)(rowp + bj * HALF + n * 16) = x; } }
    }
};
struct EpiMoe1 {
    static constexpr bool PERM = true;
    bf16_t* act;
    DI void operator()(AccRef acc, const Unit& u, int wr, int wc, int fr, int fq) const {
        const int row0 = u.pm * BM + wr * 64 + fr, col0 = (u.pn & 3) * 128 + wc * 32 + 8 * fq;
#pragma unroll
        for (int ai = 0; ai < 2; ++ai)
#pragma unroll
            for (int m = 0; m < 4; ++m) { bf16_t* rowp = act + (size_t)(row0 + ai * HALF + m * 16) * 512 + col0;
                float v[8];
#pragma unroll
                for (int q = 0; q < 4; ++q) { v[q] = silu_f(acc[ai][0][m][0][q]) * acc[ai][1][m][0][q]; v[4 + q] = silu_f(acc[ai][0][m][1][q]) * acc[ai][1][m][1][q]; }
                u32x4 w; w.x = pack2(v[0], v[1]); w.y = pack2(v[2], v[3]); w.z = pack2(v[4], v[5]); w.w = pack2(v[6], v[7]);
                *(u32x4*)rowp = w; }
    }
};
struct EpiMoe2 {
    static constexpr bool PERM = true;
    bf16_t* ys;
    DI void operator()(AccRef acc, const Unit& u, int wr, int wc, int fr, int fq) const {
        const int row0 = u.pm * BM + wr * 64 + fr, col0 = (u.pn & 3) * 256 + wc * 32 + 8 * fq;
#pragma unroll
        for (int ai = 0; ai < 2; ++ai)
#pragma unroll
            for (int m = 0; m < 4; ++m) { bf16_t* rowp = ys + (size_t)(row0 + ai * HALF + m * 16) * 1024 + col0;
#pragma unroll
                for (int bj = 0; bj < 2; ++bj) { const f32x4 v0 = acc[ai][bj][m][0], v1 = acc[ai][bj][m][1];
                    u32x4 w; w.x = pack2(v0[0], v0[1]); w.y = pack2(v0[2], v0[3]); w.z = pack2(v1[0], v1[1]); w.w = pack2(v1[2], v1[3]);
                    *(u32x4*)(rowp + bj * HALF) = w; } }
    }
};

template <class Epi, class Sched>
DI void gemm_phase(LAS unsigned char* lds, const Gemm g, const Sched& S, const Epi& E, const int tid) {
    const int wid = __builtin_amdgcn_readfirstlane(tid >> 6), lane = tid & 63, wr = wid >> 2, wc = wid & 3, fr = lane & 15, fq = lane >> 4;
    const int K = g.K, nt = K / BK;
    unsigned voffA[2], voffB[2];
#pragma unroll
    for (int i = 0; i < 2; ++i) { int R, C; stage_rc(tid * 16 + i * 8192, R, C); const int Rb = Epi::PERM ? ((R & ~31) + perm32(R & 31)) : R;
        voffA[i] = (unsigned)(R * K + C) * 2u; voffB[i] = (unsigned)(Rb * K + C) * 2u; }
    const size_t kstep = (size_t)(BK * 2);
    const size_t hstep = (size_t)HALF * K * 2;
    const size_t tstep = 2 * hstep;
    const unsigned ldsw = (unsigned)wid * 1024u;
    const int aoff = lds_byte(wr * 64 + fr, fq * 8), boff = lds_byte(wc * 32 + fr, fq * 8);
#define PG8_SA(b, h) (((b) * 2 + (h)) * HTB)
#define PG8_SB(b, h) ((4 + (b) * 2 + (h)) * HTB)
#define PG8_STAGE(bufoff, gbase, voff) do { _Pragma("unroll") for (int _i = 0; _i < 2; ++_i) \
        __builtin_amdgcn_global_load_lds((const unsigned*)((const char*)(gbase) + (voff)[_i]), (LAS unsigned*)(lds + (bufoff) + ldsw + _i * 8192), 16, 0, 0); } while (0)
#define PG8_LDA(dst, b, h) do { _Pragma("unroll") for (int m = 0; m < 4; ++m) _Pragma("unroll") for (int k = 0; k < 2; ++k) dst[m][k] = *(const LAS bf16x8*)(lds + PG8_SA(b, h) + aoff + m * 2048 + k * 1024); } while (0)
#define PG8_LDB(dst, b, h) do { _Pragma("unroll") for (int n = 0; n < 2; ++n) _Pragma("unroll") for (int k = 0; k < 2; ++k) dst[n][k] = *(const LAS bf16x8*)(lds + PG8_SB(b, h) + boff + n * 2048 + k * 1024); } while (0)
#define PG8_MMA(ai, bj, At, Bt) do { __builtin_amdgcn_s_setprio(1); _Pragma("unroll") for (int m = 0; m < 4; ++m) _Pragma("unroll") for (int n = 0; n < 2; ++n) _Pragma("unroll") for (int k = 0; k < 2; ++k) \
        acc[ai][bj][m][n] = __builtin_amdgcn_mfma_f32_16x16x32_bf16(Bt[n][k], At[m][k], acc[ai][bj][m][n], 0, 0, 0); __builtin_amdgcn_s_setprio(0); } while (0)
#define PG8_WAIT_V(n) asm volatile("s_waitcnt vmcnt(" #n ")" ::: "memory")
#define PG8_WAIT_L(n) asm volatile("s_waitcnt lgkmcnt(" #n ")" ::: "memory")
#define PG8_BAR __builtin_amdgcn_s_barrier()
#define PG8_SCHED __builtin_amdgcn_sched_barrier(0)
    Unit cur, nxt; int ui = 0;
    if (!S.next(0, cur)) return;
    f32x4 acc[2][2][4][2];
#pragma unroll
    for (int a = 0; a < 2; ++a)
#pragma unroll
        for (int b = 0; b < 2; ++b)
#pragma unroll
            for (int m = 0; m < 4; ++m)
#pragma unroll
                for (int n = 0; n < 2; ++n) acc[a][b][m][n] = (f32x4){0.f, 0.f, 0.f, 0.f};
    bf16x8 At[4][2], B0[2][2], B1[2][2];
    const char* cA = (const char*)g.A + (size_t)cur.pm * tstep; const char* cB = (const char*)g.Bt + (size_t)cur.pn * tstep;
    PG8_STAGE(PG8_SB(0, 0), cB, voffB); PG8_STAGE(PG8_SA(0, 0), cA, voffA); PG8_STAGE(PG8_SB(0, 1), cB + hstep, voffB); PG8_STAGE(PG8_SA(0, 1), cA + hstep, voffA);
    if (wr == 1) PG8_BAR;
    PG8_WAIT_V(4); PG8_BAR;
    PG8_STAGE(PG8_SB(1, 0), cB + kstep, voffB); PG8_STAGE(PG8_SA(1, 0), cA + kstep, voffA); PG8_STAGE(PG8_SB(1, 1), cB + hstep + kstep, voffB);
    PG8_WAIT_V(6); PG8_BAR;
    for (;;) {
        const bool has_next = S.next(ui + 1, nxt);
        const char* nA = has_next ? (const char*)g.A + (size_t)nxt.pm * tstep : cA; const char* nB = has_next ? (const char*)g.Bt + (size_t)nxt.pn * tstep : cB;
        for (int t = 0; t < nt; t += 2) {
            const bool last = (t == nt - 2);
            const char* a1 = cA + (size_t)(t + 1) * kstep;
            const char* a2 = last ? nA : cA + (size_t)(t + 2) * kstep; const char* b2 = last ? nB : cB + (size_t)(t + 2) * kstep;
            const char* a3 = a2 + kstep; const char* b3 = b2 + kstep;
            PG8_LDB(B0, 0, 0); PG8_SCHED; PG8_LDA(At, 0, 0); PG8_STAGE(PG8_SA(1, 1), a1 + hstep, voffA);
            PG8_WAIT_L(8); PG8_BAR; PG8_WAIT_L(0); PG8_MMA(0, 0, At, B0); PG8_BAR; PG8_SCHED;
            PG8_LDB(B1, 0, 1); PG8_STAGE(PG8_SB(0, 0), b2, voffB);
            PG8_BAR; PG8_WAIT_L(0); PG8_MMA(0, 1, At, B1); PG8_BAR;
            PG8_LDA(At, 0, 1); PG8_STAGE(PG8_SA(0, 0), a2, voffA);
            PG8_BAR; PG8_WAIT_L(0); PG8_MMA(1, 0, At, B0); PG8_BAR; PG8_SCHED;
            PG8_STAGE(PG8_SB(0, 1), b2 + hstep, voffB);
            PG8_WAIT_V(6); PG8_BAR; PG8_MMA(1, 1, At, B1); PG8_BAR;
            PG8_LDB(B0, 1, 0); PG8_SCHED; PG8_LDA(At, 1, 0); PG8_STAGE(PG8_SA(0, 1), a2 + hstep, voffA);
            PG8_WAIT_L(8); PG8_BAR; PG8_WAIT_L(0); PG8_MMA(0, 0, At, B0); PG8_BAR; PG8_SCHED;
            PG8_LDB(B1, 1, 1); PG8_STAGE(PG8_SB(1, 0), b3, voffB);
            PG8_BAR; PG8_WAIT_L(0); PG8_MMA(0, 1, At, B1); PG8_BAR;
            PG8_LDA(At, 1, 1); PG8_STAGE(PG8_SA(1, 0), a3, voffA);
            PG8_BAR; PG8_WAIT_L(0); PG8_MMA(1, 0, At, B0); PG8_BAR; PG8_SCHED;
            PG8_STAGE(PG8_SB(1, 1), b3 + hstep, voffB);
            PG8_WAIT_V(6); PG8_BAR; PG8_MMA(1, 1, At, B1); PG8_BAR;
        }
        E(acc, cur, wr, wc, fr, fq);
        if (!has_next) break;
#pragma unroll
        for (int a = 0; a < 2; ++a)
#pragma unroll
            for (int b = 0; b < 2; ++b)
#pragma unroll
                for (int m = 0; m < 4; ++m)
#pragma unroll
                    for (int n = 0; n < 2; ++n) acc[a][b][m][n] = (f32x4){0.f, 0.f, 0.f, 0.f};
        cur = nxt; cA = nA; cB = nB; ++ui;
    }
    PG8_WAIT_V(0);
    if (wr == 0) PG8_BAR;
    PG8_BAR;
#undef PG8_SA
#undef PG8_SB
#undef PG8_STAGE
#undef PG8_LDA
#undef PG8_LDB
#undef PG8_MMA
#undef PG8_WAIT_V
#undef PG8_WAIT_L
#undef PG8_BAR
#undef PG8_SCHED
}
}
constexpr int LDS_BYTES = 139264;
constexpr int LDS_MISC = 131072;

DI void tr_tile(const Frame& F, const float* src, int ld, int k0, int c0, bf16_t* dst, int K, int n0, LAS float* tile) {
    const int kr = F.tid >> 4, c4 = (F.tid & 15) * 4;
#pragma unroll
    for (int ps = 0; ps < 2; ++ps) { const int k = kr + 32 * ps; const f32x4 v = *(const f32x4*)(src + (size_t)(k0 + k) * ld + c0 + c4);
        tile[k * 65 + c4] = v[0]; tile[k * 65 + c4 + 1] = v[1]; tile[k * 65 + c4 + 2] = v[2]; tile[k * 65 + c4 + 3] = v[3]; }
    __syncthreads();
    const int n = F.tid >> 3, kc = (F.tid & 7) * 8;
    float v[8];
#pragma unroll
    for (int i = 0; i < 8; ++i) v[i] = tile[(kc + i) * 65 + n];
    u32x4 w; w.x = pack2(v[0], v[1]); w.y = pack2(v[2], v[3]); w.z = pack2(v[4], v[5]); w.w = pack2(v[6], v[7]);
    *(u32x4*)(dst + (size_t)(n0 + n) * K + k0 + kc) = w;
    __syncthreads();
}

DI void phase0(const Frame& F, LAS unsigned char* lds) {
    const int G = F.G, bid = F.bid;
    { float* wsm = (float*)(F.ws + WS_WSM); float* wrt = (float*)(F.ws + WS_WRT);
      for (int idx = bid * NT + F.tid; idx < 2 * 16 * 1024 + 16 * 1024; idx += G * NT) {
          if (idx < 2 * 16 * 1024) { const int L = idx >> 14, j = (idx >> 10) & 15, k = idx & 1023; wsm[idx] = F.inp(8)[((size_t)L * 1024 + k) * PW + 2048 + j]; }
          else { const int q = idx - 2 * 16 * 1024, j = q >> 10, k = q & 1023; wrt[q] = F.inp(24)[k * 16 + j]; } } }
    { LAS float* sil = (LAS float*)lds; LAS float* red = sil + 9 * 1024;
      for (int it = bid; it < 96; it += G) {
          const int L = it / 48, cb = it % 48;
          __syncthreads();
          for (int i = F.tid; i < 9 * 1024; i += NT) { const int r = i >> 10, k = i & 1023; const float c = r < 8 ? F.inp(1)[r * 1024 + k] : F.inp(3)[k]; sil[i] = silu_f(c); }
          __syncthreads();
          const int cl = F.tid & 127, kq = F.tid >> 7, col = cb * 128 + cl; const float* wm = F.inp(4) + (size_t)L * 1024 * 6144 + (size_t)(kq * 256) * 6144 + col;
          float acc[9];
#pragma unroll
          for (int r = 0; r < 9; ++r) acc[r] = 0.f;
          for (int k = 0; k < 256; ++k) { const float w = wm[(size_t)k * 6144];
#pragma unroll
              for (int r = 0; r < 9; ++r) acc[r] += sil[r * 1024 + kq * 256 + k] * w; }
#pragma unroll
          for (int r = 0; r < 9; ++r) red[(kq * 9 + r) * 128 + cl] = acc[r];
          __syncthreads();
          if (kq == 0) { const float bias = F.inp(5)[L * 6144 + col];
#pragma unroll
              for (int r = 0; r < 9; ++r) F.mod(L, r)[col] = ((red[(0 * 9 + r) * 128 + cl] + red[(1 * 9 + r) * 128 + cl]) + (red[(2 * 9 + r) * 128 + cl] + red[(3 * 9 + r) * 128 + cl])) + bias; }
      }
      __syncthreads(); }
    { LAS float* tile = (LAS float*)lds;
      for (int it = bid; it < 17408; it += G) {
          const int L = it / 8704; int q = it % 8704; bf16_t* wb = F.wb(L);
          if (q < 1920) { const int kt = q / 120, nt = q % 120, n0 = nt * 64, c0 = n0 < 2048 ? n0 : n0 + 16;
              tr_tile(F, F.inp(8) + (size_t)L * 1024 * PW, PW, kt * 64, c0, wb + W_IN, 1024, n0, tile); continue; }
          q -= 1920;
          if (q < 384) { const int br = q >> 7, r = q & 127, kt = r >> 4, nt = r & 15;
              tr_tile(F, F.inp(22) + (size_t)(L * 3 + br) * 512 * 1024, 1024, kt * 64, nt * 64, wb + W_BR + (size_t)br * 1024 * 512, 512, nt * 64, tile); continue; }
          q -= 384;
          if (q < 256) { const int kt = q >> 4, nt = q & 15;
              tr_tile(F, F.inp(23) + (size_t)L * 1024 * 1024, 1024, kt * 64, nt * 64, wb + W_OUT, 1024, nt * 64, tile); continue; }
          q -= 256;
          if (q < 4096) { const int e = q >> 8, r = q & 255, kt = r >> 4, nt = r & 15, n0 = nt * 64, t256 = n0 >> 8, wi = n0 & 255;
              const int c0 = wi < 128 ? t256 * 128 + wi : 512 + t256 * 128 + (wi - 128);
              tr_tile(F, F.inp(26) + (size_t)(L * 16 + e) * 1024 * 1024, 1024, kt * 64, c0, wb + W_GU + (size_t)e * 1024 * 1024, 1024, n0, tile); continue; }
          q -= 4096;
          { const int e = q >> 7, r = q & 127, kt = r >> 4, nt = r & 15;
              tr_tile(F, F.inp(27) + (size_t)(L * 16 + e) * 512 * 1024, 1024, kt * 64, nt * 64, wb + W_DN + (size_t)e * 1024 * 512, 512, nt * 64, tile); }
      } }
}

DI void norm_phase(const Frame& F, int L, int which) {
    const int G = F.G;
    const float* gain = (which == 1 ? F.inp(6) : F.inp(7)) + L * 1024;
    const float* wsm = (const float*)(F.ws + WS_WSM) + (size_t)L * 16 * 1024;
    const float* wrt = (const float*)(F.ws + WS_WRT);
    float* xs = F.xs(); bf16_t* H = F.h(); unsigned* route = F.route();
    const bf16_t* ys = F.slot(8);
    for (int r = F.bid * 8 + F.wave; r < MROWS; r += G * 8) {
        const int b = r / TT, t = r - b * TT, mi = t < CTX ? 8 : b;
        f32x4 x[4];
        if (which == 1 && L == 0) {
            const float* src = t < CTX ? F.inp(2) + ((size_t)b * CTX + t) * 1024 : F.inp(0) + ((size_t)b * SEQ + (t - CTX)) * 1024;
#pragma unroll
            for (int i = 0; i < 4; ++i) x[i] = *(const f32x4*)(src + F.lane * 4 + 256 * i);
        } else {
#pragma unroll
            for (int i = 0; i < 4; ++i) x[i] = *(const f32x4*)(xs + (size_t)r * 1024 + F.lane * 4 + 256 * i);
        }
        if (which == 1 && L > 0) {
            const unsigned* rt = route + (size_t)r * 8;
            const float w0 = __uint_as_float(rt[2]), w1 = __uint_as_float(rt[3]); const int p0 = (int)rt[4], p1 = (int)rt[5];
            const float* m5 = F.mod(L - 1, mi) + 5 * 1024;
#pragma unroll
            for (int i = 0; i < 4; ++i) { const int c = F.lane * 4 + 256 * i;
                const u32x2 a = *(const u32x2*)(ys + (size_t)p0 * 1024 + c), bq = *(const u32x2*)(ys + (size_t)p1 * 1024 + c); const f32x4 g = *(const f32x4*)(m5 + c);
                x[i][0] += g[0] * (w0 * __uint_as_float(a.x << 16) + w1 * __uint_as_float(bq.x << 16));
                x[i][1] += g[1] * (w0 * __uint_as_float(a.x & 0xffff0000u) + w1 * __uint_as_float(bq.x & 0xffff0000u));
                x[i][2] += g[2] * (w0 * __uint_as_float(a.y << 16) + w1 * __uint_as_float(bq.y << 16));
                x[i][3] += g[3] * (w0 * __uint_as_float(a.y & 0xffff0000u) + w1 * __uint_as_float(bq.y & 0xffff0000u)); }
        }
        if (which == 1) {
#pragma unroll
            for (int i = 0; i < 4; ++i) *(f32x4*)(xs + (size_t)r * 1024 + F.lane * 4 + 256 * i) = x[i];
        }
        float ss = 0.f;
#pragma unroll
        for (int i = 0; i < 4; ++i) ss += x[i][0] * x[i][0] + x[i][1] * x[i][1] + x[i][2] * x[i][2] + x[i][3] * x[i][3];
        ss = wave_sum(ss);
        const float rstd = rsqrtf(ss * (1.f / 1024.f) + EPS);
        const float* mv = F.mod(L, mi) + (which == 1 ? 0 : 3 * 1024);
        f32x4 hh[4];
#pragma unroll
        for (int i = 0; i < 4; ++i) { const int c = F.lane * 4 + 256 * i; const f32x4 g = *(const f32x4*)(gain + c), sh = *(const f32x4*)(mv + c), sc = *(const f32x4*)(mv + 1024 + c);
#pragma unroll
            for (int q = 0; q < 4; ++q) hh[i][q] = (x[i][q] * rstd * g[q]) * (1.f + sc[q]) + sh[q];
            u32x2 w; w.x = pack2(hh[i][0], hh[i][1]); w.y = pack2(hh[i][2], hh[i][3]);
            *(u32x2*)(H + (size_t)r * 1024 + c) = w; }
        const float* sw = which == 1 ? wsm : wrt;
        float dv = 0.f;
#pragma unroll 1
        for (int j = 0; j < 16; ++j) { float a = 0.f;
#pragma unroll
            for (int i = 0; i < 4; ++i) { const f32x4 w = *(const f32x4*)(sw + j * 1024 + F.lane * 4 + 256 * i); a += hh[i][0] * w[0] + hh[i][1] * w[1] + hh[i][2] * w[2] + hh[i][3] * w[3]; }
            a = wave_sum(a); dv = (F.lane == j) ? a : dv; }
        if (which == 1) {
            float* ba = (float*)(F.ws + WS_BA) + (size_t)r * 16;
            if (F.lane < 16) ba[F.lane] = dv;
        } else {
            float p[16], mx = -3.0e38f;
#pragma unroll
            for (int j = 0; j < 16; ++j) { p[j] = __shfl(dv, j) + F.inp(25)[j]; mx = fmaxf(mx, p[j]); }
            float sum = 0.f;
#pragma unroll
            for (int j = 0; j < 16; ++j) { p[j] = __expf(p[j] - mx); sum += p[j]; }
            const float inv = 1.f / sum;
            float bs = -1.f, bp0 = 0.f, bp1 = 0.f; int be0 = 0, be1 = 1;
#pragma unroll
            for (int g = 0; g < 4; ++g) { float a = -1.f, c2 = -1.f; int ia = 0, ib = 0;
#pragma unroll
                for (int i = 0; i < 4; ++i) { const float v = p[g * 4 + i] * inv; if (v > a) { c2 = a; ib = ia; a = v; ia = i; } else if (v > c2) { c2 = v; ib = i; } }
                const float sc = a + c2; if (sc > bs) { bs = sc; bp0 = a; bp1 = c2; be0 = g * 4 + ia; be1 = g * 4 + ib; } }
            if (F.lane == 0) {
                unsigned* cnt = F.ctl() + L * 16;
                const int pos0 = (int)atomicAdd(cnt + be0, 1u), pos1 = (int)atomicAdd(cnt + be1, 1u);
                unsigned* rt = route + (size_t)r * 8; const float wsum = bp0 + bp1;
                rt[0] = (unsigned)be0; rt[1] = (unsigned)be1; rt[2] = __float_as_uint(bp0 / wsum); rt[3] = __float_as_uint(bp1 / wsum); rt[6] = (unsigned)pos0; rt[7] = (unsigned)pos1;
            }
        }
    }
}

DI void moe_tile_bases(const Frame& F, int L, LAS int* tb) {
    if (F.tid == 0) { const unsigned* cnt = F.ctl() + L * 16; int acc = 0;
        for (int e = 0; e < 16; ++e) { tb[e] = acc; acc += (int)((cnt[e] + 255u) >> 8); }
        tb[16] = acc; }
    __syncthreads();
}

DI void sort_phase(const Frame& F, int L, LAS int* tb) {
    moe_tile_bases(F, L, tb);
    const int G = F.G; const bf16_t* H = F.h(); bf16_t* h2s = F.slot(0); unsigned* route = F.route();
    for (int r = F.bid * 8 + F.wave; r < MROWS; r += G * 8) {
        unsigned* rt = route + (size_t)r * 8;
        const int e0 = (int)rt[0], e1 = (int)rt[1]; const int d0 = tb[e0] * 256 + (int)rt[6], d1 = tb[e1] * 256 + (int)rt[7];
        const u32x4 a = *(const u32x4*)(H + (size_t)r * 1024 + F.lane * 8), c = *(const u32x4*)(H + (size_t)r * 1024 + 512 + F.lane * 8);
        *(u32x4*)(h2s + (size_t)d0 * 1024 + F.lane * 8) = a; *(u32x4*)(h2s + (size_t)d0 * 1024 + 512 + F.lane * 8) = c;
        *(u32x4*)(h2s + (size_t)d1 * 1024 + F.lane * 8) = a; *(u32x4*)(h2s + (size_t)d1 * 1024 + 512 + F.lane * 8) = c;
        if (F.lane == 0) { rt[4] = (unsigned)d0; rt[5] = (unsigned)d1; }
    }
}

DI void final_phase(const Frame& F) {
    const int G = F.G; const float* xs = F.xs(); const bf16_t* ys = F.slot(8); const unsigned* route = F.route();
    for (int o = F.bid * 8 + F.wave; o < NB * SEQ; o += G * 8) {
        const int b = o / SEQ, s = o - b * SEQ, r = b * TT + CTX + s;
        const unsigned* rt = route + (size_t)r * 8;
        const float w0 = __uint_as_float(rt[2]), w1 = __uint_as_float(rt[3]); const int p0 = (int)rt[4], p1 = (int)rt[5];
        const float* m5 = F.mod(1, b) + 5 * 1024;
#pragma unroll
        for (int i = 0; i < 4; ++i) { const int c = F.lane * 4 + 256 * i;
            f32x4 x = *(const f32x4*)(xs + (size_t)r * 1024 + c);
            const u32x2 a = *(const u32x2*)(ys + (size_t)p0 * 1024 + c), bq = *(const u32x2*)(ys + (size_t)p1 * 1024 + c); const f32x4 g = *(const f32x4*)(m5 + c);
            x[0] += g[0] * (w0 * __uint_as_float(a.x << 16) + w1 * __uint_as_float(bq.x << 16));
            x[1] += g[1] * (w0 * __uint_as_float(a.x & 0xffff0000u) + w1 * __uint_as_float(bq.x & 0xffff0000u));
            x[2] += g[2] * (w0 * __uint_as_float(a.y << 16) + w1 * __uint_as_float(bq.y << 16));
            x[3] += g[3] * (w0 * __uint_as_float(a.y & 0xffff0000u) + w1 * __uint_as_float(bq.y & 0xffff0000u));
            *(f32x4*)(F.out + (size_t)o * 1024 + c) = x; }
    }
}
DI void attn_prep_item(const Frame& F, int L, int b, int tt, LAS unsigned char* lds) {
    const int t0 = tt * 64;
    const bf16_t* Pq = F.slot(4); const bf16_t* Pk = F.slot(5); const bf16_t* Pv = F.slot(6);
    bf16_t* Qn = F.slot(9); bf16_t* Kn = F.slot(10); bf16_t* Vt = F.slot(11);
    const int d = F.lane;
    const float gq = F.inp(13)[L * 64 + d], gk = F.inp(14)[L * 64 + d];
    const int half = d >> 5, idx = d & 31, fi = idx & 15;
    const float inv_freq = exp2f(-(float)fi * (13.287712379549449f / 16.f));
    for (int task = F.wave; task < 1024; task += 8) {
        const int tok = task >> 4, rest = task & 15, qk = rest >> 3, hd = (rest >> 1) & 3, c = rest & 1;
        const int t = t0 + tok; const size_t r = (size_t)b * TT + t;
        const float x = bf2f((qk ? Pk : Pq)[r * 512 + hd * 128 + c * 64 + d]);
        const float ss = wave_sum(x * x);
        float y = x * rsqrtf(ss * (1.f / 64.f) + EPS) * (qk ? gk : gq);
        if (t >= CTX) {
            const int pos = t - CTX; const float id = half ? (float)(pos & 63) : (float)(pos >> 6);
            const float ang = id * inv_freq; float sn, cs; sincosf(ang, &sn, &cs);
            const float other = __shfl_xor(y, 16);
            y = idx < 16 ? y * cs - other * sn : y * cs + other * sn;
        }
        if (!qk) y *= 0.125f * 1.4426950408889634f;
        (qk ? Kn : Qn)[((size_t)((b * 4 + hd) * 2 + c) * TT + t) * 64 + d] = f2bf(y);
    }
    LAS bf16_t* tl = (LAS bf16_t*)lds;
    __syncthreads();
    for (int ch = F.tid; ch < 4096; ch += NT) { const int tok = ch >> 6, c8 = (ch & 63) * 8;
        *(LAS u32x4*)(tl + tok * 520 + c8) = *(const u32x4*)(Pv + ((size_t)b * TT + t0 + tok) * 512 + c8); }
    __syncthreads();
    { const int col = F.tid; bf16_t* dst = Vt + ((size_t)b * 512 + col) * TT + t0;
#pragma unroll
      for (int g = 0; g < 8; ++g) { unsigned w[4];
#pragma unroll
          for (int q = 0; q < 4; ++q) w[q] = (unsigned)tl[(g * 8 + 2 * q) * 520 + col] | ((unsigned)tl[(g * 8 + 2 * q + 1) * 520 + col] << 16);
          u32x4 v; v.x = w[0]; v.y = w[1]; v.z = w[2]; v.w = w[3];
          *(u32x4*)(dst + g * 8) = v; } }
    __syncthreads();
}

DI void lru_chunk(const Frame& F, int L, int b, int c32, int mode, LAS unsigned char* lds) {
    LAS float* xcs = (LAS float*)lds;
    const int t0 = c32 * 32, seg_lo = t0 < CTX ? 0 : CTX, seg_hi = t0 < CTX ? CTX : TT;
    const int ch = F.tid, n = ch >> 6, k = ch & 63;
    const bf16_t* Px = F.slot(7); const bf16_t* Py = F.slot(8); bf16_t* Yc = F.slot(6);
    float* lrs = (float*)(F.ws + WS_LRS);
    __syncthreads();
    { const float w0 = F.inp(17)[(L * 4 + 0) * 512 + ch], w1 = F.inp(17)[(L * 4 + 1) * 512 + ch], w2 = F.inp(17)[(L * 4 + 2) * 512 + ch], w3 = F.inp(17)[(L * 4 + 3) * 512 + ch], cb = F.inp(18)[L * 512 + ch];
      auto raw = [&](int t) -> float { return (t >= seg_lo && t < seg_hi) ? bf2f(Px[((size_t)b * TT + t) * 512 + ch]) : 0.f; };
      float r0 = raw(t0 - 2), r1 = raw(t0 - 1), r2 = raw(t0);
      for (int tok = 0; tok < 32; ++tok) { const float r3 = raw(t0 + tok + 1);
          xcs[tok * 512 + ch] = w0 * r0 + w1 * r1 + w2 * r2 + w3 * r3 + cb; r0 = r1; r1 = r2; r2 = r3; } }
    __syncthreads();
    LAS float* hfs = xcs + 32 * 512;
#pragma unroll
    for (int dir = 0; dir < 2; ++dir) {
        float la[32], acc[32];
        const float sp = softplus_f(-F.inp(21)[(L * 2 + dir) * 512 + ch]);
#pragma unroll
        for (int gate = 0; gate < 2; ++gate) {
            const float bg = F.inp(20)[((L * 2 + dir) * 2 + gate) * 512 + ch];
            const float* wg = F.inp(19) + ((size_t)(((L * 2 + dir) * 2 + gate) * 8 + n) * 64) * 64 + k;
#pragma unroll
            for (int th = 0; th < 2; ++th) {
                float a16[16];
#pragma unroll
                for (int tok = 0; tok < 16; ++tok) a16[tok] = bg;
#pragma unroll 1
                for (int j = 0; j < 64; j += 4) {
                    const float wa = wg[(j + 0) * 64], wb2 = wg[(j + 1) * 64], wc = wg[(j + 2) * 64], wd = wg[(j + 3) * 64];
#pragma unroll
                    for (int tok = 0; tok < 16; ++tok) { const f32x4 xv = *(const LAS f32x4*)(xcs + (th * 16 + tok) * 512 + n * 64 + j);
                        a16[tok] += xv[0] * wa + xv[1] * wb2 + xv[2] * wc + xv[3] * wd; }
                }
#pragma unroll
                for (int tok = 0; tok < 16; ++tok) { if (gate == 0) la[th * 16 + tok] = -8.f * sigmoid_f(a16[tok]) * sp; else acc[th * 16 + tok] = a16[tok]; }
            }
        }
        float h = 0.f, ap = 1.f;
        if (mode == 1) {
            const float* s = lrs + ((size_t)((b * 2 + dir) * NLC) * 512 + ch) * 2;
            if (dir == 0) { for (int cc = 0; cc < c32; ++cc) { const float A = s[(size_t)cc * 1024], Bv = s[(size_t)cc * 1024 + 1]; h = A * h + Bv; } }
            else { const int stop = c32 < 8 ? c32 : -1;
                for (int cc = 7; cc > stop; --cc) { const float A = s[(size_t)cc * 1024], Bv = s[(size_t)cc * 1024 + 1]; h = A * h + Bv; }
                if (c32 >= 8) for (int cc = NLC - 1; cc > c32; --cc) { const float A = s[(size_t)cc * 1024], Bv = s[(size_t)cc * 1024 + 1]; h = A * h + Bv; } }
        }
#pragma unroll
        for (int i = 0; i < 32; ++i) { const int tok = dir ? 31 - i : i;
            const float a = __expf(la[tok]); const float mult = sqrtf(fmaxf(-expm1f(2.f * la[tok]), 0.f));
            const float bb = mult * sigmoid_f(acc[tok]) * xcs[tok * 512 + ch];
            h = a * h + bb; ap *= a;
            if (mode == 1) { if (dir == 0) hfs[tok * 512 + ch] = h;
                else { const size_t r = (size_t)b * TT + t0 + tok; Yc[r * 512 + ch] = f2bf((hfs[tok * 512 + ch] + h) * gelu_tanh_f(bf2f(Py[r * 512 + ch]))); } }
        }
        if (mode == 0) { float* s = lrs + ((size_t)((b * 2 + dir) * NLC + c32) * 512 + ch) * 2; s[0] = ap; s[1] = h; }
    }
}

DI float row16_sum(float v) {
#pragma unroll
    for (int o = 8; o >= 1; o >>= 1) v += __shfl_xor(v, o);
    return v;
}
DI void gdn_item(const Frame& F, int L, int b, int hd, int dir, int eq, LAS unsigned char* lds) {
    LAS float* qk = (LAS float*)lds;
    LAS float* vv = qk + 64 * 256;
    LAS float* ob = vv + 64 * 32;
    LAS float* sc = ob + 64 * 32;
    const bf16_t* Pq = F.slot(0); const bf16_t* Pk = F.slot(1); const bf16_t* Pv = F.slot(2);
    bf16_t* og = F.slot(12 + dir);
    const float* ba = (const float*)(F.ws + WS_BA);
    const float* cw = F.inp(9) + (size_t)L * 4 * 1536;
    const float neg_a = -__expf(F.inp(10)[(L * 2 + dir) * 4 + hd]), dtb = F.inp(11)[(L * 2 + dir) * 4 + hd];
    const int col = F.lane >> 4, ds = F.lane & 15, el = 4 * F.wave + col;
    float S[8];
#pragma unroll
    for (int i = 0; i < 8; ++i) S[i] = 0.f;
    for (int step = 0; step < 36; ++step) {
        const int tt = dir == 0 ? step : (step < 4 ? 3 - step : 39 - step);
        const int t0 = tt * 64, seg_lo = t0 < CTX ? 0 : CTX, seg_hi = t0 < CTX ? CTX : TT;
        __syncthreads();
        {
            const int c2 = F.tid & 255, th = F.tid >> 8, isk = c2 >> 7, dd = c2 & 127;
            const bf16_t* P = isk ? Pk : Pq; const int pc = hd * 128 + dd, wcn = isk * 512 + pc;
            const float w0 = cw[0 * 1536 + wcn], w1 = cw[1 * 1536 + wcn], w2 = cw[2 * 1536 + wcn], w3 = cw[3 * 1536 + wcn];
            auto raw = [&](int t) -> float { return (t >= seg_lo && t < seg_hi) ? bf2f(P[((size_t)b * TT + t) * 512 + pc]) : 0.f; };
            const int ts = t0 + th * 32;
            float r0 = raw(ts - 2), r1 = raw(ts - 1), r2 = raw(ts);
            for (int i = 0; i < 32; ++i) { const float r3 = raw(ts + i + 1);
                qk[(th * 32 + i) * 256 + c2] = silu_f(w0 * r0 + w1 * r1 + w2 * r2 + w3 * r3); r0 = r1; r1 = r2; r2 = r3; }
        }
        {
            const int tl = F.tid >> 3, c4 = (F.tid & 7) * 4, t = t0 + tl;
#pragma unroll
            for (int cc = 0; cc < 4; ++cc) { const int pc = hd * 128 + eq * 32 + c4 + cc, wcn = 1024 + pc; float a = 0.f;
#pragma unroll
                for (int j = 0; j < 4; ++j) { const int ts = t - 2 + j; if (ts >= seg_lo && ts < seg_hi) a += cw[j * 1536 + wcn] * bf2f(Pv[((size_t)b * TT + ts) * 512 + pc]); }
                vv[tl * 32 + c4 + cc] = silu_f(a); }
        }
        if (F.tid < 64) { const size_t r = (size_t)b * TT + t0 + F.tid;
            sc[F.tid * 4 + 2] = sigmoid_f(ba[r * 16 + dir * 4 + hd]);
            sc[F.tid * 4 + 3] = __expf(neg_a * softplus_f(ba[r * 16 + 8 + dir * 4 + hd] + dtb)); }
        __syncthreads();
        {
            const int pair = F.tid >> 2, part = F.tid & 3, tl = pair >> 1, isk = pair & 1; float a = 0.f;
            for (int i = 0; i < 32; ++i) { const float x = qk[tl * 256 + isk * 128 + part * 32 + ((i + pair) & 31)]; a += x * x; }
            a += __shfl_xor(a, 1); a += __shfl_xor(a, 2);
            if (part == 0) sc[tl * 4 + isk] = rsqrtf(a + EPS) * (isk ? 1.f : 0.08838834764831845f);
        }
        __syncthreads();
        for (int i = 0; i < 64; ++i) {
            const int tl = dir ? 63 - i : i;
            const f32x4 s4 = *(const LAS f32x4*)(sc + tl * 4);
            const f32x4 ka = *(const LAS f32x4*)(qk + tl * 256 + 128 + ds * 8), kb = *(const LAS f32x4*)(qk + tl * 256 + 128 + ds * 8 + 4);
            const f32x4 qa = *(const LAS f32x4*)(qk + tl * 256 + ds * 8), qb = *(const LAS f32x4*)(qk + tl * 256 + ds * 8 + 4);
            const float vval = vv[tl * 32 + el];
            float ks = ka[0] * S[0] + ka[1] * S[1] + ka[2] * S[2] + ka[3] * S[3] + kb[0] * S[4] + kb[1] * S[5] + kb[2] * S[6] + kb[3] * S[7];
            ks = row16_sum(ks);
            const float vn = s4[2] * (vval - s4[3] * s4[1] * ks);
            const float kv = s4[1] * vn;
            S[0] = s4[3] * S[0] + ka[0] * kv; S[1] = s4[3] * S[1] + ka[1] * kv; S[2] = s4[3] * S[2] + ka[2] * kv; S[3] = s4[3] * S[3] + ka[3] * kv;
            S[4] = s4[3] * S[4] + kb[0] * kv; S[5] = s4[3] * S[5] + kb[1] * kv; S[6] = s4[3] * S[6] + kb[2] * kv; S[7] = s4[3] * S[7] + kb[3] * kv;
            float o = qa[0] * S[0] + qa[1] * S[1] + qa[2] * S[2] + qa[3] * S[3] + qb[0] * S[4] + qb[1] * S[5] + qb[2] * S[6] + qb[3] * S[7];
            o = row16_sum(o);
            if (ds == 0) ob[tl * 32 + el] = s4[0] * o;
        }
        __syncthreads();
        { const int tl = F.tid >> 3, c4 = (F.tid & 7) * 4; const f32x4 o4 = *(const LAS f32x4*)(ob + tl * 32 + c4);
          u32x2 w; w.x = pack2(o4[0], o4[1]); w.y = pack2(o4[2], o4[3]);
          *(u32x2*)(og + ((size_t)b * TT + t0 + tl) * 512 + hd * 128 + eq * 32 + c4) = w; }
    }
}

DI void gdn_post(const Frame& F, int L) {
    const int G = F.G; const bf16_t* of = F.slot(12); const bf16_t* obk = F.slot(13); const bf16_t* Pz = F.slot(3); bf16_t* Ya = F.slot(4);
    const float* gain = F.inp(12) + L * 128;
    for (int r = F.bid * 8 + F.wave; r < MROWS; r += G * 8) {
        const size_t off = (size_t)r * 512 + F.lane * 8;
        const u32x4 a = *(const u32x4*)(of + off), c = *(const u32x4*)(obk + off), z = *(const u32x4*)(Pz + off);
        const unsigned aa[4] = {a.x, a.y, a.z, a.w}, cc[4] = {c.x, c.y, c.z, c.w}, zz[4] = {z.x, z.y, z.z, z.w};
        float o[8]; float ss = 0.f;
#pragma unroll
        for (int q = 0; q < 4; ++q) { o[2 * q] = __uint_as_float(aa[q] << 16) + __uint_as_float(cc[q] << 16); o[2 * q + 1] = __uint_as_float(aa[q] & 0xffff0000u) + __uint_as_float(cc[q] & 0xffff0000u);
            ss += o[2 * q] * o[2 * q] + o[2 * q + 1] * o[2 * q + 1]; }
        ss = row16_sum(ss);
        const float rstd = rsqrtf(ss * (1.f / 128.f) + EPS);
        const int e0 = (F.lane & 15) * 8;
        float y[8];
#pragma unroll
        for (int q = 0; q < 4; ++q) { y[2 * q] = o[2 * q] * rstd * gain[e0 + 2 * q] * silu_f(__uint_as_float(zz[q] << 16)); y[2 * q + 1] = o[2 * q + 1] * rstd * gain[e0 + 2 * q + 1] * silu_f(__uint_as_float(zz[q] & 0xffff0000u)); }
        u32x4 w; w.x = pack2(y[0], y[1]); w.y = pack2(y[2], y[3]); w.z = pack2(y[4], y[5]); w.w = pack2(y[6], y[7]);
        *(u32x4*)(Ya + off) = w;
    }
}
#define MFMA32(a, b, c) __builtin_amdgcn_mfma_f32_32x32x16_bf16((a), (b), (c), 0, 0, 0)
DI bf16x8 pack8(const f32x16& x, int s) {
    u32x4 p; p.x = pack2(x[8 * s], x[8 * s + 1]); p.y = pack2(x[8 * s + 2], x[8 * s + 3]); p.z = pack2(x[8 * s + 4], x[8 * s + 5]); p.w = pack2(x[8 * s + 6], x[8 * s + 7]);
    return __builtin_bit_cast(bf16x8, p);
}
constexpr int AK_PITCH = 272, AV_PITCH = 136, AK_BYTES = 64 * AK_PITCH, AV_BYTES = 128 * AV_PITCH;

DI void attn_item(const Frame& F, int L, int b, int hd, int qt, float lam, float lam_init, float bound2, LAS unsigned char* lds) {
    const bf16_t* Qn = F.slot(9); const bf16_t* Kn = F.slot(10); const bf16_t* Vt = F.slot(11); bf16_t* Yb = F.slot(5);
    const int qbase = qt < 8 ? CTX + qt * 256 : 0, nkt = qt < 8 ? 36 : 4;
    int tid_ = F.tid; asm volatile("" : "+v"(tid_));
    const int lane_ = tid_ & 63, l31 = lane_ & 31, hh = lane_ >> 5;
    const int tq = qbase + 32 * F.wave + l31;
    LAS unsigned char* Kl = lds; LAS unsigned char* Vl = lds + AK_BYTES;
    LAS unsigned char* Ql = lds + AK_BYTES + AV_BYTES + F.wave * 8192 + lane_ * 16;
    __syncthreads();
#pragma unroll
    for (int c = 0; c < 2; ++c)
#pragma unroll
        for (int s = 0; s < 4; ++s) *(LAS bf16x8*)(Ql + (c * 4 + s) * 1024) = *(const bf16x8*)(Qn + ((size_t)((b * 4 + hd) * 2 + c) * TT + tq) * 64 + 16 * s + 8 * hh);
    f32x16 O[2][4];
#pragma unroll
    for (int c = 0; c < 2; ++c)
#pragma unroll
        for (int e = 0; e < 4; ++e)
#pragma unroll
            for (int i = 0; i < 16; ++i) O[c][e][i] = 0.f;
    float lsum[2] = {0.f, 0.f};
    const int kkey = tid_ >> 3, kch = tid_ & 7;
    const bf16_t* kb = Kn + (size_t)((b * 4 + hd) * 2) * TT * 64;
    const bf16_t* vbs = Vt + (size_t)(b * 4 + hd) * 128 * TT;
    const unsigned koff = (unsigned)(kkey * 64 + kch * 8);
    const int ve0 = tid_ >> 3, ve1 = ve0 + 64, vch = tid_ & 7;
    const unsigned voff = (unsigned)(ve0 * TT + vch * 8);
    u32x4 rk0, rk1, rv0, rv1;
    rk0 = *(const u32x4*)(kb + koff); rk1 = *(const u32x4*)(kb + TT * 64 + koff); rv0 = *(const u32x4*)(vbs + voff); rv1 = *(const u32x4*)(vbs + 64 * TT + voff);
    for (int kt = 0; kt < nkt; ++kt) {
        __syncthreads();
        *(LAS u32x4*)(Kl + kkey * AK_PITCH + kch * 16) = rk0;
        *(LAS u32x4*)(Kl + kkey * AK_PITCH + 128 + kch * 16) = rk1;
        { u32x2 a; a.x = rv0.x; a.y = rv0.y; u32x2 c; c.x = rv0.z; c.y = rv0.w; *(LAS u32x2*)(Vl + ve0 * AV_PITCH + vch * 16) = a; *(LAS u32x2*)(Vl + ve0 * AV_PITCH + vch * 16 + 8) = c; }
        { u32x2 a; a.x = rv1.x; a.y = rv1.y; u32x2 c; c.x = rv1.z; c.y = rv1.w; *(LAS u32x2*)(Vl + ve1 * AV_PITCH + vch * 16) = a; *(LAS u32x2*)(Vl + ve1 * AV_PITCH + vch * 16 + 8) = c; }
        __syncthreads();
        if (kt + 1 < nkt) { const bf16_t* kn = kb + (kt + 1) * 4096; const bf16_t* vn = vbs + (kt + 1) * 64;
            rk0 = *(const u32x4*)(kn + koff); rk1 = *(const u32x4*)(kn + TT * 64 + koff); rv0 = *(const u32x4*)(vn + voff); rv1 = *(const u32x4*)(vn + 64 * TT + voff); }
#pragma unroll 1
        for (int u = 0; u < 2; ++u) {
            bf16x8 Pf[2][2];
#pragma unroll
            for (int c = 0; c < 2; ++c) {
                f32x16 S;
#pragma unroll
                for (int i = 0; i < 16; ++i) S[i] = 0.f;
#pragma unroll
                for (int s = 0; s < 4; ++s) { const bf16x8 A = *(const LAS bf16x8*)(Kl + (32 * u + l31) * AK_PITCH + c * 128 + (16 * s + 8 * hh) * 2); const bf16x8 Bq = *(const LAS bf16x8*)(Ql + (c * 4 + s) * 1024); S = MFMA32(A, Bq, S); }
#pragma unroll
                for (int i = 0; i < 16; ++i) { S[i] = __builtin_amdgcn_exp2f(S[i] - bound2); lsum[c] += S[i]; }
                Pf[c][0] = pack8(S, 0); Pf[c][1] = pack8(S, 1);
            }
#pragma unroll
            for (int s = 0; s < 2; ++s) {
                __builtin_amdgcn_sched_barrier(0);
#pragma unroll
                for (int e = 0; e < 4; ++e) {
                    const LAS unsigned char* vb = Vl + (32 * e + l31) * AV_PITCH + (32 * u + 16 * s + 4 * hh) * 2;
                    const s16x4 lo = *(const LAS s16x4*)vb, hi = *(const LAS s16x4*)(vb + 16);
                    const bf16x8 A = __builtin_shufflevector(lo, hi, 0, 1, 2, 3, 4, 5, 6, 7);
                    O[0][e] = MFMA32(A, Pf[0][s], O[0][e]); O[1][e] = MFMA32(A, Pf[1][s], O[1][e]);
                }
            }
            __builtin_amdgcn_sched_barrier(0);
        }
    }
    const float l0 = lsum[0] + __shfl_xor(lsum[0], 32), l1 = lsum[1] + __shfl_xor(lsum[1], 32);
    const float i0 = 1.f / l0, i1 = lam / l1;
    float ss = 0.f;
#pragma unroll
    for (int e = 0; e < 4; ++e)
#pragma unroll
        for (int i = 0; i < 16; ++i) { const float o = O[0][e][i] * i0 - O[1][e][i] * i1; O[0][e][i] = o; ss += o * o; }
    ss += __shfl_xor(ss, 32);
    const float rstd = rsqrtf(ss * (1.f / 128.f) + EPS) * (1.f - lam_init);
    const float* og = F.inp(16) + L * 128;
    bf16_t* dst = Yb + ((size_t)b * TT + tq) * 512 + hd * 128;
#pragma unroll
    for (int e = 0; e < 4; ++e)
#pragma unroll
        for (int g = 0; g < 4; ++g) { const int e0 = 32 * e + 8 * g + 4 * hh; const f32x4 gv = *(const f32x4*)(og + e0);
            u32x2 w; w.x = pack2(O[0][e][4 * g] * rstd * gv[0], O[0][e][4 * g + 1] * rstd * gv[1]); w.y = pack2(O[0][e][4 * g + 2] * rstd * gv[2], O[0][e][4 * g + 3] * rstd * gv[3]);
            *(u32x2*)(dst + e0) = w; }
}

__global__ void __launch_bounds__(NT) mk_fwd(Params p) {
    extern __shared__ __attribute__((aligned(16))) unsigned char lds_raw[];
    LAS unsigned char* lds = (LAS unsigned char*)lds_raw;
    cg::grid_group grid = cg::this_grid();
    LAS int* tb = (LAS int*)(lds + LDS_MISC);
    LAS unsigned long long* itab = (LAS unsigned long long*)(lds + LDS_MISC + 256);
    LAS unsigned* scal = (LAS unsigned*)(lds + LDS_MISC + 512);
    if (threadIdx.x < 28) itab[threadIdx.x] = (unsigned long long)p.in[threadIdx.x];
    if (threadIdx.x == 0) { const unsigned long long w = (unsigned long long)p.ws, o = (unsigned long long)p.out;
        scal[0] = (unsigned)w; scal[1] = (unsigned)(w >> 32); scal[2] = (unsigned)o; scal[3] = (unsigned)(o >> 32); scal[4] = gridDim.x; scal[5] = blockIdx.x; }
    __syncthreads();
    for (int ph = p.ph_lo; ph < p.ph_hi; ++ph) {
        int tid_ = threadIdx.x; asm volatile("" : "+v"(tid_));
        const unsigned w0 = __builtin_amdgcn_readfirstlane(scal[0]), w1 = __builtin_amdgcn_readfirstlane(scal[1]), o0 = __builtin_amdgcn_readfirstlane(scal[2]), o1 = __builtin_amdgcn_readfirstlane(scal[3]);
        unsigned char* ws_ = (unsigned char*)(((unsigned long long)w1 << 32) | w0); float* out_ = (float*)(((unsigned long long)o1 << 32) | o0);
        const int G = __builtin_amdgcn_readfirstlane(scal[4]), bid = __builtin_amdgcn_readfirstlane(scal[5]);
        Frame F; F.itab = itab; F.out = out_; F.ws = ws_; F.tid = tid_; F.lane = tid_ & 63; F.wave = __builtin_amdgcn_readfirstlane(tid_ >> 6); F.G = G; F.bid = bid;
        if (ph == 0) phase0(F, lds);
        else if (ph == 23) final_phase(F);
        else {
            const int L = (ph - 1) / 11, k = (ph - 1) % 11;
            bf16_t* wb = F.wb(L);
            if (k == 0) norm_phase(F, L, 1);
            else if (k == 1) {
                pg8::Gemm g{F.h(), wb + W_IN, 1024}; pg8::StaticOrder S{72, 18, G, bid};
                pg8::EpiSlots E{F.slot(0), {0, 1, 2, 3, 4, 5, 6, 7, 8}};
                pg8::gemm_phase(lds, g, S, E, F.tid);
            } else if (k == 2) {
                for (int it = bid; it < 288; it += G) attn_prep_item(F, L, it / 36, it % 36, lds);
                for (int it = bid; it < NB * NLC; it += G) lru_chunk(F, L, it / NLC, it % NLC, 0, lds);
            } else if (k == 3) {
                for (int it = bid; it < 256; it += G) gdn_item(F, L, it >> 5, (it >> 3) & 3, (it >> 2) & 1, it & 3, lds);
                { const float* lv = F.inp(15) + L * 256; float s01 = 0.f, s23 = 0.f;
                  for (int i = 0; i < 64; ++i) { s01 += lv[i] * lv[64 + i]; s23 += lv[128 + i] * lv[192 + i]; }
                  const float lam_init = 0.8f - 0.6f * expf(-0.3f * (float)L);
                  const float lam = expf(s01) - expf(s23) + lam_init;
                  float mq = 0.f, mk = 0.f;
                  for (int i = 0; i < 64; ++i) { mq = fmaxf(mq, fabsf(F.inp(13)[L * 64 + i])); mk = fmaxf(mk, fabsf(F.inp(14)[L * 64 + i])); }
                  const float bound2 = 8.f * mq * mk * 1.4426950408889634f;
                  const int nat = L == 0 ? 288 : 256;
                  for (int it = bid; it < nat; it += G) { if (it < 256) attn_item(F, L, it >> 5, (it >> 3) & 3, it & 7, lam, lam_init, bound2, lds);
                      else attn_item(F, L, (it - 256) >> 2, (it - 256) & 3, 8, lam, lam_init, bound2, lds); } }
                for (int it = bid; it < NB * NLC; it += G) lru_chunk(F, L, it / NLC, it % NLC, 1, lds);
            } else if (k == 4) {
                gdn_post(F, L);
                pg8::Gemm g{F.h(), wb + W_IN + (size_t)4608 * 1024, 1024}; pg8::StaticOrder S{72, 12, G, bid};
                pg8::EpiSlots E{F.slot(0), {0, 1, 2, 9, 10, 11, 0, 0, 0}};
                pg8::gemm_phase(lds, g, S, E, F.tid);
            } else if (k == 5) {
                pg8::Gemm g{F.slot(4), wb + W_BR, 512}; pg8::MergeOrder S{G, bid};
                pg8::EpiMerge E{F.h(), F.slot(0)};
                pg8::gemm_phase(lds, g, S, E, F.tid);
            } else if (k == 6) {
                pg8::Gemm g{F.h(), wb + W_OUT, 1024}; pg8::StaticOrder S{72, 4, G, bid};
                pg8::EpiResid E{F.xs(), F.mod(L, 0)};
                pg8::gemm_phase(lds, g, S, E, F.tid);
            } else if (k == 7) norm_phase(F, L, 2);
            else if (k == 8) sort_phase(F, L, tb);
            else if (k == 9) {
                moe_tile_bases(F, L, tb);
                pg8::Gemm g{F.slot(0), wb + W_GU, 1024}; pg8::MoeOrder S{tb, G, bid};
                pg8::EpiMoe1 E{F.slot(5)};
                pg8::gemm_phase(lds, g, S, E, F.tid);
            } else {
                moe_tile_bases(F, L, tb);
                pg8::Gemm g{F.slot(5), wb + W_DN, 512}; pg8::MoeOrder S{tb, G, bid};
                pg8::EpiMoe2 E{F.slot(8)};
                pg8::gemm_phase(lds, g, S, E, F.tid);
            }
        }
        if (ph + 1 < p.ph_hi) grid.sync();
    }
}

extern "C" void kernel_launch(void* const* d_in, const int* in_sizes, int n_in, void* d_out, int out_size, void* d_ws, size_t ws_size, hipStream_t stream) {
    static int grid = 0;
    if (grid == 0) {
        if (n_in != 28 || out_size != NB * SEQ * DM || ws_size < WS_END) { fprintf(stderr, "kernel_launch: unexpected shapes (n_in %d out %d ws %zu need %zu)\n", n_in, out_size, ws_size, (size_t)WS_END); grid = -1; return; }
        int dev = 0, cus = 0, per_cu = 0;
        hipGetDevice(&dev); hipDeviceGetAttribute(&cus, hipDeviceAttributeMultiprocessorCount, dev);
        hipFuncSetAttribute((const void*)mk_fwd, hipFuncAttributeMaxDynamicSharedMemorySize, LDS_BYTES);
        hipOccupancyMaxActiveBlocksPerMultiprocessor(&per_cu, (const void*)mk_fwd, NT, LDS_BYTES);
        if (per_cu < 1) { fprintf(stderr, "kernel_launch: occupancy query says %d blocks per CU\n", per_cu); per_cu = 1; }
        grid = cus;
        (void)hipGetLastError();
    }
    if (grid < 0) return;
    hipMemsetAsync((char*)d_ws + WS_CTL, 0, ZERO_BYTES, stream);
    Params p{};
    for (int i = 0; i < 28; ++i) p.in[i] = (const float*)d_in[i];
    p.out = (float*)d_out; p.ws = (unsigned char*)d_ws;
#if defined(MK_PER_PHASE)
    for (int ph = 0; ph < 24; ++ph) { p.ph_lo = ph; p.ph_hi = ph + 1; hipLaunchKernelGGL(mk_fwd, dim3(grid), dim3(NT), LDS_BYTES, stream, p); }
#else
    p.ph_lo = 0; p.ph_hi = 24;
    void* args[] = {&p};
    hipError_t e = hipLaunchCooperativeKernel((const void*)mk_fwd, dim3(grid), dim3(NT), args, LDS_BYTES, stream);
    if (e != hipSuccess) fprintf(stderr, "cooperative launch failed: %s (grid %d)\n", hipGetErrorString(e), grid);
#endif
}
```

```cpp
#include <hip/hip_runtime.h>
#include <hip/hip_cooperative_groups.h>
#include <cstdio>
namespace cg = cooperative_groups;

#define DI __device__ __forceinline__
#define LAS __attribute__((address_space(3)))
typedef unsigned short bf16_t;
typedef short bf16x8 __attribute__((ext_vector_type(8)));
typedef short s16x4 __attribute__((ext_vector_type(4)));
typedef float f32x4 __attribute__((ext_vector_type(4)));
typedef float f32x2 __attribute__((ext_vector_type(2)));
typedef float f32x16 __attribute__((ext_vector_type(16)));
typedef unsigned u32x4 __attribute__((ext_vector_type(4)));
typedef unsigned u32x2 __attribute__((ext_vector_type(2)));

constexpr int NB = 8, SEQ = 2048, CTX = 256, TT = 2304, DM = 1024, MROWS = NB * TT, NLAYER = 2;
constexpr int PW = 7696;
constexpr int NT = 512;
constexpr float EPS = 1e-6f;
constexpr size_t SLOT_ELEMS = (size_t)MROWS * 512;
constexpr int MPAD = 40960;
constexpr int NLC = 72;

constexpr size_t W_IN = 0, W_BR = W_IN + (size_t)7680 * 1024, W_OUT = W_BR + (size_t)3 * 1024 * 512, W_GU = W_OUT + (size_t)1024 * 1024,
                 W_DN = W_GU + (size_t)16 * 1024 * 1024, W_LAYER = W_DN + (size_t)16 * 1024 * 512;

constexpr size_t WS_CTL = 0;
constexpr size_t WS_MOD = 65536;
constexpr size_t ZERO_BYTES = WS_MOD + (size_t)2 * 9 * 6144 * 4;
constexpr size_t WS_WSM = 524288;
constexpr size_t WS_WRT = WS_WSM + (size_t)2 * 16 * 1024 * 4;
constexpr size_t WS_BA = WS_WRT + (size_t)16 * 1024 * 4;
constexpr size_t WS_LRS = WS_BA + (size_t)MROWS * 16 * 4;
constexpr size_t WS_ROUTE = WS_LRS + (size_t)NB * 2 * NLC * 512 * 2 * 4;
constexpr size_t WS_WGT = WS_ROUTE + (size_t)MROWS * 8 * 4;
constexpr size_t WS_GSC = WS_WGT + (size_t)2 * 131072 * 2;
constexpr size_t NCD = (size_t)NB * 4 * 2 * 72;
constexpr size_t WS_GT = WS_GSC + NCD * 32 * 4 * 4;
constexpr size_t WS_GQK = WS_GT + NCD * 1024 * 2;
constexpr size_t WS_GQ = WS_GQK + NCD * 1024 * 2;
constexpr size_t GQ_ELEMS = (size_t)NB * 4 * TT * 128;
constexpr size_t WS_WB = WS_GQ + 3 * GQ_ELEMS * 2;
constexpr size_t WS_XS = WS_WB + (size_t)W_LAYER * 2;
constexpr size_t WS_H = WS_XS + (size_t)MROWS * 1024 * 4;
constexpr size_t WS_SLOT = WS_H + (size_t)MROWS * 1024 * 2;
constexpr size_t WS_END = WS_SLOT + (size_t)14 * SLOT_ELEMS * 2;
static_assert(WS_END <= (size_t)536870912, "workspace layout exceeds 512 MiB");

struct Params {
    const float* in[28];
    float* out;
    unsigned char* ws;
    int ph_lo, ph_hi, sub, pad;
};

struct Frame {
    const LAS unsigned long long* itab;
    float* out;
    unsigned char* ws;
    int tid, lane, wave, G, bid;
    DI const float* inp(int i) const { const unsigned long long v = itab[i];
        const unsigned lo = __builtin_amdgcn_readfirstlane((unsigned)v), hi = __builtin_amdgcn_readfirstlane((unsigned)(v >> 32));
        return (const float*)(((unsigned long long)hi << 32) | lo); }
    DI bf16_t* slot(int s) const { return (bf16_t*)(ws + WS_SLOT) + (size_t)s * SLOT_ELEMS; }
    DI bf16_t* wb(int) const { return (bf16_t*)(ws + WS_WB); }
    DI float* mod(int L, int mi) const { return (float*)(ws + WS_MOD) + (size_t)(L * 9 + mi) * 6144; }
    DI float* xs() const { return (float*)(ws + WS_XS); }
    DI bf16_t* h() const { return (bf16_t*)(ws + WS_H); }
    DI unsigned* ctl() const { return (unsigned*)(ws + WS_CTL); }
    DI unsigned* route() const { return (unsigned*)(ws + WS_ROUTE); }
};

DI float bf2f(bf16_t b) { return __uint_as_float(((unsigned)b) << 16); }
DI bf16_t f2bf(float f) { return __builtin_bit_cast(unsigned short, (__bf16)f); }
DI unsigned pack2(float a, float b) { typedef __bf16 v2 __attribute__((ext_vector_type(2))); v2 v; v[0] = (__bf16)a; v[1] = (__bf16)b; return __builtin_bit_cast(unsigned, v); }
DI float sigmoid_f(float x) { return 1.f / (1.f + __expf(-x)); }
DI float silu_f(float x) { return x / (1.f + __expf(-x)); }
DI float softplus_f(float x) { return fmaxf(x, 0.f) + log1pf(__expf(-fabsf(x))); }
DI float gelu_tanh_f(float x) { const float u = 0.7978845608028654f * (x + 0.044715f * x * x * x); return 0.5f * x * (1.f + tanhf(u)); }
DI float wave_sum(float v) {
#pragma unroll
    for (int o = 32; o >= 1; o >>= 1) v += __shfl_xor(v, o);
    return v;
}
DI int modidx(int r) { const int b = r / TT, t = r - b * TT; return t < CTX ? 8 : b; }
#define MFMA32(a, b, c) __builtin_amdgcn_mfma_f32_32x32x16_bf16((a), (b), (c), 0, 0, 0)
namespace pg8 {
constexpr int BM = 256, BK = 64, HALF = 128, HTB = HALF * BK * 2  , STAGE_BYTES = 8 * HTB, NXCD = 8, WGM = 8;

__host__ __device__ __forceinline__ int lds_byte(int r, int c) { const int st = (r >> 4) * 2 + (c >> 5), rr = r & 15, cc = c & 31, ob = rr * 64 + cc * 2; return st * 1024 + (ob ^ (((ob >> 9) & 1) << 5)); }
__host__ __device__ __forceinline__ void stage_rc(int b, int& R, int& C) { const int st = b / 1024, sb = b % 1024, swz = sb ^ (((sb >> 9) & 1) << 5); R = (st >> 1) * 16 + swz / 64; C = (st & 1) * 32 + (swz % 64) / 2; }
__host__ __device__ __forceinline__ int perm32(int rho) { const int n = rho >> 4, i = rho & 15; return 8 * (i >> 2) + 4 * n + (i & 3); }

struct Unit { int pm, pn; };
struct Gemm { const bf16_t* A; const bf16_t* Bt; int K; };

DI bool grid_unit(int nM, int nN, long L, Unit& u) {
    const int nwg = nM * nN; if (L >= nwg) return false;
    int wgid = (int)L; { const int q = nwg / NXCD, r = nwg % NXCD, xcd = wgid % NXCD, off = wgid / NXCD; wgid = (xcd < r ? xcd * (q + 1) : r * (q + 1) + (xcd - r) * q) + off; }
    const int nig = WGM * nN, gid = wgid / nig, fm = gid * WGM, gsz = (nM - fm) < WGM ? (nM - fm) : WGM;
    u.pm = fm + ((wgid % nig) % gsz); u.pn = (wgid % nig) / gsz; return true;
}
struct StaticOrder {
    int nM, nN, G, c;
    DI bool next(int i, Unit& u) const { return grid_unit(nM, nN, (long)i * G + c, u); }
};
struct MergeOrder {
    int G, c;
    DI bool next(int i, Unit& u) const {
        const int n = i % 3; Unit t; if (!grid_unit(72, 4, (long)(i / 3) * G + c, t)) return false;
        u.pm = n * 72 + t.pm; u.pn = n * 4 + t.pn; return true;
    }
};
struct MoeOrder {
    const LAS int* tb; int G, c;
    DI bool next(int i, Unit& u) const {
        const long L = (long)i * G + c; const int total = __builtin_amdgcn_readfirstlane(tb[16]) * 4; if (L >= total) return false;
        const int pm = (int)(L >> 2), j = (int)(L & 3); int e = 0;
#pragma unroll
        for (int q = 1; q < 16; ++q) e += (pm >= __builtin_amdgcn_readfirstlane(tb[q])) ? 1 : 0;
        u.pm = pm; u.pn = e * 4 + j; return true;
    }
};

typedef const f32x4 (&AccRef)[2][2][4][2];

struct EpiSlots {
    static constexpr bool PERM = true;
    bf16_t* base; int smap[9];
    DI void operator()(AccRef acc, const Unit& u, int wr, int wc, int fr, int fq) const {
        int sl = 0;
#pragma unroll
        for (int q = 0; q < 9; ++q) sl = ((u.pn >> 1) == q) ? smap[q] : sl;
        bf16_t* O = base + (size_t)sl * SLOT_ELEMS;
        const int row0 = u.pm * BM + wr * 64 + fr, col0 = (u.pn & 1) * 256 + wc * 32 + 8 * fq;
#pragma unroll
        for (int ai = 0; ai < 2; ++ai)
#pragma unroll
            for (int m = 0; m < 4; ++m) { bf16_t* rowp = O + (size_t)(row0 + ai * HALF + m * 16) * 512 + col0;
#pragma unroll
                for (int bj = 0; bj < 2; ++bj) { const f32x4 v0 = acc[ai][bj][m][0], v1 = acc[ai][bj][m][1];
                    u32x4 w; w.x = pack2(v0[0], v0[1]); w.y = pack2(v0[2], v0[3]); w.z = pack2(v1[0], v1[1]); w.w = pack2(v1[2], v1[3]);
                    *(u32x4*)(rowp + bj * HALF) = w; } }
    }
};
struct EpiMerge {
    static constexpr bool PERM = true;
    bf16_t* merged; const bf16_t* slots;
    DI void operator()(AccRef acc, const Unit& u, int wr, int wc, int fr, int fq) const {
        const int n = u.pm / 72, pm = u.pm - n * 72, pn = u.pn & 3;
        const int row0 = pm * BM + wr * 64 + fr, col0 = pn * 256 + wc * 32 + 8 * fq;
        const int j = 2 * n + (col0 >> 9);
        const int gs = j < 3 ? j : j + 6;
        const bf16_t* G = slots + (size_t)gs * SLOT_ELEMS;
        const int gcol0 = col0 & 511;
#pragma unroll
        for (int ai = 0; ai < 2; ++ai)
#pragma unroll
            for (int m = 0; m < 4; ++m) { const size_t row = (size_t)(row0 + ai * HALF + m * 16);
#pragma unroll
                for (int bj = 0; bj < 2; ++bj) {
                    const u32x4 gw = *(const u32x4*)(G + row * 512 + gcol0 + bj * HALF);
                    bf16_t* mp = merged + row * 1024 + col0 + bj * HALF;
                    float v[8];
#pragma unroll
                    for (int q = 0; q < 4; ++q) { v[q] = acc[ai][bj][m][0][q]; v[4 + q] = acc[ai][bj][m][1][q]; }
                    const unsigned gg[4] = {gw.x, gw.y, gw.z, gw.w};
#pragma unroll
                    for (int q = 0; q < 4; ++q) { v[2 * q] *= sigmoid_f(__uint_as_float(gg[q] << 16)); v[2 * q + 1] *= sigmoid_f(__uint_as_float(gg[q] & 0xffff0000u)); }
                    if (n > 0) { const u32x4 ow = *(const u32x4*)mp; const unsigned oo[4] = {ow.x, ow.y, ow.z, ow.w};
#pragma unroll
                        for (int q = 0; q < 4; ++q) { v[2 * q] += __uint_as_float(oo[q] << 16); v[2 * q + 1] += __uint_as_float(oo[q] & 0xffff0000u); } }
                    u32x4 w; w.x = pack2(v[0], v[1]); w.y = pack2(v[2], v[3]); w.z = pack2(v[4], v[5]); w.w = pack2(v[6], v[7]);
                    *(u32x4*)mp = w; } }
    }
};
struct EpiResid {
    static constexpr bool PERM = false;
    float* xs; const float* modL;
    DI void operator()(AccRef acc, const Unit& u, int wr, int wc, int fr, int fq) const {
        const int row0 = u.pm * BM + wr * 64 + fr, col0 = u.pn * BM + wc * 32 + 4 * fq;
#pragma unroll
        for (int ai = 0; ai < 2; ++ai)
#pragma unroll
            for (int m = 0; m < 4; ++m) { const int row = row0 + ai * HALF + m * 16; float* rowp = xs + (size_t)row * 1024 + col0;
                const float* g = modL + (size_t)modidx(row) * 6144 + 2048 + col0;
#pragma unroll
                for (int bj = 0; bj < 2; ++bj)
#pragma unroll
                    for (int n = 0; n < 2; ++n) { const f32x4 gv = *(const f32x4*)(g + bj * HALF + n * 16); f32x4 x = *(f32x4*)(rowp + bj * HALF + n * 16);
                        x += gv * acc[ai][bj][m][n]; *(f32x4*)(rowp + bj * HALF + n * 16) = x; } }
    }
};
struct EpiMoe1 {
    static constexpr bool PERM = true;
    bf16_t* act;
    DI void operator()(AccRef acc, const Unit& u, int wr, int wc, int fr, int fq) const {
        const int row0 = u.pm * BM + wr * 64 + fr, col0 = (u.pn & 3) * 128 + wc * 32 + 8 * fq;
#pragma unroll
        for (int ai = 0; ai < 2; ++ai)
#pragma unroll
            for (int m = 0; m < 4; ++m) { bf16_t* rowp = act + (size_t)(row0 + ai * HALF + m * 16) * 512 + col0;
                float v[8];
#pragma unroll
                for (int q = 0; q < 4; ++q) { v[q] = silu_f(acc[ai][0][m][0][q]) * acc[ai][1][m][0][q]; v[4 + q] = silu_f(acc[ai][0][m][1][q]) * acc[ai][1][m][1][q]; }
                u32x4 w; w.x = pack2(v[0], v[1]); w.y = pack2(v[2], v[3]); w.z = pack2(v[4], v[5]); w.w = pack2(v[6], v[7]);
                *(u32x4*)rowp = w; }
    }
};
struct EpiMoe2 {
    static constexpr bool PERM = true;
    bf16_t* ys;
    DI void operator()(AccRef acc, const Unit& u, int wr, int wc, int fr, int fq) const {
        const int row0 = u.pm * BM + wr * 64 + fr, col0 = (u.pn & 3) * 256 + wc * 32 + 8 * fq;
#pragma unroll
        for (int ai = 0; ai < 2; ++ai)
#pragma unroll
            for (int m = 0; m < 4; ++m) { bf16_t* rowp = ys + (size_t)(row0 + ai * HALF + m * 16) * 1024 + col0;
#pragma unroll
                for (int bj = 0; bj < 2; ++bj) { const f32x4 v0 = acc[ai][bj][m][0], v1 = acc[ai][bj][m][1];
                    u32x4 w; w.x = pack2(v0[0], v0[1]); w.y = pack2(v0[2], v0[3]); w.z = pack2(v1[0], v1[1]); w.w = pack2(v1[2], v1[3]);
                    *(u32x4*)(rowp + bj * HALF) = w; } }
    }
};

template <class Epi, class Sched>
DI void gemm_phase(LAS unsigned char* lds, const Gemm g, const Sched& S, const Epi& E, const int tid) {
    const int wid = __builtin_amdgcn_readfirstlane(tid >> 6), lane = tid & 63, wr = wid >> 2, wc = wid & 3, fr = lane & 15, fq = lane >> 4;
    const int K = g.K, nt = K / BK;
    unsigned voffA[2], voffB[2];
#pragma unroll
    for (int i = 0; i < 2; ++i) { int R, C; stage_rc(tid * 16 + i * 8192, R, C); const int Rb = Epi::PERM ? ((R & ~31) + perm32(R & 31)) : R;
        voffA[i] = (unsigned)(R * K + C) * 2u; voffB[i] = (unsigned)(Rb * K + C) * 2u; }
    const size_t kstep = (size_t)(BK * 2);
    const size_t hstep = (size_t)HALF * K * 2;
    const size_t tstep = 2 * hstep;
    const unsigned ldsw = (unsigned)wid * 1024u;
    const int aoff = lds_byte(wr * 64 + fr, fq * 8), boff = lds_byte(wc * 32 + fr, fq * 8);
#define PG8_SA(b, h) (((b) * 2 + (h)) * HTB)
#define PG8_SB(b, h) ((4 + (b) * 2 + (h)) * HTB)
#define PG8_STAGE(bufoff, gbase, voff) do { _Pragma("unroll") for (int _i = 0; _i < 2; ++_i) \
        __builtin_amdgcn_global_load_lds((const unsigned*)((const char*)(gbase) + (voff)[_i]), (LAS unsigned*)(lds + (bufoff) + ldsw + _i * 8192), 16, 0, 0); } while (0)
#define PG8_LDA(dst, b, h) do { _Pragma("unroll") for (int m = 0; m < 4; ++m) _Pragma("unroll") for (int k = 0; k < 2; ++k) dst[m][k] = *(const LAS bf16x8*)(lds + PG8_SA(b, h) + aoff + m * 2048 + k * 1024); } while (0)
#define PG8_LDB(dst, b, h) do { _Pragma("unroll") for (int n = 0; n < 2; ++n) _Pragma("unroll") for (int k = 0; k < 2; ++k) dst[n][k] = *(const LAS bf16x8*)(lds + PG8_SB(b, h) + boff + n * 2048 + k * 1024); } while (0)
#define PG8_MMA(ai, bj, At, Bt) do { __builtin_amdgcn_s_setprio(1); _Pragma("unroll") for (int m = 0; m < 4; ++m) _Pragma("unroll") for (int n = 0; n < 2; ++n) _Pragma("unroll") for (int k = 0; k < 2; ++k) \
        acc[ai][bj][m][n] = __builtin_amdgcn_mfma_f32_16x16x32_bf16(Bt[n][k], At[m][k], acc[ai][bj][m][n], 0, 0, 0); __builtin_amdgcn_s_setprio(0); } while (0)
#define PG8_WAIT_V(n) asm volatile("s_waitcnt vmcnt(" #n ")" ::: "memory")
#define PG8_WAIT_L(n) asm volatile("s_waitcnt lgkmcnt(" #n ")" ::: "memory")
#define PG8_BAR __builtin_amdgcn_s_barrier()
#define PG8_SCHED __builtin_amdgcn_sched_barrier(0)
    Unit cur, nxt; int ui = 0;
    if (!S.next(0, cur)) return;
    f32x4 acc[2][2][4][2];
#pragma unroll
    for (int a = 0; a < 2; ++a)
#pragma unroll
        for (int b = 0; b < 2; ++b)
#pragma unroll
            for (int m = 0; m < 4; ++m)
#pragma unroll
                for (int n = 0; n < 2; ++n) acc[a][b][m][n] = (f32x4){0.f, 0.f, 0.f, 0.f};
    bf16x8 At[4][2], B0[2][2], B1[2][2];
    const char* cA = (const char*)g.A + (size_t)cur.pm * tstep; const char* cB = (const char*)g.Bt + (size_t)cur.pn * tstep;
    PG8_STAGE(PG8_SB(0, 0), cB, voffB); PG8_STAGE(PG8_SA(0, 0), cA, voffA); PG8_STAGE(PG8_SB(0, 1), cB + hstep, voffB); PG8_STAGE(PG8_SA(0, 1), cA + hstep, voffA);
    if (wr == 1) PG8_BAR;
    PG8_WAIT_V(4); PG8_BAR;
    PG8_STAGE(PG8_SB(1, 0), cB + kstep, voffB); PG8_STAGE(PG8_SA(1, 0), cA + kstep, voffA); PG8_STAGE(PG8_SB(1, 1), cB + hstep + kstep, voffB);
    PG8_WAIT_V(6); PG8_BAR;
    for (;;) {
        const bool has_next = S.next(ui + 1, nxt);
        const char* nA = has_next ? (const char*)g.A + (size_t)nxt.pm * tstep : cA; const char* nB = has_next ? (const char*)g.Bt + (size_t)nxt.pn * tstep : cB;
        for (int t = 0; t < nt; t += 2) {
            const bool last = (t == nt - 2);
            const char* a1 = cA + (size_t)(t + 1) * kstep;
            const char* a2 = last ? nA : cA + (size_t)(t + 2) * kstep; const char* b2 = last ? nB : cB + (size_t)(t + 2) * kstep;
            const char* a3 = a2 + kstep; const char* b3 = b2 + kstep;
            PG8_LDB(B0, 0, 0); PG8_SCHED; PG8_LDA(At, 0, 0); PG8_STAGE(PG8_SA(1, 1), a1 + hstep, voffA);
            PG8_WAIT_L(8); PG8_BAR; PG8_WAIT_L(0); PG8_MMA(0, 0, At, B0); PG8_BAR; PG8_SCHED;
            PG8_LDB(B1, 0, 1); PG8_STAGE(PG8_SB(0, 0), b2, voffB);
            PG8_BAR; PG8_WAIT_L(0); PG8_MMA(0, 1, At, B1); PG8_BAR;
            PG8_LDA(At, 0, 1); PG8_STAGE(PG8_SA(0, 0), a2, voffA);
            PG8_BAR; PG8_WAIT_L(0); PG8_MMA(1, 0, At, B0); PG8_BAR; PG8_SCHED;
            PG8_STAGE(PG8_SB(0, 1), b2 + hstep, voffB);
            PG8_WAIT_V(6); PG8_BAR; PG8_MMA(1, 1, At, B1); PG8_BAR;
            PG8_LDB(B0, 1, 0); PG8_SCHED; PG8_LDA(At, 1, 0); PG8_STAGE(PG8_SA(0, 1), a2 + hstep, voffA);
            PG8_WAIT_L(8); PG8_BAR; PG8_WAIT_L(0); PG8_MMA(0, 0, At, B0); PG8_BAR; PG8_SCHED;
            PG8_LDB(B1, 1, 1); PG8_STAGE(PG8_SB(1, 0), b3, voffB);
            PG8_BAR; PG8_WAIT_L(0); PG8_MMA(0, 1, At, B1); PG8_BAR;
            PG8_LDA(At, 1, 1); PG8_STAGE(PG8_SA(1, 0), a3, voffA);
            PG8_BAR; PG8_WAIT_L(0); PG8_MMA(1, 0, At, B0); PG8_BAR; PG8_SCHED;
            PG8_STAGE(PG8_SB(1, 1), b3 + hstep, voffB);
            PG8_WAIT_V(6); PG8_BAR; PG8_MMA(1, 1, At, B1); PG8_BAR;
        }
        E(acc, cur, wr, wc, fr, fq);
        if (!has_next) break;
#pragma unroll
        for (int a = 0; a < 2; ++a)
#pragma unroll
            for (int b = 0; b < 2; ++b)
#pragma unroll
                for (int m = 0; m < 4; ++m)
#pragma unroll
                    for (int n = 0; n < 2; ++n) acc[a][b][m][n] = (f32x4){0.f, 0.f, 0.f, 0.f};
        cur = nxt; cA = nA; cB = nB; ++ui;
    }
    PG8_WAIT_V(0);
    if (wr == 0) PG8_BAR;
    PG8_BAR;
#undef PG8_SA
#undef PG8_SB
#undef PG8_STAGE
#undef PG8_LDA
#undef PG8_LDB
#undef PG8_MMA
#undef PG8_WAIT_V
#undef PG8_WAIT_L
#undef PG8_BAR
#undef PG8_SCHED
}
}
constexpr int LDS_BYTES = 163840;
constexpr int LDS_MISC = 162816;

DI void tr_tile(const Frame& F, const float* src, int ld, int k0, int c0, bf16_t* dst, int K, int n0, LAS float* tile) {
    const int kr = F.tid >> 4, c4 = (F.tid & 15) * 4;
#pragma unroll
    for (int ps = 0; ps < 2; ++ps) { const int k = kr + 32 * ps; const f32x4 v = *(const f32x4*)(src + (size_t)(k0 + k) * ld + c0 + c4);
        tile[k * 65 + c4] = v[0]; tile[k * 65 + c4 + 1] = v[1]; tile[k * 65 + c4 + 2] = v[2]; tile[k * 65 + c4 + 3] = v[3]; }
    __syncthreads();
    const int n = F.tid >> 3, kc = (F.tid & 7) * 8;
    float v[8];
#pragma unroll
    for (int i = 0; i < 8; ++i) v[i] = tile[(kc + i) * 65 + n];
    u32x4 w; w.x = pack2(v[0], v[1]); w.y = pack2(v[2], v[3]); w.z = pack2(v[4], v[5]); w.w = pack2(v[6], v[7]);
    *(u32x4*)(dst + (size_t)(n0 + n) * K + k0 + kc) = w;
    __syncthreads();
}

DI void phase0(const Frame& F, LAS unsigned char* lds) {
    const int G = F.G, bid = F.bid;
    { float* wsm = (float*)(F.ws + WS_WSM); float* wrt = (float*)(F.ws + WS_WRT);
      for (int idx = bid * NT + F.tid; idx < 2 * 16 * 1024 + 16 * 1024; idx += G * NT) {
          if (idx < 2 * 16 * 1024) { const int L = idx >> 14, j = (idx >> 10) & 15, k = idx & 1023; wsm[idx] = F.inp(8)[((size_t)L * 1024 + k) * PW + 2048 + j]; }
          else { const int q = idx - 2 * 16 * 1024, j = q >> 10, k = q & 1023; wrt[q] = F.inp(24)[k * 16 + j]; } } }
    { bf16_t* wgt = (bf16_t*)(F.ws + WS_WGT);
      for (int idx = bid * NT + F.tid; idx < 2 * 131072; idx += G * NT) { const int j = idx & 63, k = (idx >> 6) & 63, hi = idx >> 12;
          wgt[idx] = f2bf(F.inp(19)[((size_t)hi * 64 + j) * 64 + k]); } }
    { LAS float* sil = (LAS float*)lds; LAS float* red = sil + 9 * 1024;
      for (int it = bid; it < 96; it += G) {
          const int L = it / 48, cb = it % 48;
          __syncthreads();
          for (int i = F.tid; i < 9 * 1024; i += NT) { const int r = i >> 10, k = i & 1023; const float c = r < 8 ? F.inp(1)[r * 1024 + k] : F.inp(3)[k]; sil[i] = silu_f(c); }
          __syncthreads();
          const int cl = F.tid & 127, kq = F.tid >> 7, col = cb * 128 + cl; const float* wm = F.inp(4) + (size_t)L * 1024 * 6144 + (size_t)(kq * 256) * 6144 + col;
          float acc[9];
#pragma unroll
          for (int r = 0; r < 9; ++r) acc[r] = 0.f;
          for (int k = 0; k < 256; ++k) { const float w = wm[(size_t)k * 6144];
#pragma unroll
              for (int r = 0; r < 9; ++r) acc[r] += sil[r * 1024 + kq * 256 + k] * w; }
#pragma unroll
          for (int r = 0; r < 9; ++r) red[(kq * 9 + r) * 128 + cl] = acc[r];
          __syncthreads();
          if (kq == 0) { const float bias = F.inp(5)[L * 6144 + col];
#pragma unroll
              for (int r = 0; r < 9; ++r) F.mod(L, r)[col] = ((red[(0 * 9 + r) * 128 + cl] + red[(1 * 9 + r) * 128 + cl]) + (red[(2 * 9 + r) * 128 + cl] + red[(3 * 9 + r) * 128 + cl])) + bias; }
      }
      __syncthreads(); }
}

DI void convert_weights(const Frame& F, int L, LAS unsigned char* lds) {
    const int G = F.G, bid = F.bid;
    { LAS float* tile = (LAS float*)lds; bf16_t* wb = F.wb(L);
      __syncthreads();
      for (int it = bid; it < 8704; it += G) {
          int q = it;
          if (q < 1920) { const int kt = q / 120, nt = q % 120, n0 = nt * 64, c0 = n0 < 2048 ? n0 : n0 + 16;
              tr_tile(F, F.inp(8) + (size_t)L * 1024 * PW, PW, kt * 64, c0, wb + W_IN, 1024, n0, tile); continue; }
          q -= 1920;
          if (q < 384) { const int br = q >> 7, r = q & 127, kt = r >> 4, nt = r & 15;
              tr_tile(F, F.inp(22) + (size_t)(L * 3 + br) * 512 * 1024, 1024, kt * 64, nt * 64, wb + W_BR + (size_t)br * 1024 * 512, 512, nt * 64, tile); continue; }
          q -= 384;
          if (q < 256) { const int kt = q >> 4, nt = q & 15;
              tr_tile(F, F.inp(23) + (size_t)L * 1024 * 1024, 1024, kt * 64, nt * 64, wb + W_OUT, 1024, nt * 64, tile); continue; }
          q -= 256;
          if (q < 4096) { const int e = q >> 8, r = q & 255, kt = r >> 4, nt = r & 15, n0 = nt * 64, t256 = n0 >> 8, wi = n0 & 255;
              const int c0 = wi < 128 ? t256 * 128 + wi : 512 + t256 * 128 + (wi - 128);
              tr_tile(F, F.inp(26) + (size_t)(L * 16 + e) * 1024 * 1024, 1024, kt * 64, c0, wb + W_GU + (size_t)e * 1024 * 1024, 1024, n0, tile); continue; }
          q -= 4096;
          { const int e = q >> 7, r = q & 127, kt = r >> 4, nt = r & 15;
              tr_tile(F, F.inp(27) + (size_t)(L * 16 + e) * 512 * 1024, 1024, kt * 64, nt * 64, wb + W_DN + (size_t)e * 1024 * 512, 512, nt * 64, tile); }
      } }
}

DI void norm_phase(const Frame& F, int L, int which, LAS unsigned char* lds) {
    const int G = F.G;
    LAS float* swl = (LAS float*)lds;
    { const float* src = which == 1 ? (const float*)(F.ws + WS_WSM) + (size_t)L * 16 * 1024 : (const float*)(F.ws + WS_WRT);
      __syncthreads();
      for (int i = F.tid; i < 4096; i += NT) *(LAS f32x4*)(swl + i * 4) = *(const f32x4*)(src + i * 4);
      __syncthreads(); }
    const float* gain = (which == 1 ? F.inp(6) : F.inp(7)) + L * 1024;
    float* xs = F.xs(); bf16_t* H = F.h(); unsigned* route = F.route();
    const bf16_t* ys = F.slot(8);
    for (int r = F.bid * 8 + F.wave; r < MROWS; r += G * 8) {
        const int b = r / TT, t = r - b * TT, mi = t < CTX ? 8 : b;
        f32x4 x[4];
        if (which == 1 && L == 0) {
            const float* src = t < CTX ? F.inp(2) + ((size_t)b * CTX + t) * 1024 : F.inp(0) + ((size_t)b * SEQ + (t - CTX)) * 1024;
#pragma unroll
            for (int i = 0; i < 4; ++i) x[i] = *(const f32x4*)(src + F.lane * 4 + 256 * i);
        } else {
#pragma unroll
            for (int i = 0; i < 4; ++i) x[i] = *(const f32x4*)(xs + (size_t)r * 1024 + F.lane * 4 + 256 * i);
        }
        if (which == 1 && L > 0) {
            const unsigned* rt = route + (size_t)r * 8;
            const float w0 = __uint_as_float(rt[2]), w1 = __uint_as_float(rt[3]); const int p0 = (int)rt[4], p1 = (int)rt[5];
            const float* m5 = F.mod(L - 1, mi) + 5 * 1024;
#pragma unroll
            for (int i = 0; i < 4; ++i) { const int c = F.lane * 4 + 256 * i;
                const u32x2 a = *(const u32x2*)(ys + (size_t)p0 * 1024 + c), bq = *(const u32x2*)(ys + (size_t)p1 * 1024 + c); const f32x4 g = *(const f32x4*)(m5 + c);
                x[i][0] += g[0] * (w0 * __uint_as_float(a.x << 16) + w1 * __uint_as_float(bq.x << 16));
                x[i][1] += g[1] * (w0 * __uint_as_float(a.x & 0xffff0000u) + w1 * __uint_as_float(bq.x & 0xffff0000u));
                x[i][2] += g[2] * (w0 * __uint_as_float(a.y << 16) + w1 * __uint_as_float(bq.y << 16));
                x[i][3] += g[3] * (w0 * __uint_as_float(a.y & 0xffff0000u) + w1 * __uint_as_float(bq.y & 0xffff0000u)); }
        }
        if (which == 1) {
#pragma unroll
            for (int i = 0; i < 4; ++i) *(f32x4*)(xs + (size_t)r * 1024 + F.lane * 4 + 256 * i) = x[i];
        }
        float ss = 0.f;
#pragma unroll
        for (int i = 0; i < 4; ++i) ss += x[i][0] * x[i][0] + x[i][1] * x[i][1] + x[i][2] * x[i][2] + x[i][3] * x[i][3];
        ss = wave_sum(ss);
        const float rstd = rsqrtf(ss * (1.f / 1024.f) + EPS);
        const float* mv = F.mod(L, mi) + (which == 1 ? 0 : 3 * 1024);
        f32x4 hh[4];
#pragma unroll
        for (int i = 0; i < 4; ++i) { const int c = F.lane * 4 + 256 * i; const f32x4 g = *(const f32x4*)(gain + c), sh = *(const f32x4*)(mv + c), sc = *(const f32x4*)(mv + 1024 + c);
#pragma unroll
            for (int q = 0; q < 4; ++q) hh[i][q] = (x[i][q] * rstd * g[q]) * (1.f + sc[q]) + sh[q];
            u32x2 w; w.x = pack2(hh[i][0], hh[i][1]); w.y = pack2(hh[i][2], hh[i][3]);
            *(u32x2*)(H + (size_t)r * 1024 + c) = w; }
        float dv = 0.f;
#pragma unroll 1
        for (int j = 0; j < 16; ++j) { float a = 0.f;
#pragma unroll
            for (int i = 0; i < 4; ++i) { const f32x4 w = *(const LAS f32x4*)(swl + j * 1024 + F.lane * 4 + 256 * i); a += hh[i][0] * w[0] + hh[i][1] * w[1] + hh[i][2] * w[2] + hh[i][3] * w[3]; }
            a = wave_sum(a); dv = (F.lane == j) ? a : dv; }
        if (which == 1) {
            float* ba = (float*)(F.ws + WS_BA) + (size_t)r * 16;
            if (F.lane < 16) ba[F.lane] = dv;
        } else {
            float p[16], mx = -3.0e38f;
#pragma unroll
            for (int j = 0; j < 16; ++j) { p[j] = __shfl(dv, j) + F.inp(25)[j]; mx = fmaxf(mx, p[j]); }
            float sum = 0.f;
#pragma unroll
            for (int j = 0; j < 16; ++j) { p[j] = __expf(p[j] - mx); sum += p[j]; }
            const float inv = 1.f / sum;
            float bs = -1.f, bp0 = 0.f, bp1 = 0.f; int be0 = 0, be1 = 1;
#pragma unroll
            for (int g = 0; g < 4; ++g) { float a = -1.f, c2 = -1.f; int ia = 0, ib = 0;
#pragma unroll
                for (int i = 0; i < 4; ++i) { const float v = p[g * 4 + i] * inv; if (v > a) { c2 = a; ib = ia; a = v; ia = i; } else if (v > c2) { c2 = v; ib = i; } }
                const float sc = a + c2; if (sc > bs) { bs = sc; bp0 = a; bp1 = c2; be0 = g * 4 + ia; be1 = g * 4 + ib; } }
            if (F.lane == 0) {
                unsigned* cnt = F.ctl() + L * 16;
                const int pos0 = (int)atomicAdd(cnt + be0, 1u), pos1 = (int)atomicAdd(cnt + be1, 1u);
                unsigned* rt = route + (size_t)r * 8; const float wsum = bp0 + bp1;
                rt[0] = (unsigned)be0; rt[1] = (unsigned)be1; rt[2] = __float_as_uint(bp0 / wsum); rt[3] = __float_as_uint(bp1 / wsum); rt[6] = (unsigned)pos0; rt[7] = (unsigned)pos1;
            }
        }
    }
}

DI void moe_tile_bases(const Frame& F, int L, LAS int* tb) {
    if (F.tid == 0) { const unsigned* cnt = F.ctl() + L * 16; int acc = 0;
        for (int e = 0; e < 16; ++e) { tb[e] = acc; acc += (int)((cnt[e] + 255u) >> 8); }
        tb[16] = acc; }
    __syncthreads();
}

DI void sort_phase(const Frame& F, int L, LAS int* tb) {
    moe_tile_bases(F, L, tb);
    const int G = F.G; const bf16_t* H = F.h(); bf16_t* h2s = F.slot(0); unsigned* route = F.route();
    for (int r = F.bid * 8 + F.wave; r < MROWS; r += G * 8) {
        unsigned* rt = route + (size_t)r * 8;
        const int e0 = (int)rt[0], e1 = (int)rt[1]; const int d0 = tb[e0] * 256 + (int)rt[6], d1 = tb[e1] * 256 + (int)rt[7];
        const u32x4 a = *(const u32x4*)(H + (size_t)r * 1024 + F.lane * 8), c = *(const u32x4*)(H + (size_t)r * 1024 + 512 + F.lane * 8);
        *(u32x4*)(h2s + (size_t)d0 * 1024 + F.lane * 8) = a; *(u32x4*)(h2s + (size_t)d0 * 1024 + 512 + F.lane * 8) = c;
        *(u32x4*)(h2s + (size_t)d1 * 1024 + F.lane * 8) = a; *(u32x4*)(h2s + (size_t)d1 * 1024 + 512 + F.lane * 8) = c;
        if (F.lane == 0) { rt[4] = (unsigned)d0; rt[5] = (unsigned)d1; }
    }
}

DI void final_phase(const Frame& F) {
    const int G = F.G; const float* xs = F.xs(); const bf16_t* ys = F.slot(8); const unsigned* route = F.route();
    for (int o = F.bid * 8 + F.wave; o < NB * SEQ; o += G * 8) {
        const int b = o / SEQ, s = o - b * SEQ, r = b * TT + CTX + s;
        const unsigned* rt = route + (size_t)r * 8;
        const float w0 = __uint_as_float(rt[2]), w1 = __uint_as_float(rt[3]); const int p0 = (int)rt[4], p1 = (int)rt[5];
        const float* m5 = F.mod(1, b) + 5 * 1024;
#pragma unroll
        for (int i = 0; i < 4; ++i) { const int c = F.lane * 4 + 256 * i;
            f32x4 x = *(const f32x4*)(xs + (size_t)r * 1024 + c);
            const u32x2 a = *(const u32x2*)(ys + (size_t)p0 * 1024 + c), bq = *(const u32x2*)(ys + (size_t)p1 * 1024 + c); const f32x4 g = *(const f32x4*)(m5 + c);
            x[0] += g[0] * (w0 * __uint_as_float(a.x << 16) + w1 * __uint_as_float(bq.x << 16));
            x[1] += g[1] * (w0 * __uint_as_float(a.x & 0xffff0000u) + w1 * __uint_as_float(bq.x & 0xffff0000u));
            x[2] += g[2] * (w0 * __uint_as_float(a.y << 16) + w1 * __uint_as_float(bq.y << 16));
            x[3] += g[3] * (w0 * __uint_as_float(a.y & 0xffff0000u) + w1 * __uint_as_float(bq.y & 0xffff0000u));
            *(f32x4*)(F.out + (size_t)o * 1024 + c) = x; }
    }
}
DI float row16_sum(float v) {
#pragma unroll
    for (int o = 8; o >= 1; o >>= 1) v += __shfl_xor(v, o);
    return v;
}
template <int CTRL> DI float dpp_add(float v) { return v + __int_as_float(__builtin_amdgcn_update_dpp(0, __float_as_int(v), CTRL, 0xf, 0xf, false)); }
DI float row16_sum_dpp(float v) { v = dpp_add<0xB1>(v); v = dpp_add<0x4E>(v); v = dpp_add<0x124>(v); v = dpp_add<0x128>(v); return v; }
DI void rope_table(const Frame& F, LAS unsigned char* lds) {
    LAS float* rt = (LAS float*)(lds + 69632);
    __syncthreads();
    for (int i = F.tid; i < 1024; i += NT) { const int id = i >> 4, fi = i & 15; const float inv_freq = exp2f(-(float)fi * (13.287712379549449f / 16.f));
        float sn, cs; sincosf((float)id * inv_freq, &sn, &cs); rt[i * 2] = cs; rt[i * 2 + 1] = sn; }
    __syncthreads();
}
DI void attn_prep_item(const Frame& F, int L, int b, int tt, LAS unsigned char* lds) {
    const int t0 = tt * 64;
    const bf16_t* Pq = F.slot(4); const bf16_t* Pk = F.slot(5); const bf16_t* Pv = F.slot(6);
    bf16_t* Qn = F.slot(9); bf16_t* Kn = F.slot(10); bf16_t* Vt = F.slot(11);
    const LAS float* rt = (const LAS float*)(lds + 69632);
    {
        const int li = F.tid & 15, grp = F.tid >> 4, d0 = 4 * li;
        const f32x4 gq = *(const f32x4*)(F.inp(13) + L * 64 + d0), gk = *(const f32x4*)(F.inp(14) + L * 64 + d0);
        for (int v = grp; v < 1024; v += 32) {
            const int tok = v >> 4, rest = v & 15, qk = rest >> 3, hd = (rest >> 1) & 3, c = rest & 1;
            const int t = t0 + tok; const size_t r = (size_t)b * TT + t;
            const u32x2 raw = *(const u32x2*)((qk ? Pk : Pq) + r * 512 + hd * 128 + c * 64 + d0);
            float x[4] = {__uint_as_float(raw.x << 16), __uint_as_float(raw.x & 0xffff0000u), __uint_as_float(raw.y << 16), __uint_as_float(raw.y & 0xffff0000u)};
            const float ss = row16_sum(x[0] * x[0] + x[1] * x[1] + x[2] * x[2] + x[3] * x[3]);
            const float rs = rsqrtf(ss * (1.f / 64.f) + EPS);
            const f32x4 g = qk ? gk : gq;
#pragma unroll
            for (int e = 0; e < 4; ++e) x[e] *= rs * g[e];
            if (t >= CTX) {
                const int pos = t - CTX, id = (li & 8) ? (pos & 63) : (pos >> 6), fi0 = 4 * (li & 3);
                const bool lowhalf = (li & 4) == 0;
#pragma unroll
                for (int e = 0; e < 4; ++e) { const float other = __shfl_xor(x[e], 4); const float cs = rt[(id * 16 + fi0 + e) * 2], sn = rt[(id * 16 + fi0 + e) * 2 + 1];
                    x[e] = lowhalf ? x[e] * cs - other * sn : x[e] * cs + other * sn; }
            }
            if (!qk) {
#pragma unroll
                for (int e = 0; e < 4; ++e) x[e] *= 0.125f * 1.4426950408889634f;
            }
            u32x2 w; w.x = pack2(x[0], x[1]); w.y = pack2(x[2], x[3]);
            *(u32x2*)((qk ? Kn : Qn) + ((size_t)((b * 4 + hd) * 2 + c) * TT + t) * 64 + d0) = w;
        }
    }
    LAS bf16_t* tl = (LAS bf16_t*)lds;
    __syncthreads();
    for (int ch = F.tid; ch < 4096; ch += NT) { const int tok = ch >> 6, c8 = (ch & 63) * 8;
        *(LAS u32x4*)(tl + tok * 520 + c8) = *(const u32x4*)(Pv + ((size_t)b * TT + t0 + tok) * 512 + c8); }
    __syncthreads();
    { const int col = F.tid; bf16_t* dst = Vt + ((size_t)b * 512 + col) * TT + t0;
#pragma unroll
      for (int g = 0; g < 8; ++g) { unsigned w[4];
#pragma unroll
          for (int q = 0; q < 4; ++q) w[q] = (unsigned)tl[(g * 8 + 2 * q) * 520 + col] | ((unsigned)tl[(g * 8 + 2 * q + 1) * 520 + col] << 16);
          u32x4 v; v.x = w[0]; v.y = w[1]; v.z = w[2]; v.w = w[3];
          *(u32x4*)(dst + g * 8) = v; } }
    __syncthreads();
}

constexpr int XC_PITCH = 520;
DI void lru_chunk(const Frame& F, int L, int b, int c32, int mode, LAS unsigned char* lds) {
    LAS bf16_t* xcl = (LAS bf16_t*)lds;
    const int t0 = c32 * 32, seg_lo = t0 < CTX ? 0 : CTX, seg_hi = t0 < CTX ? CTX : TT;
    const bf16_t* Px = F.slot(7); const bf16_t* Py = F.slot(8); bf16_t* Yc = F.slot(6);
    float* lrs = (float*)(F.ws + WS_LRS);
    const bf16_t* wgt = (const bf16_t*)(F.ws + WS_WGT) + (size_t)L * 131072;
    LAS bf16_t* rawl = (LAS bf16_t*)(lds + 34816);
    __syncthreads();
    { u32x4 pre[5];
#pragma unroll
      for (int j = 0; j < 5; ++j) { int id = F.tid + j * NT; id = id < 35 * 64 ? id : 35 * 64 - 1; const int row = id >> 6, c8 = (id & 63) * 8; int t = t0 - 2 + row; t = t < seg_lo ? seg_lo : (t >= seg_hi ? seg_hi - 1 : t);
          pre[j] = *(const u32x4*)(Px + ((size_t)b * TT + t) * 512 + c8); }
#pragma unroll
      for (int j = 0; j < 5; ++j) { const int id = F.tid + j * NT; if (id < 35 * 64) { const int row = id >> 6, c8 = (id & 63) * 8, t = t0 - 2 + row;
          const bool in = t >= seg_lo && t < seg_hi; u32x4 v = pre[j]; v.x = in ? v.x : 0u; v.y = in ? v.y : 0u; v.z = in ? v.z : 0u; v.w = in ? v.w : 0u;
          *(LAS u32x4*)(rawl + row * XC_PITCH + c8) = v; } } }
    __syncthreads();
    { const int ch = F.tid;
      const float w0 = F.inp(17)[(L * 4 + 0) * 512 + ch], w1 = F.inp(17)[(L * 4 + 1) * 512 + ch], w2 = F.inp(17)[(L * 4 + 2) * 512 + ch], w3 = F.inp(17)[(L * 4 + 3) * 512 + ch], cb = F.inp(18)[L * 512 + ch];
      float r0 = bf2f(rawl[0 * XC_PITCH + ch]), r1 = bf2f(rawl[1 * XC_PITCH + ch]), r2 = bf2f(rawl[2 * XC_PITCH + ch]);
#pragma unroll 8
      for (int tok = 0; tok < 32; ++tok) { const float r3 = bf2f(rawl[(tok + 3) * XC_PITCH + ch]);
          xcl[tok * XC_PITCH + ch] = f2bf(w0 * r0 + w1 * r1 + w2 * r2 + w3 * r3 + cb); r0 = r1; r1 = r2; r2 = r3; } }
    __syncthreads();
    const int n = F.wave, l31 = F.lane & 31, hh = F.lane >> 5;
#pragma unroll 1
    for (int nt = 0; nt < 2; ++nt) {
        const int ch = n * 64 + 32 * nt + l31;
        float hf[16];
#pragma unroll
        for (int dir = 0; dir < 2; ++dir) {
            f32x16 aR, aI;
            { const float br = F.inp(20)[((L * 2 + dir) * 2 + 0) * 512 + ch], bi = F.inp(20)[((L * 2 + dir) * 2 + 1) * 512 + ch];
#pragma unroll
              for (int i = 0; i < 16; ++i) { aR[i] = br; aI[i] = bi; } }
#pragma unroll
            for (int s = 0; s < 4; ++s) {
                const bf16x8 A = *(const LAS bf16x8*)(xcl + l31 * XC_PITCH + n * 64 + 16 * s + 8 * hh);
                const bf16x8 Br = *(const bf16x8*)(wgt + ((size_t)(((dir * 2 + 0) * 8 + n) * 64 + 32 * nt + l31)) * 64 + 16 * s + 8 * hh);
                const bf16x8 Bi = *(const bf16x8*)(wgt + ((size_t)(((dir * 2 + 1) * 8 + n) * 64 + 32 * nt + l31)) * 64 + 16 * s + 8 * hh);
                aR = MFMA32(A, Br, aR); aI = MFMA32(A, Bi, aI);
            }
            const float sp = softplus_f(-F.inp(21)[(L * 2 + dir) * 512 + ch]);
#pragma unroll
            for (int i = 0; i < 16; ++i) { const int tok = 8 * (i >> 2) + 4 * hh + (i & 3);
                const float la = -8.f * sigmoid_f(aR[i]) * sp;
                const float bb = sqrtf(fmaxf(-expm1f(2.f * la), 0.f)) * sigmoid_f(aI[i]) * bf2f(xcl[tok * XC_PITCH + ch]);
                aR[i] = __expf(la); aI[i] = bb; }
            float GA[4], GB[4], PA[4], PB[4];
#pragma unroll
            for (int g = 0; g < 4; ++g) { float A_ = 1.f, B_ = 0.f;
#pragma unroll
                for (int q = 0; q < 4; ++q) { const int e = dir ? 3 - q : q; const float a = aR[4 * g + e]; A_ *= a; B_ = a * B_ + aI[4 * g + e]; }
                GA[g] = A_; GB[g] = B_; PA[g] = __shfl_xor(A_, 32); PB[g] = __shfl_xor(B_, 32); }
            float h = 0.f;
            if (mode == 1) {
                const float* s = lrs + ((size_t)((b * 2 + dir) * NLC) * 512 + ch) * 2;
                const int nprev = dir == 0 ? c32 : (c32 < 8 ? 7 - c32 : 8 + (NLC - 1 - c32));
                for (int i0 = 0; i0 < nprev; i0 += 8) { f32x2 ab[8];
#pragma unroll
                    for (int j = 0; j < 8; ++j) { const int i = i0 + j < nprev ? i0 + j : nprev - 1; const int cc = dir == 0 ? i : (i < 8 && c32 >= 8 ? 7 - i : (c32 < 8 ? 7 - i : NLC - 1 - (i - 8)));
                        ab[j] = *(const f32x2*)(s + (size_t)cc * 1024); }
#pragma unroll
                    for (int j = 0; j < 8; ++j) if (i0 + j < nprev) h = ab[j][0] * h + ab[j][1]; }
            }
            float hs[4] = {0.f, 0.f, 0.f, 0.f}, ap = 1.f;
#pragma unroll
            for (int q = 0; q < 8; ++q) { const int qi = dir ? 7 - q : q, g = qi >> 1, hp = qi & 1;
                const bool mine = (hp == hh);
                const float A_ = mine ? GA[g] : PA[g], B_ = mine ? GB[g] : PB[g];
                hs[g] = mine ? h : hs[g];
                h = A_ * h + B_; ap *= A_; }
            if (mode == 0) { if (hh == 0) { float* s = lrs + ((size_t)((b * 2 + dir) * NLC + c32) * 512 + ch) * 2; s[0] = ap; s[1] = h; } }
            else {
#pragma unroll
                for (int g = 0; g < 4; ++g) { float hv = hs[g];
#pragma unroll
                    for (int q = 0; q < 4; ++q) { const int e = dir ? 3 - q : q, i = 4 * g + e; hv = aR[i] * hv + aI[i];
                        if (dir == 0) hf[i] = hv;
                        else { const int tok = 8 * g + 4 * hh + e; const size_t r = (size_t)b * TT + t0 + tok;
                            Yc[r * 512 + ch] = f2bf((hf[i] + hv) * gelu_tanh_f(bf2f(Py[r * 512 + ch]))); } } }
            }
        }
    }
}

constexpr int GP_PITCH = 264;
DI void gdn_prep_item(const Frame& F, int L, int b, int hd, int tt, LAS unsigned char* lds) {
    LAS float* qk = (LAS float*)lds;
    LAS bf16_t* rawl = (LAS bf16_t*)(lds + 65536);
    LAS float* sc = (LAS float*)(lds + 100912);
    LAS unsigned char* Qi = lds + 102960;
    LAS unsigned char* Ki = lds + 120368;
    LAS float* KKs = (LAS float*)(lds + 137776);
    LAS float* QKs = (LAS float*)(lds + 146224);
    const int t0 = tt * 64, seg_lo = t0 < CTX ? 0 : CTX, seg_hi = t0 < CTX ? CTX : TT;
    const bf16_t* Pq = F.slot(0); const bf16_t* Pk = F.slot(1); const bf16_t* Pv = F.slot(2);
    bf16_t* QH = (bf16_t*)(F.ws + WS_GQ); bf16_t* KH = QH + GQ_ELEMS; bf16_t* VH = KH + GQ_ELEMS;
    const float* ba = (const float*)(F.ws + WS_BA);
    const float* cw = F.inp(9) + (size_t)L * 4 * 1536;
    const size_t hrow = (size_t)(b * 4 + hd) * TT;
    { u32x4 pre[5];
#pragma unroll
      for (int j = 0; j < 5; ++j) { int id = F.tid + j * NT; id = id < 67 * 32 ? id : 67 * 32 - 1; const int row = id >> 5, c = id & 31; int t = t0 - 2 + row; t = t < seg_lo ? seg_lo : (t >= seg_hi ? seg_hi - 1 : t);
          const size_t r = (size_t)b * TT + t; pre[j] = *(const u32x4*)((c < 16 ? Pq : Pk) + r * 512 + hd * 128 + (c & 15) * 8); }
      __syncthreads();
#pragma unroll
      for (int j = 0; j < 5; ++j) { const int id = F.tid + j * NT; if (id < 67 * 32) { const int row = id >> 5, c = id & 31, t = t0 - 2 + row; const bool in = t >= seg_lo && t < seg_hi;
          u32x4 v = pre[j]; v.x = in ? v.x : 0u; v.y = in ? v.y : 0u; v.z = in ? v.z : 0u; v.w = in ? v.w : 0u; *(LAS u32x4*)(rawl + row * GP_PITCH + c * 8) = v; } } }
    __syncthreads();
    u32x4 prev[3];
#pragma unroll
    for (int j = 0; j < 3; ++j) { int id = F.tid + j * NT; id = id < 67 * 16 ? id : 67 * 16 - 1; const int row = id >> 4, c = id & 15; int t = t0 - 2 + row; t = t < seg_lo ? seg_lo : (t >= seg_hi ? seg_hi - 1 : t);
        prev[j] = *(const u32x4*)(Pv + ((size_t)b * TT + t) * 512 + hd * 128 + c * 8); }
    { const int c2 = F.tid & 255, th = F.tid >> 8, isk = c2 >> 7, dd = c2 & 127, wcn = isk * 512 + hd * 128 + dd;
      const float w0 = cw[0 * 1536 + wcn], w1 = cw[1 * 1536 + wcn], w2 = cw[2 * 1536 + wcn], w3 = cw[3 * 1536 + wcn];
      const int r0i = th * 32;
      float r0 = bf2f(rawl[(r0i + 0) * GP_PITCH + c2]), r1 = bf2f(rawl[(r0i + 1) * GP_PITCH + c2]), r2 = bf2f(rawl[(r0i + 2) * GP_PITCH + c2]);
#pragma unroll 8
      for (int i = 0; i < 32; ++i) { const float r3 = bf2f(rawl[(r0i + i + 3) * GP_PITCH + c2]);
          qk[(r0i + i) * 256 + c2] = silu_f(w0 * r0 + w1 * r1 + w2 * r2 + w3 * r3); r0 = r1; r1 = r2; r2 = r3; } }
    if (F.tid < 128) { const int tl = F.tid & 63, dir = F.tid >> 6; const size_t r = (size_t)b * TT + t0 + tl;
        const float neg_a = -__expf(F.inp(10)[(L * 2 + dir) * 4 + hd]), dtb = F.inp(11)[(L * 2 + dir) * 4 + hd];
        sc[tl * 8 + 2 + dir] = sigmoid_f(ba[r * 16 + dir * 4 + hd]);
        sc[tl * 8 + 4 + dir] = neg_a * softplus_f(ba[r * 16 + 8 + dir * 4 + hd] + dtb); }
    __syncthreads();
    { const int pair = F.tid >> 2, part = F.tid & 3, tl = pair >> 1, isk = pair & 1; float a = 0.f;
      for (int i = 0; i < 32; ++i) { const float x = qk[tl * 256 + isk * 128 + part * 32 + ((i + pair) & 31)]; a += x * x; }
      a += __shfl_xor(a, 1); a += __shfl_xor(a, 2);
      if (part == 0) sc[tl * 8 + isk] = rsqrtf(a + EPS) * (isk ? 1.f : 0.08838834764831845f); }
#pragma unroll
    for (int j = 0; j < 3; ++j) { const int id = F.tid + j * NT; if (id < 67 * 16) { const int row = id >> 4, c = id & 15, t = t0 - 2 + row; const bool in = t >= seg_lo && t < seg_hi;
        u32x4 v = prev[j]; v.x = in ? v.x : 0u; v.y = in ? v.y : 0u; v.z = in ? v.z : 0u; v.w = in ? v.w : 0u; *(LAS u32x4*)(rawl + row * GP_PITCH + c * 8) = v; } }
    __syncthreads();
    { const int c2 = F.tid & 255, th = F.tid >> 8, isk = c2 >> 7, dd = c2 & 127;
      bf16_t* dstg = (isk ? KH : QH) + (hrow + t0) * 128 + dd; LAS unsigned char* img = isk ? Ki : Qi;
#pragma unroll 8
      for (int i = 0; i < 32; ++i) { const int tl = th * 32 + i; const bf16_t v = f2bf(qk[tl * 256 + c2] * sc[tl * 8 + isk]);
          dstg[(size_t)tl * 128] = v; *(LAS bf16_t*)(img + tl * 272 + dd * 2) = v; } }
    { const int col = F.tid & 127, tq = F.tid >> 7, wcn = 1024 + hd * 128 + col;
      const float w0 = cw[0 * 1536 + wcn], w1 = cw[1 * 1536 + wcn], w2 = cw[2 * 1536 + wcn], w3 = cw[3 * 1536 + wcn];
      const int r0i = tq * 16;
      float r0 = bf2f(rawl[(r0i + 0) * GP_PITCH + col]), r1 = bf2f(rawl[(r0i + 1) * GP_PITCH + col]), r2 = bf2f(rawl[(r0i + 2) * GP_PITCH + col]);
#pragma unroll 8
      for (int i = 0; i < 16; ++i) { const float r3 = bf2f(rawl[(r0i + i + 3) * GP_PITCH + col]);
          VH[(hrow + t0 + r0i + i) * 128 + col] = f2bf(silu_f(w0 * r0 + w1 * r1 + w2 * r2 + w3 * r3)); r0 = r1; r1 = r2; r2 = r3; } }
    __syncthreads();
    const int l31 = F.lane & 31, hh = F.lane >> 5;
    if (F.wave < 4) { const int mat = F.wave >> 1, c = F.wave & 1;
        f32x16 acc;
#pragma unroll
        for (int i = 0; i < 16; ++i) acc[i] = 0.f;
#pragma unroll
        for (int s = 0; s < 8; ++s) { const bf16x8 A = *(const LAS bf16x8*)((mat ? Qi : Ki) + (32 * c + l31) * 272 + (16 * s + 8 * hh) * 2);
            const bf16x8 B = *(const LAS bf16x8*)(Ki + (32 * c + l31) * 272 + (16 * s + 8 * hh) * 2); acc = MFMA32(A, B, acc); }
        LAS float* dst = (mat ? QKs : KKs) + c * 1056;
#pragma unroll
        for (int i = 0; i < 16; ++i) dst[(8 * (i >> 2) + 4 * hh + (i & 3)) * 33 + l31] = acc[i]; }
    __syncthreads();
    if (F.wave < 4) { const int c = F.wave & 1, dir = F.wave >> 1, c32 = 2 * tt + c;
        LAS float* As = (LAS float*)lds + F.wave * 2112; LAS float* Tl = As + 1056;
        const size_t cd = ((size_t)(b * 4 + hd) * 2 + dir) * 72 + c32;
        const int p = l31, tau = dir ? 31 - p : p, tl = 32 * c + tau;
        const float bet = sc[tl * 8 + 2 + dir]; float G = sc[tl * 8 + 4 + dir];
#pragma unroll
        for (int o = 1; o < 32; o <<= 1) { const float up = __shfl_up(G, o, 32); G += (p >= o) ? up : 0.f; }
        const float Glast = __shfl(G, 31, 32);
        if (hh == 0) { float* gs = (float*)(F.ws + WS_GSC) + (cd * 32 + p) * 4; f32x4 v; v[0] = bet; v[1] = __expf(G); v[2] = __expf(Glast - G); v[3] = 0.f; *(f32x4*)gs = v; }
        const LAS float* KKc = KKs + c * 1056; const LAS float* QKc = QKs + c * 1056;
        bf16_t* Tg = (bf16_t*)(F.ws + WS_GT) + cd * 1024; bf16_t* QKg = (bf16_t*)(F.ws + WS_GQK) + cd * 1024;
        for (int i = 0; i < 32; ++i) { const float bi = __shfl(bet, i, 32), Gi = __shfl(G, i, 32); const int ti = dir ? 31 - i : i;
            const float dec = __expf(fminf(Gi - G, 0.f));
            const float a = (i > p) ? bi * KKc[ti * 33 + tau] * dec : 0.f;
            if (hh == 0) { As[i * 33 + p] = a; QKg[i * 32 + p] = f2bf((i >= p) ? QKc[ti * 33 + tau] * dec : 0.f); } }
        for (int i = 0; i < 32; ++i) { float s = (i == p) ? 1.f : 0.f;
#pragma unroll 8
            for (int j = 0; j < i; ++j) s -= As[i * 33 + j] * Tl[j * 33 + p];
            if (hh == 0) { Tl[i * 33 + p] = s; Tg[i * 32 + p] = f2bf(s); } }
    }
    __syncthreads();
}

constexpr int GS_KI = 0, GS_QI = 8448, GS_VI = 16896, GS_KT = 25344, GS_TI = 34560, GS_QK = 36864, GS_SC = 39168, GS_BUF = 40960;
DI bf16x8 frag8(const LAS unsigned char* base, int byteoff) { const s16x4 lo = *(const LAS s16x4*)(base + byteoff), hi = *(const LAS s16x4*)(base + byteoff + 16); return __builtin_shufflevector(lo, hi, 0, 1, 2, 3, 4, 5, 6, 7); }
DI bf16x8 pack8v(const f32x16& x, int s) {
    u32x4 p; p.x = pack2(x[8 * s], x[8 * s + 1]); p.y = pack2(x[8 * s + 2], x[8 * s + 3]); p.z = pack2(x[8 * s + 4], x[8 * s + 5]); p.w = pack2(x[8 * s + 6], x[8 * s + 7]);
    return __builtin_bit_cast(bf16x8, p);
}
DI void gdn_scan_item(const Frame& F, int L, int b, int hd, int dir, LAS unsigned char* lds) {
    const bf16_t* QH = (const bf16_t*)(F.ws + WS_GQ); const bf16_t* KH = QH + GQ_ELEMS; const bf16_t* VH = KH + GQ_ELEMS;
    const bf16_t* Tg = (const bf16_t*)(F.ws + WS_GT); const bf16_t* QKg = (const bf16_t*)(F.ws + WS_GQK); const float* gsc = (const float*)(F.ws + WS_GSC);
    bf16_t* og = F.slot(12 + dir);
    const size_t hrow = (size_t)(b * 4 + hd) * TT, cdb = ((size_t)(b * 4 + hd) * 2 + dir) * 72;
    const int l31 = F.lane & 31, hh = F.lane >> 5;
    auto chunk_of = [&](int s) { return dir == 0 ? s : (s < 8 ? 7 - s : 79 - s); };
    if (F.wave >= 4) {
        const int h = F.tid - 256;
        u32x4 rk[2], rq[2], rv[2], rt, rs;
        auto issue = [&](int s) { const int c32 = chunk_of(s < 72 ? s : 71); const size_t tb0 = hrow + (size_t)c32 * 32, cd = cdb + c32;
#pragma unroll
            for (int j = 0; j < 2; ++j) { const int id = h + 256 * j, r = id >> 4, c16 = id & 15; const size_t off = (tb0 + r) * 128 + c16 * 8;
                rk[j] = *(const u32x4*)(KH + off); rq[j] = *(const u32x4*)(QH + off); rv[j] = *(const u32x4*)(VH + off); }
            { const int id = h & 127; rt = *(const u32x4*)((h < 128 ? Tg : QKg) + cd * 1024 + id * 8); }
            rs = *(const u32x4*)(gsc + (cd * 32 + (h & 31)) * 4); };
        auto put = [&](LAS unsigned char* B) {
#pragma unroll
            for (int j = 0; j < 2; ++j) { const int id = h + 256 * j, r = id >> 4, c16 = id & 15, p = dir ? 31 - r : r;
                { u32x2 a; a.x = rk[j].x; a.y = rk[j].y; u32x2 c; c.x = rk[j].z; c.y = rk[j].w; *(LAS u32x2*)(B + GS_KI + p * 264 + c16 * 16) = a; *(LAS u32x2*)(B + GS_KI + p * 264 + c16 * 16 + 8) = c; }
                { u32x2 a; a.x = rq[j].x; a.y = rq[j].y; u32x2 c; c.x = rq[j].z; c.y = rq[j].w; *(LAS u32x2*)(B + GS_QI + p * 264 + c16 * 16) = a; *(LAS u32x2*)(B + GS_QI + p * 264 + c16 * 16 + 8) = c; }
                { u32x2 a; a.x = rv[j].x; a.y = rv[j].y; u32x2 c; c.x = rv[j].z; c.y = rv[j].w; *(LAS u32x2*)(B + GS_VI + p * 264 + c16 * 16) = a; *(LAS u32x2*)(B + GS_VI + p * 264 + c16 * 16 + 8) = c; }
                const unsigned kw[4] = {rk[j].x, rk[j].y, rk[j].z, rk[j].w};
#pragma unroll
                for (int e = 0; e < 4; ++e) { *(LAS bf16_t*)(B + GS_KT + (c16 * 8 + 2 * e) * 72 + p * 2) = (bf16_t)(kw[e] & 0xffffu); *(LAS bf16_t*)(B + GS_KT + (c16 * 8 + 2 * e + 1) * 72 + p * 2) = (bf16_t)(kw[e] >> 16); } }
            { const int id = h & 127, i = id >> 2, c = id & 3; LAS unsigned char* dst = B + (h < 128 ? GS_TI : GS_QK) + i * 72 + c * 16;
              u32x2 a; a.x = rt.x; a.y = rt.y; u32x2 c2; c2.x = rt.z; c2.y = rt.w; *(LAS u32x2*)dst = a; *(LAS u32x2*)(dst + 8) = c2; }
            if (h < 32) *(LAS u32x4*)(B + GS_SC + h * 16) = rs; };
        __syncthreads();
        issue(0); put(lds); issue(1);
        __syncthreads();
        for (int s = 0; s < 72; ++s) {
            if (s + 1 < 72) { put(lds + ((s + 1) & 1) * GS_BUF); issue(s + 2); }
            __syncthreads();
        }
    } else {
        const int eq = F.wave;
        f32x16 S[4];
#pragma unroll
        for (int m = 0; m < 4; ++m)
#pragma unroll
            for (int i = 0; i < 16; ++i) S[m][i] = 0.f;
        __syncthreads();
        __syncthreads();
#pragma unroll 1
        for (int s = 0; s < 72; ++s) {
            int ln_ = F.lane; asm volatile("" : "+v"(ln_));
            const int l31 = ln_ & 31, hh = ln_ >> 5;
            const LAS unsigned char* B = lds + (s & 1) * GS_BUF;
            const int c32 = chunk_of(s);
            f32x16 ks, oq;
#pragma unroll
            for (int i = 0; i < 16; ++i) { ks[i] = 0.f; oq[i] = 0.f; }
#pragma unroll
            for (int m = 0; m < 4; ++m)
#pragma unroll
                for (int t = 0; t < 2; ++t) { const bf16x8 Sp = pack8v(S[m], t);
                    ks = MFMA32(frag8(B + GS_KI, l31 * 264 + (32 * m + 16 * t + 4 * hh) * 2), Sp, ks);
                    oq = MFMA32(frag8(B + GS_QI, l31 * 264 + (32 * m + 16 * t + 4 * hh) * 2), Sp, oq); }
            f32x16 X;
#pragma unroll
            for (int i = 0; i < 16; ++i) { const int pos = 8 * (i >> 2) + 4 * hh + (i & 3); const f32x4 s4 = *(const LAS f32x4*)(B + GS_SC + pos * 16);
                const float v = bf2f(*(const LAS bf16_t*)(B + GS_VI + pos * 264 + (32 * eq + l31) * 2));
                X[i] = s4[0] * (v - s4[1] * ks[i]); oq[i] *= s4[1]; }
            f32x16 vn;
#pragma unroll
            for (int i = 0; i < 16; ++i) vn[i] = 0.f;
#pragma unroll
            for (int t = 0; t < 2; ++t) vn = MFMA32(frag8(B + GS_TI, l31 * 72 + (16 * t + 4 * hh) * 2), pack8v(X, t), vn);
            { const bf16x8 vp0 = pack8v(vn, 0), vp1 = pack8v(vn, 1);
              oq = MFMA32(frag8(B + GS_QK, l31 * 72 + (4 * hh) * 2), vp0, oq); oq = MFMA32(frag8(B + GS_QK, l31 * 72 + (16 + 4 * hh) * 2), vp1, oq); }
            { bf16_t* dst = og + ((size_t)b * TT + (size_t)c32 * 32) * 512 + hd * 128 + 32 * eq + l31;
#pragma unroll
              for (int i = 0; i < 16; ++i) { const int pos = 8 * (i >> 2) + 4 * hh + (i & 3), tk = dir ? 31 - pos : pos; dst[(size_t)tk * 512] = f2bf(oq[i]); } }
            const float gl = (*(const LAS f32x4*)(B + GS_SC + 31 * 16))[1];
#pragma unroll
            for (int i = 0; i < 16; ++i) { const int pos = 8 * (i >> 2) + 4 * hh + (i & 3); vn[i] *= (*(const LAS f32x4*)(B + GS_SC + pos * 16))[2]; }
            const bf16x8 wp0 = pack8v(vn, 0), wp1 = pack8v(vn, 1);
#pragma unroll
            for (int m = 0; m < 4; ++m) {
#pragma unroll
                for (int i = 0; i < 16; ++i) S[m][i] *= gl;
                S[m] = MFMA32(frag8(B + GS_KT, (32 * m + l31) * 72 + (4 * hh) * 2), wp0, S[m]);
                S[m] = MFMA32(frag8(B + GS_KT, (32 * m + l31) * 72 + (16 + 4 * hh) * 2), wp1, S[m]); }
            __syncthreads();
        }
    }
}

DI void gdn_post(const Frame& F, int L) {
    const int G = F.G; const bf16_t* of = F.slot(12); const bf16_t* obk = F.slot(13); const bf16_t* Pz = F.slot(3); bf16_t* Ya = F.slot(4);
    const float* gain = F.inp(12) + L * 128;
    for (int r = F.bid * 8 + F.wave; r < MROWS; r += G * 8) {
        const size_t off = (size_t)r * 512 + F.lane * 8;
        const u32x4 a = *(const u32x4*)(of + off), c = *(const u32x4*)(obk + off), z = *(const u32x4*)(Pz + off);
        const unsigned aa[4] = {a.x, a.y, a.z, a.w}, cc[4] = {c.x, c.y, c.z, c.w}, zz[4] = {z.x, z.y, z.z, z.w};
        float o[8]; float ss = 0.f;
#pragma unroll
        for (int q = 0; q < 4; ++q) { o[2 * q] = __uint_as_float(aa[q] << 16) + __uint_as_float(cc[q] << 16); o[2 * q + 1] = __uint_as_float(aa[q] & 0xffff0000u) + __uint_as_float(cc[q] & 0xffff0000u);
            ss += o[2 * q] * o[2 * q] + o[2 * q + 1] * o[2 * q + 1]; }
        ss = row16_sum(ss);
        const float rstd = rsqrtf(ss * (1.f / 128.f) + EPS);
        const int e0 = (F.lane & 15) * 8;
        float y[8];
#pragma unroll
        for (int q = 0; q < 4; ++q) { y[2 * q] = o[2 * q] * rstd * gain[e0 + 2 * q] * silu_f(__uint_as_float(zz[q] << 16)); y[2 * q + 1] = o[2 * q + 1] * rstd * gain[e0 + 2 * q + 1] * silu_f(__uint_as_float(zz[q] & 0xffff0000u)); }
        u32x4 w; w.x = pack2(y[0], y[1]); w.y = pack2(y[2], y[3]); w.z = pack2(y[4], y[5]); w.w = pack2(y[6], y[7]);
        *(u32x4*)(Ya + off) = w;
    }
}
DI bf16x8 pack8(const f32x16& x, int s) {
    u32x4 p; p.x = pack2(x[8 * s], x[8 * s + 1]); p.y = pack2(x[8 * s + 2], x[8 * s + 3]); p.z = pack2(x[8 * s + 4], x[8 * s + 5]); p.w = pack2(x[8 * s + 6], x[8 * s + 7]);
    return __builtin_bit_cast(bf16x8, p);
}
constexpr int AK_PITCH = 272, AV_PITCH = 136, AK_BYTES = 64 * AK_PITCH, AV_BYTES = 128 * AV_PITCH;

DI void attn_item(const Frame& F, int L, int b, int hd, int qt, float lam, float lam_init, float bound2, LAS unsigned char* lds) {
    const bf16_t* Qn = F.slot(9); const bf16_t* Kn = F.slot(10); const bf16_t* Vt = F.slot(11); bf16_t* Yb = F.slot(5);
    const int qbase = qt < 8 ? CTX + qt * 256 : 0, nkt = qt < 8 ? 36 : 4;
    int tid_ = F.tid; asm volatile("" : "+v"(tid_));
    const int lane_ = tid_ & 63, l31 = lane_ & 31, hh = lane_ >> 5;
    const int tq = qbase + 32 * F.wave + l31;
    LAS unsigned char* Kl = lds; LAS unsigned char* Vl = lds + AK_BYTES;
    LAS unsigned char* Ql = lds + AK_BYTES + AV_BYTES + F.wave * 8192 + lane_ * 16;
    __syncthreads();
#pragma unroll
    for (int c = 0; c < 2; ++c)
#pragma unroll
        for (int s = 0; s < 4; ++s) *(LAS bf16x8*)(Ql + (c * 4 + s) * 1024) = *(const bf16x8*)(Qn + ((size_t)((b * 4 + hd) * 2 + c) * TT + tq) * 64 + 16 * s + 8 * hh);
    f32x16 O[2][4];
#pragma unroll
    for (int c = 0; c < 2; ++c)
#pragma unroll
        for (int e = 0; e < 4; ++e)
#pragma unroll
            for (int i = 0; i < 16; ++i) O[c][e][i] = 0.f;
    float lsum[2] = {0.f, 0.f};
    const int kkey = tid_ >> 3, kch = tid_ & 7;
    const bf16_t* kb = Kn + (size_t)((b * 4 + hd) * 2) * TT * 64;
    const bf16_t* vbs = Vt + (size_t)(b * 4 + hd) * 128 * TT;
    const unsigned koff = (unsigned)(kkey * 64 + kch * 8);
    const int ve0 = tid_ >> 3, ve1 = ve0 + 64, vch = tid_ & 7;
    const unsigned voff = (unsigned)(ve0 * TT + vch * 8);
    u32x4 rk0, rk1, rv0, rv1;
    rk0 = *(const u32x4*)(kb + koff); rk1 = *(const u32x4*)(kb + TT * 64 + koff); rv0 = *(const u32x4*)(vbs + voff); rv1 = *(const u32x4*)(vbs + 64 * TT + voff);
    for (int kt = 0; kt < nkt; ++kt) {
        __syncthreads();
        *(LAS u32x4*)(Kl + kkey * AK_PITCH + kch * 16) = rk0;
        *(LAS u32x4*)(Kl + kkey * AK_PITCH + 128 + kch * 16) = rk1;
        { u32x2 a; a.x = rv0.x; a.y = rv0.y; u32x2 c; c.x = rv0.z; c.y = rv0.w; *(LAS u32x2*)(Vl + ve0 * AV_PITCH + vch * 16) = a; *(LAS u32x2*)(Vl + ve0 * AV_PITCH + vch * 16 + 8) = c; }
        { u32x2 a; a.x = rv1.x; a.y = rv1.y; u32x2 c; c.x = rv1.z; c.y = rv1.w; *(LAS u32x2*)(Vl + ve1 * AV_PITCH + vch * 16) = a; *(LAS u32x2*)(Vl + ve1 * AV_PITCH + vch * 16 + 8) = c; }
        __syncthreads();
        if (kt + 1 < nkt) { const bf16_t* kn = kb + (kt + 1) * 4096; const bf16_t* vn = vbs + (kt + 1) * 64;
            rk0 = *(const u32x4*)(kn + koff); rk1 = *(const u32x4*)(kn + TT * 64 + koff); rv0 = *(const u32x4*)(vn + voff); rv1 = *(const u32x4*)(vn + 64 * TT + voff); }
#pragma unroll 1
        for (int u = 0; u < 2; ++u) {
            bf16x8 Pf[2][2];
#pragma unroll
            for (int c = 0; c < 2; ++c) {
                f32x16 S;
#pragma unroll
                for (int i = 0; i < 16; ++i) S[i] = 0.f;
#pragma unroll
                for (int s = 0; s < 4; ++s) { const bf16x8 A = *(const LAS bf16x8*)(Kl + (32 * u + l31) * AK_PITCH + c * 128 + (16 * s + 8 * hh) * 2); const bf16x8 Bq = *(const LAS bf16x8*)(Ql + (c * 4 + s) * 1024); S = MFMA32(A, Bq, S); }
#pragma unroll
                for (int i = 0; i < 16; ++i) { S[i] = __builtin_amdgcn_exp2f(S[i] - bound2); lsum[c] += S[i]; }
                Pf[c][0] = pack8(S, 0); Pf[c][1] = pack8(S, 1);
            }
#pragma unroll
            for (int s = 0; s < 2; ++s) {
                __builtin_amdgcn_sched_barrier(0);
#pragma unroll
                for (int e = 0; e < 4; ++e) {
                    const LAS unsigned char* vb = Vl + (32 * e + l31) * AV_PITCH + (32 * u + 16 * s + 4 * hh) * 2;
                    const s16x4 lo = *(const LAS s16x4*)vb, hi = *(const LAS s16x4*)(vb + 16);
                    const bf16x8 A = __builtin_shufflevector(lo, hi, 0, 1, 2, 3, 4, 5, 6, 7);
                    O[0][e] = MFMA32(A, Pf[0][s], O[0][e]); O[1][e] = MFMA32(A, Pf[1][s], O[1][e]);
                }
            }
            __builtin_amdgcn_sched_barrier(0);
        }
    }
    const float l0 = lsum[0] + __shfl_xor(lsum[0], 32), l1 = lsum[1] + __shfl_xor(lsum[1], 32);
    const float i0 = 1.f / l0, i1 = lam / l1;
    float ss = 0.f;
#pragma unroll
    for (int e = 0; e < 4; ++e)
#pragma unroll
        for (int i = 0; i < 16; ++i) { const float o = O[0][e][i] * i0 - O[1][e][i] * i1; O[0][e][i] = o; ss += o * o; }
    ss += __shfl_xor(ss, 32);
    const float rstd = rsqrtf(ss * (1.f / 128.f) + EPS) * (1.f - lam_init);
    const float* og = F.inp(16) + L * 128;
    bf16_t* dst = Yb + ((size_t)b * TT + tq) * 512 + hd * 128;
#pragma unroll
    for (int e = 0; e < 4; ++e)
#pragma unroll
        for (int g = 0; g < 4; ++g) { const int e0 = 32 * e + 8 * g + 4 * hh; const f32x4 gv = *(const f32x4*)(og + e0);
            u32x2 w; w.x = pack2(O[0][e][4 * g] * rstd * gv[0], O[0][e][4 * g + 1] * rstd * gv[1]); w.y = pack2(O[0][e][4 * g + 2] * rstd * gv[2], O[0][e][4 * g + 3] * rstd * gv[3]);
            *(u32x2*)(dst + e0) = w; }
}

__global__ void __launch_bounds__(NT) mk_fwd(Params p) {
    extern __shared__ __attribute__((aligned(16))) unsigned char lds_raw[];
    LAS unsigned char* lds = (LAS unsigned char*)lds_raw;
    cg::grid_group grid = cg::this_grid();
    LAS int* tb = (LAS int*)(lds + LDS_MISC);
    LAS unsigned long long* itab = (LAS unsigned long long*)(lds + LDS_MISC + 256);
    LAS unsigned* scal = (LAS unsigned*)(lds + LDS_MISC + 512);
    if (threadIdx.x < 28) itab[threadIdx.x] = (unsigned long long)p.in[threadIdx.x];
    if (threadIdx.x == 0) { const unsigned long long w = (unsigned long long)p.ws, o = (unsigned long long)p.out;
        scal[0] = (unsigned)w; scal[1] = (unsigned)(w >> 32); scal[2] = (unsigned)o; scal[3] = (unsigned)(o >> 32); scal[4] = gridDim.x; scal[5] = blockIdx.x; }
    __syncthreads();
    for (int ph = p.ph_lo; ph < p.ph_hi; ++ph) {
        int tid_ = threadIdx.x; asm volatile("" : "+v"(tid_));
        const unsigned w0 = __builtin_amdgcn_readfirstlane(scal[0]), w1 = __builtin_amdgcn_readfirstlane(scal[1]), o0 = __builtin_amdgcn_readfirstlane(scal[2]), o1 = __builtin_amdgcn_readfirstlane(scal[3]);
        unsigned char* ws_ = (unsigned char*)(((unsigned long long)w1 << 32) | w0); float* out_ = (float*)(((unsigned long long)o1 << 32) | o0);
        const int G = __builtin_amdgcn_readfirstlane(scal[4]), bid = __builtin_amdgcn_readfirstlane(scal[5]);
        Frame F; F.itab = itab; F.out = out_; F.ws = ws_; F.tid = tid_; F.lane = tid_ & 63; F.wave = __builtin_amdgcn_readfirstlane(tid_ >> 6); F.G = G; F.bid = bid;
        if (ph == 0) { phase0(F, lds); convert_weights(F, 0, lds); }
        else if (ph == 23) final_phase(F);
        else {
            const int L = (ph - 1) / 11, k = (ph - 1) % 11;
            bf16_t* wb = F.wb(L);
            if (k == 0) { norm_phase(F, L, 1, lds); if (L == 1) convert_weights(F, 1, lds); }
            else if (k == 1) {
                pg8::Gemm g{F.h(), wb + W_IN, 1024}; pg8::StaticOrder S{72, 18, G, bid};
                pg8::EpiSlots E{F.slot(0), {0, 1, 2, 3, 4, 5, 6, 7, 8}};
                pg8::gemm_phase(lds, g, S, E, F.tid);
            } else if (k == 2) {
                const int sub = p.sub;
                if (sub & 2) { rope_table(F, lds);
                for (int it = bid; it < 288; it += G) attn_prep_item(F, L, it / 36, it % 36, lds); }
                if (sub & 4) for (int it = bid; it < NB * NLC; it += G) lru_chunk(F, L, it / NLC, it % NLC, 0, lds);
                if (sub & 1) for (int it = bid; it < 1152; it += G) { const int rem = it % 144; gdn_prep_item(F, L, it / 144, rem / 36, rem % 36, lds); }
            } else if (k == 3) {
                const int sub = p.sub;
                if (sub & 1) for (int it = bid; it < 64; it += G) gdn_scan_item(F, L, it >> 3, (it >> 1) & 3, it & 1, lds);
                if (sub & 2) { const float* lv = F.inp(15) + L * 256; float s01 = 0.f, s23 = 0.f;
                  for (int i = 0; i < 64; ++i) { s01 += lv[i] * lv[64 + i]; s23 += lv[128 + i] * lv[192 + i]; }
                  const float lam_init = 0.8f - 0.6f * expf(-0.3f * (float)L);
                  const float lam = expf(s01) - expf(s23) + lam_init;
                  float mq = 0.f, mk = 0.f;
                  for (int i = 0; i < 64; ++i) { mq = fmaxf(mq, fabsf(F.inp(13)[L * 64 + i])); mk = fmaxf(mk, fabsf(F.inp(14)[L * 64 + i])); }
                  const float bound2 = 8.f * mq * mk * 1.4426950408889634f;
                  const int nat = L == 0 ? 288 : 256;
                  for (int it = bid; it < nat; it += G) { if (it < 256) attn_item(F, L, it >> 5, (it >> 3) & 3, it & 7, lam, lam_init, bound2, lds);
                      else attn_item(F, L, (it - 256) >> 2, (it - 256) & 3, 8, lam, lam_init, bound2, lds); } }
                if (sub & 4) for (int it = bid; it < NB * NLC; it += G) lru_chunk(F, L, it / NLC, it % NLC, 1, lds);
            } else if (k == 4) {
                gdn_post(F, L);
                pg8::Gemm g{F.h(), wb + W_IN + (size_t)4608 * 1024, 1024}; pg8::StaticOrder S{72, 12, G, bid};
                pg8::EpiSlots E{F.slot(0), {0, 1, 2, 9, 10, 11, 0, 0, 0}};
                pg8::gemm_phase(lds, g, S, E, F.tid);
            } else if (k == 5) {
                pg8::Gemm g{F.slot(4), wb + W_BR, 512}; pg8::MergeOrder S{G, bid};
                pg8::EpiMerge E{F.h(), F.slot(0)};
                pg8::gemm_phase(lds, g, S, E, F.tid);
            } else if (k == 6) {
                pg8::Gemm g{F.h(), wb + W_OUT, 1024}; pg8::StaticOrder S{72, 4, G, bid};
                pg8::EpiResid E{F.xs(), F.mod(L, 0)};
                pg8::gemm_phase(lds, g, S, E, F.tid);
            } else if (k == 7) norm_phase(F, L, 2, lds);
            else if (k == 8) sort_phase(F, L, tb);
            else if (k == 9) {
                moe_tile_bases(F, L, tb);
                pg8::Gemm g{F.slot(0), wb + W_GU, 1024}; pg8::MoeOrder S{tb, G, bid};
                pg8::EpiMoe1 E{F.slot(5)};
                pg8::gemm_phase(lds, g, S, E, F.tid);
            } else {
                moe_tile_bases(F, L, tb);
                pg8::Gemm g{F.slot(5), wb + W_DN, 512}; pg8::MoeOrder S{tb, G, bid};
                pg8::EpiMoe2 E{F.slot(8)};
                pg8::gemm_phase(lds, g, S, E, F.tid);
            }
        }
        if (ph + 1 < p.ph_hi) grid.sync();
    }
}

extern "C" void kernel_launch(void* const* d_in, const int* in_sizes, int n_in, void* d_out, int out_size, void* d_ws, size_t ws_size, hipStream_t stream) {
    static int grid = 0;
    if (grid == 0) {
        if (n_in != 28 || out_size != NB * SEQ * DM || ws_size < WS_END) { fprintf(stderr, "kernel_launch: unexpected shapes (n_in %d out %d ws %zu need %zu)\n", n_in, out_size, ws_size, (size_t)WS_END); grid = -1; return; }
        int dev = 0, cus = 0, per_cu = 0;
        hipGetDevice(&dev); hipDeviceGetAttribute(&cus, hipDeviceAttributeMultiprocessorCount, dev);
        hipFuncSetAttribute((const void*)mk_fwd, hipFuncAttributeMaxDynamicSharedMemorySize, LDS_BYTES);
        hipOccupancyMaxActiveBlocksPerMultiprocessor(&per_cu, (const void*)mk_fwd, NT, LDS_BYTES);
        if (per_cu < 1) { fprintf(stderr, "kernel_launch: occupancy query says %d blocks per CU\n", per_cu); per_cu = 1; }
        grid = cus;
        (void)hipGetLastError();
    }
    if (grid < 0) return;
    hipMemsetAsync((char*)d_ws + WS_CTL, 0, ZERO_BYTES, stream);
    Params p{};
    for (int i = 0; i < 28; ++i) p.in[i] = (const float*)d_in[i];
    p.out = (float*)d_out; p.ws = (unsigned char*)d_ws;
#if defined(MK_PER_PHASE)
#ifndef MK_SUB
#define MK_SUB 7
#endif
    for (int ph = 0; ph < 24; ++ph) { p.ph_lo = ph; p.ph_hi = ph + 1;
        int nrep = (ph >= 1 && ph < 23 && ((MK_PER_PHASE >> ((ph - 1) % 11)) & 2)) ? 2 : 1;
        if (ph == 0 && (MK_PER_PHASE & (1 << 13))) nrep = 2; if (ph == 23 && (MK_PER_PHASE & (1 << 14))) nrep = 2; if (ph == 1 && (MK_PER_PHASE & (1 << 15))) nrep = 2;
        for (int rep = 0; rep < nrep; ++rep) { p.sub = rep == 0 ? 7 : MK_SUB; hipLaunchKernelGGL(mk_fwd, dim3(grid), dim3(NT), LDS_BYTES, stream, p); } }
#else
    p.ph_lo = 0; p.ph_hi = 24; p.sub = 7;
    void* args[] = {&p};
    hipError_t e = hipLaunchCooperativeKernel((const void*)mk_fwd, dim3(grid), dim3(NT), args, LDS_BYTES, stream);
    if (e != hipSuccess) fprintf(stderr, "cooperative launch failed: %s (grid %d)\n", hipGetErrorString(e), grid);
#endif
}
```

```cpp
#include <hip/hip_runtime.h>
#include <hip/hip_cooperative_groups.h>
#include <cstdio>
namespace cg = cooperative_groups;

#define DI __device__ __forceinline__
#define LAS __attribute__((address_space(3)))
typedef unsigned short bf16_t;
typedef short bf16x8 __attribute__((ext_vector_type(8)));
typedef short s16x4 __attribute__((ext_vector_type(4)));
typedef float f32x4 __attribute__((ext_vector_type(4)));
typedef float f32x2 __attribute__((ext_vector_type(2)));
typedef float f32x16 __attribute__((ext_vector_type(16)));
typedef unsigned u32x4 __attribute__((ext_vector_type(4)));
typedef unsigned u32x2 __attribute__((ext_vector_type(2)));

constexpr int NB = 8, SEQ = 2048, CTX = 256, TT = 2304, DM = 1024, MROWS = NB * TT, NLAYER = 2;
constexpr int PW = 7696;
constexpr int NT = 512;
constexpr float EPS = 1e-6f;
constexpr size_t SLOT_ELEMS = (size_t)MROWS * 512;
constexpr int MPAD = 40960;
constexpr int NLC = 72;

constexpr size_t W_IN = 0, W_BR = W_IN + (size_t)7680 * 1024, W_OUT = W_BR + (size_t)3 * 1024 * 512, W_GU = W_OUT + (size_t)1024 * 1024,
                 W_DN = W_GU + (size_t)16 * 1024 * 1024, W_LAYER = W_DN + (size_t)16 * 1024 * 512;

constexpr size_t WS_CTL = 0;
constexpr size_t WS_MOD = 65536;
constexpr size_t ZERO_BYTES = WS_MOD + (size_t)2 * 9 * 6144 * 4;
constexpr size_t WS_WSM = 524288;
constexpr size_t WS_WRT = WS_WSM + (size_t)2 * 16 * 1024 * 4;
constexpr size_t WS_BA = WS_WRT + (size_t)16 * 1024 * 4;
constexpr size_t WS_LRS = WS_BA + (size_t)MROWS * 16 * 4;
constexpr size_t WS_ROUTE = WS_LRS + (size_t)NB * 2 * NLC * 512 * 2 * 4;
constexpr size_t WS_WGT = WS_ROUTE + (size_t)MROWS * 8 * 4;
constexpr size_t WS_GSC = WS_WGT + (size_t)2 * 131072 * 2;
constexpr size_t NCD = (size_t)NB * 4 * 2 * 72;
constexpr size_t WS_GT = WS_GSC + NCD * 32 * 4 * 4;
constexpr size_t WS_GQK = WS_GT + NCD * 1024 * 2;
constexpr size_t WS_GQ = WS_GQK + NCD * 1024 * 2;
constexpr size_t GQ_ELEMS = (size_t)NB * 4 * TT * 128;
constexpr size_t WS_WB = WS_GQ + 3 * GQ_ELEMS * 2;
constexpr size_t WS_XS = WS_WB + (size_t)W_LAYER * 2;
constexpr size_t WS_H = WS_XS + (size_t)MROWS * 1024 * 4;
constexpr size_t WS_SLOT = WS_H + (size_t)MROWS * 1024 * 2;
constexpr size_t WS_END = WS_SLOT + (size_t)14 * SLOT_ELEMS * 2;
static_assert(WS_END <= (size_t)536870912, "workspace layout exceeds 512 MiB");

struct Params {
    const float* in[28];
    float* out;
    unsigned char* ws;
    int ph_lo, ph_hi, sub, pad;
};

struct Frame {
    const LAS unsigned long long* itab;
    float* out;
    unsigned char* ws;
    int tid, lane, wave, G, bid;
    DI const float* inp(int i) const { const unsigned long long v = itab[i];
        const unsigned lo = __builtin_amdgcn_readfirstlane((unsigned)v), hi = __builtin_amdgcn_readfirstlane((unsigned)(v >> 32));
        return (const float*)(const __attribute__((address_space(1))) float*)(((unsigned long long)hi << 32) | lo); }
    DI bf16_t* slot(int s) const { return (bf16_t*)(ws + WS_SLOT) + (size_t)s * SLOT_ELEMS; }
    DI bf16_t* wb(int) const { return (bf16_t*)(ws + WS_WB); }
    DI float* mod(int L, int mi) const { return (float*)(ws + WS_MOD) + (size_t)(L * 9 + mi) * 6144; }
    DI float* xs() const { return (float*)(ws + WS_XS); }
    DI bf16_t* h() const { return (bf16_t*)(ws + WS_H); }
    DI unsigned* ctl() const { return (unsigned*)(ws + WS_CTL); }
    DI unsigned* route() const { return (unsigned*)(ws + WS_ROUTE); }
};

DI float bf2f(bf16_t b) { return __uint_as_float(((unsigned)b) << 16); }
DI bf16_t f2bf(float f) { return __builtin_bit_cast(unsigned short, (__bf16)f); }
DI unsigned pack2(float a, float b) { typedef __bf16 v2 __attribute__((ext_vector_type(2))); v2 v; v[0] = (__bf16)a; v[1] = (__bf16)b; return __builtin_bit_cast(unsigned, v); }
DI float sigmoid_f(float x) { return __builtin_amdgcn_rcpf(1.f + __expf(-x)); }
DI float silu_f(float x) { return x * __builtin_amdgcn_rcpf(1.f + __expf(-x)); }
DI float softplus_f(float x) { return fmaxf(x, 0.f) + log1pf(__expf(-fabsf(x))); }
DI float gelu_tanh_f(float x) { const float u = 0.7978845608028654f * (x + 0.044715f * x * x * x); return x * __builtin_amdgcn_rcpf(1.f + __expf(-2.f * u)); }
DI float neg_expm1_f(float x) { const float p = -x * (1.f + x * (0.5f + x * (0.16666667f + x * (0.041666668f + x * (0.0083333338f + x * 0.0013888889f))))); return x > -0.25f ? p : 1.f - __expf(x); }
DI float wave_sum(float v) {
#pragma unroll
    for (int o = 32; o >= 1; o >>= 1) v += __shfl_xor(v, o);
    return v;
}
template <int CTRL> DI float dpp_add(float v) { return v + __int_as_float(__builtin_amdgcn_update_dpp(0, __float_as_int(v), CTRL, 0xf, 0xf, false)); }
DI float row16_sum_dpp(float v) { v = dpp_add<0xB1>(v); v = dpp_add<0x4E>(v); v = dpp_add<0x124>(v); v = dpp_add<0x128>(v); return v; }
DI float wave_sum_fast(float v) { v = row16_sum_dpp(v); v += __shfl_xor(v, 16); v += __shfl_xor(v, 32); return v; }
DI int modidx(int r) { const int b = r / TT, t = r - b * TT; return t < CTX ? 8 : b; }
#define MFMA32(a, b, c) __builtin_amdgcn_mfma_f32_32x32x16_bf16((a), (b), (c), 0, 0, 0)
namespace pg8 {
constexpr int BM = 256, BK = 64, HALF = 128, HTB = HALF * BK * 2  , STAGE_BYTES = 8 * HTB, NXCD = 8, WGM = 8;

__host__ __device__ __forceinline__ int lds_byte(int r, int c) { const int st = (r >> 4) * 2 + (c >> 5), rr = r & 15, cc = c & 31, ob = rr * 64 + cc * 2; return st * 1024 + (ob ^ (((ob >> 9) & 1) << 5)); }
__host__ __device__ __forceinline__ void stage_rc(int b, int& R, int& C) { const int st = b / 1024, sb = b % 1024, swz = sb ^ (((sb >> 9) & 1) << 5); R = (st >> 1) * 16 + swz / 64; C = (st & 1) * 32 + (swz % 64) / 2; }
__host__ __device__ __forceinline__ int perm32(int rho) { const int n = rho >> 4, i = rho & 15; return 8 * (i >> 2) + 4 * n + (i & 3); }

struct Unit { int pm, pn; };
struct Gemm { const bf16_t* A; const bf16_t* Bt; int K; };

DI bool grid_unit(int nM, int nN, long L, Unit& u) {
    const int nwg = nM * nN; if (L >= nwg) return false;
    int wgid = (int)L; { const int q = nwg / NXCD, r = nwg % NXCD, xcd = wgid % NXCD, off = wgid / NXCD; wgid = (xcd < r ? xcd * (q + 1) : r * (q + 1) + (xcd - r) * q) + off; }
    const int nig = WGM * nN, gid = wgid / nig, fm = gid * WGM, gsz = (nM - fm) < WGM ? (nM - fm) : WGM;
    u.pm = fm + ((wgid % nig) % gsz); u.pn = (wgid % nig) / gsz; return true;
}
DI int lat_tile(int j) { return (j >> 3) * 9 + 1 + (j & 7); }
struct StaticOrder {
    int nM, nN, G, c, lat;
    DI bool next(int i, Unit& u) const { if (!grid_unit(lat ? 64 : nM, nN, (long)i * G + c, u)) return false; if (lat) u.pm = lat_tile(u.pm); return true; }
};
struct MergeOrder {
    int G, c, lat;
    DI bool next(int i, Unit& u) const {
        const int n = i % 3; Unit t; if (!grid_unit(lat ? 64 : 72, 4, (long)(i / 3) * G + c, t)) return false;
        if (lat) t.pm = lat_tile(t.pm);
        u.pm = n * 72 + t.pm; u.pn = n * 4 + t.pn; return true;
    }
};
struct MoeOrder {
    const LAS int* tb; int G, c;
    DI bool next(int i, Unit& u) const {
        const long L = (long)i * G + c; const int total = __builtin_amdgcn_readfirstlane(tb[16]) * 4; if (L >= total) return false;
        const int pm = (int)(L >> 2), j = (int)(L & 3); int e = 0;
#pragma unroll
        for (int q = 1; q < 16; ++q) e += (pm >= __builtin_amdgcn_readfirstlane(tb[q])) ? 1 : 0;
        u.pm = pm; u.pn = e * 4 + j; return true;
    }
};

typedef f32x4 (&AccRef)[2][2][4][2];

struct EpiSlots {
    static constexpr bool PERM = true;
    bf16_t* base; int smap[9];
    DI bool operator()(AccRef acc, const Unit& u, int wr, int wc, int fr, int fq) const {
        int sl = 0;
#pragma unroll
        for (int q = 0; q < 9; ++q) sl = ((u.pn >> 1) == q) ? smap[q] : sl;
        bf16_t* O = base + (size_t)sl * SLOT_ELEMS;
        const int row0 = u.pm * BM + wr * 64 + fr, col0 = (u.pn & 1) * 256 + wc * 32 + 8 * fq;
#pragma unroll
        for (int ai = 0; ai < 2; ++ai)
#pragma unroll
            for (int m = 0; m < 4; ++m) { bf16_t* rowp = O + (size_t)(row0 + ai * HALF + m * 16) * 512 + col0;
#pragma unroll
                for (int bj = 0; bj < 2; ++bj) { const f32x4 v0 = acc[ai][bj][m][0], v1 = acc[ai][bj][m][1];
                    u32x4 w; w.x = pack2(v0[0], v0[1]); w.y = pack2(v0[2], v0[3]); w.z = pack2(v1[0], v1[1]); w.w = pack2(v1[2], v1[3]);
                    *(u32x4*)(rowp + bj * HALF) = w; } }
        return false;
    }
};
struct EpiMerge {
    static constexpr bool PERM = true;
    bf16_t* merged; const bf16_t* slots;
    DI bool operator()(AccRef acc, const Unit& u, int wr, int wc, int fr, int fq) const {
        const int n = u.pm / 72, pm = u.pm - n * 72, pn = u.pn & 3;
        const int row0 = pm * BM + wr * 64 + fr, col0 = pn * 256 + wc * 32 + 8 * fq;
        const int j = 2 * n + (col0 >> 9), gs = j < 3 ? j : j + 6;
        const int j2 = n < 2 ? j + 2 : j, gs2 = j2 < 3 ? j2 : j2 + 6;
        const bf16_t* G = slots + (size_t)gs * SLOT_ELEMS; const bf16_t* G2 = slots + (size_t)gs2 * SLOT_ELEMS;
        const int gcol0 = col0 & 511;
#pragma unroll
        for (int ai = 0; ai < 2; ++ai)
#pragma unroll
            for (int m = 0; m < 4; ++m) { const size_t row = (size_t)(row0 + ai * HALF + m * 16);
#pragma unroll
                for (int bj = 0; bj < 2; ++bj) {
                    const u32x4 gw = *(const u32x4*)(G + row * 512 + gcol0 + bj * HALF);
                    const unsigned gg[4] = {gw.x, gw.y, gw.z, gw.w};
                    float f[8];
#pragma unroll
                    for (int q = 0; q < 4; ++q) { f[2 * q] = sigmoid_f(__uint_as_float(gg[q] << 16)); f[2 * q + 1] = sigmoid_f(__uint_as_float(gg[q] & 0xffff0000u)); }
                    if (n < 2) {
                        const u32x4 hw = *(const u32x4*)(G2 + row * 512 + gcol0 + bj * HALF);
                        const unsigned hh2[4] = {hw.x, hw.y, hw.z, hw.w};
#pragma unroll
                        for (int q = 0; q < 4; ++q) { f[2 * q] *= 1.f + __expf(-__uint_as_float(hh2[q] << 16)); f[2 * q + 1] *= 1.f + __expf(-__uint_as_float(hh2[q] & 0xffff0000u)); }
#pragma unroll
                        for (int q = 0; q < 4; ++q) { acc[ai][bj][m][0][q] *= f[q]; acc[ai][bj][m][1][q] *= f[4 + q]; }
                    } else {
                        bf16_t* mp = merged + row * 1024 + col0 + bj * HALF;
                        float v[8];
#pragma unroll
                        for (int q = 0; q < 4; ++q) { v[q] = acc[ai][bj][m][0][q] * f[q]; v[4 + q] = acc[ai][bj][m][1][q] * f[4 + q]; }
                        u32x4 w; w.x = pack2(v[0], v[1]); w.y = pack2(v[2], v[3]); w.z = pack2(v[4], v[5]); w.w = pack2(v[6], v[7]);
                        *(u32x4*)mp = w; } } }
        return n < 2;
    }
};
struct EpiResid {
    static constexpr bool PERM = false;
    float* xs; const float* modL; bool dry;
    DI bool operator()(AccRef acc, const Unit& u, int wr, int wc, int fr, int fq) const {
        const int row0 = u.pm * BM + wr * 64 + fr, col0 = u.pn * BM + wc * 32 + 4 * fq;
#pragma unroll
        for (int ai = 0; ai < 2; ++ai)
#pragma unroll
            for (int m = 0; m < 4; ++m) { const int row = row0 + ai * HALF + m * 16; float* rowp = xs + (size_t)row * 1024 + col0;
                const float* g = modL + (size_t)modidx(row) * 6144 + 2048 + col0;
#pragma unroll
                for (int bj = 0; bj < 2; ++bj)
#pragma unroll
                    for (int n = 0; n < 2; ++n) { const f32x4 gv = *(const f32x4*)(g + bj * HALF + n * 16); f32x4 x = *(f32x4*)(rowp + bj * HALF + n * 16);
                        x += gv * acc[ai][bj][m][n]; if (!dry) *(f32x4*)(rowp + bj * HALF + n * 16) = x; } }
        return false;
    }
};
struct EpiMoe1 {
    static constexpr bool PERM = true;
    bf16_t* act;
    DI bool operator()(AccRef acc, const Unit& u, int wr, int wc, int fr, int fq) const {
        const int row0 = u.pm * BM + wr * 64 + fr, col0 = (u.pn & 3) * 128 + wc * 32 + 8 * fq;
#pragma unroll
        for (int ai = 0; ai < 2; ++ai)
#pragma unroll
            for (int m = 0; m < 4; ++m) { bf16_t* rowp = act + (size_t)(row0 + ai * HALF + m * 16) * 512 + col0;
                float v[8];
#pragma unroll
                for (int q = 0; q < 4; ++q) { v[q] = silu_f(acc[ai][0][m][0][q]) * acc[ai][1][m][0][q]; v[4 + q] = silu_f(acc[ai][0][m][1][q]) * acc[ai][1][m][1][q]; }
                u32x4 w; w.x = pack2(v[0], v[1]); w.y = pack2(v[2], v[3]); w.z = pack2(v[4], v[5]); w.w = pack2(v[6], v[7]);
                *(u32x4*)rowp = w; }
        return false;
    }
};
struct EpiMoe2 {
    static constexpr bool PERM = true;
    bf16_t* ys;
    DI bool operator()(AccRef acc, const Unit& u, int wr, int wc, int fr, int fq) const {
        const int row0 = u.pm * BM + wr * 64 + fr, col0 = (u.pn & 3) * 256 + wc * 32 + 8 * fq;
#pragma unroll
        for (int ai = 0; ai < 2; ++ai)
#pragma unroll
            for (int m = 0; m < 4; ++m) { bf16_t* rowp = ys + (size_t)(row0 + ai * HALF + m * 16) * 1024 + col0;
#pragma unroll
                for (int bj = 0; bj < 2; ++bj) { const f32x4 v0 = acc[ai][bj][m][0], v1 = acc[ai][bj][m][1];
                    u32x4 w; w.x = pack2(v0[0], v0[1]); w.y = pack2(v0[2], v0[3]); w.z = pack2(v1[0], v1[1]); w.w = pack2(v1[2], v1[3]);
                    *(u32x4*)(rowp + bj * HALF) = w; } }
        return false;
    }
};

template <class Epi, class Sched>
DI void gemm_phase(LAS unsigned char* lds, const Gemm g, const Sched& S, const Epi& E, const int tid) {
    const int wid = __builtin_amdgcn_readfirstlane(tid >> 6), lane = tid & 63, wr = wid >> 2, wc = wid & 3, fr = lane & 15, fq = lane >> 4;
    const int K = g.K, nt = K / BK;
    unsigned voffA[2], voffB[2];
#pragma unroll
    for (int i = 0; i < 2; ++i) { int R, C; stage_rc(tid * 16 + i * 8192, R, C); const int Rb = Epi::PERM ? ((R & ~31) + perm32(R & 31)) : R;
        voffA[i] = (unsigned)(R * K + C) * 2u; voffB[i] = (unsigned)(Rb * K + C) * 2u; }
    const size_t kstep = (size_t)(BK * 2);
    const size_t hstep = (size_t)HALF * K * 2;
    const size_t tstep = 2 * hstep;
    const unsigned ldsw = (unsigned)wid * 1024u;
    const int aoff = lds_byte(wr * 64 + fr, fq * 8), boff = lds_byte(wc * 32 + fr, fq * 8);
#define PG8_SA(b, h) (((b) * 2 + (h)) * HTB)
#define PG8_SB(b, h) ((4 + (b) * 2 + (h)) * HTB)
#define PG8_STAGE(bufoff, gbase, voff) do { _Pragma("unroll") for (int _i = 0; _i < 2; ++_i) \
        __builtin_amdgcn_global_load_lds((const unsigned*)((const char*)(gbase) + (voff)[_i]), (LAS unsigned*)(lds + (bufoff) + ldsw + _i * 8192), 16, 0, 0); } while (0)
#define PG8_LDA(dst, b, h) do { _Pragma("unroll") for (int m = 0; m < 4; ++m) _Pragma("unroll") for (int k = 0; k < 2; ++k) dst[m][k] = *(const LAS bf16x8*)(lds + PG8_SA(b, h) + aoff + m * 2048 + k * 1024); } while (0)
#define PG8_LDB(dst, b, h) do { _Pragma("unroll") for (int n = 0; n < 2; ++n) _Pragma("unroll") for (int k = 0; k < 2; ++k) dst[n][k] = *(const LAS bf16x8*)(lds + PG8_SB(b, h) + boff + n * 2048 + k * 1024); } while (0)
#define PG8_MMA(ai, bj, At, Bt) do { __builtin_amdgcn_s_setprio(1); _Pragma("unroll") for (int m = 0; m < 4; ++m) _Pragma("unroll") for (int n = 0; n < 2; ++n) _Pragma("unroll") for (int k = 0; k < 2; ++k) \
        acc[ai][bj][m][n] = __builtin_amdgcn_mfma_f32_16x16x32_bf16(Bt[n][k], At[m][k], acc[ai][bj][m][n], 0, 0, 0); __builtin_amdgcn_s_setprio(0); } while (0)
#define PG8_WAIT_V(n) asm volatile("s_waitcnt vmcnt(" #n ")" ::: "memory")
#define PG8_WAIT_L(n) asm volatile("s_waitcnt lgkmcnt(" #n ")" ::: "memory")
#define PG8_BAR __builtin_amdgcn_s_barrier()
#define PG8_SCHED __builtin_amdgcn_sched_barrier(0)
    Unit cur, nxt; int ui = 0;
    if (!S.next(0, cur)) return;
    f32x4 acc[2][2][4][2];
#pragma unroll
    for (int a = 0; a < 2; ++a)
#pragma unroll
        for (int b = 0; b < 2; ++b)
#pragma unroll
            for (int m = 0; m < 4; ++m)
#pragma unroll
                for (int n = 0; n < 2; ++n) acc[a][b][m][n] = (f32x4){0.f, 0.f, 0.f, 0.f};
    bf16x8 At[4][2], B0[2][2], B1[2][2];
    const char* cA = (const char*)g.A + (size_t)cur.pm * tstep; const char* cB = (const char*)g.Bt + (size_t)cur.pn * tstep;
    PG8_STAGE(PG8_SB(0, 0), cB, voffB); PG8_STAGE(PG8_SA(0, 0), cA, voffA); PG8_STAGE(PG8_SB(0, 1), cB + hstep, voffB); PG8_STAGE(PG8_SA(0, 1), cA + hstep, voffA);
    if (wr == 1) PG8_BAR;
    PG8_WAIT_V(4); PG8_BAR;
    PG8_STAGE(PG8_SB(1, 0), cB + kstep, voffB); PG8_STAGE(PG8_SA(1, 0), cA + kstep, voffA); PG8_STAGE(PG8_SB(1, 1), cB + hstep + kstep, voffB);
    PG8_WAIT_V(6); PG8_BAR;
    for (;;) {
        const bool has_next = S.next(ui + 1, nxt);
        const char* nA = has_next ? (const char*)g.A + (size_t)nxt.pm * tstep : cA; const char* nB = has_next ? (const char*)g.Bt + (size_t)nxt.pn * tstep : cB;
        for (int t = 0; t < nt; t += 2) {
            const bool last = (t == nt - 2);
            const char* a1 = cA + (size_t)(t + 1) * kstep;
            const char* a2 = last ? nA : cA + (size_t)(t + 2) * kstep; const char* b2 = last ? nB : cB + (size_t)(t + 2) * kstep;
            const char* a3 = a2 + kstep; const char* b3 = b2 + kstep;
            PG8_LDB(B0, 0, 0); PG8_SCHED; PG8_LDA(At, 0, 0); PG8_STAGE(PG8_SA(1, 1), a1 + hstep, voffA);
            PG8_WAIT_L(8); PG8_BAR; PG8_WAIT_L(0); PG8_MMA(0, 0, At, B0); PG8_BAR; PG8_SCHED;
            PG8_LDB(B1, 0, 1); PG8_STAGE(PG8_SB(0, 0), b2, voffB);
            PG8_BAR; PG8_WAIT_L(0); PG8_MMA(0, 1, At, B1); PG8_BAR;
            PG8_LDA(At, 0, 1); PG8_STAGE(PG8_SA(0, 0), a2, voffA);
            PG8_BAR; PG8_WAIT_L(0); PG8_MMA(1, 0, At, B0); PG8_BAR; PG8_SCHED;
            PG8_STAGE(PG8_SB(0, 1), b2 + hstep, voffB);
            PG8_WAIT_V(6); PG8_BAR; PG8_MMA(1, 1, At, B1); PG8_BAR;
            PG8_LDB(B0, 1, 0); PG8_SCHED; PG8_LDA(At, 1, 0); PG8_STAGE(PG8_SA(0, 1), a2 + hstep, voffA);
            PG8_WAIT_L(8); PG8_BAR; PG8_WAIT_L(0); PG8_MMA(0, 0, At, B0); PG8_BAR; PG8_SCHED;
            PG8_LDB(B1, 1, 1); PG8_STAGE(PG8_SB(1, 0), b3, voffB);
            PG8_BAR; PG8_WAIT_L(0); PG8_MMA(0, 1, At, B1); PG8_BAR;
            PG8_LDA(At, 1, 1); PG8_STAGE(PG8_SA(1, 0), a3, voffA);
            PG8_BAR; PG8_WAIT_L(0); PG8_MMA(1, 0, At, B0); PG8_BAR; PG8_SCHED;
            PG8_STAGE(PG8_SB(1, 1), b3 + hstep, voffB);
            PG8_WAIT_V(6); PG8_BAR; PG8_MMA(1, 1, At, B1); PG8_BAR;
        }
        const bool keep = E(acc, cur, wr, wc, fr, fq);
        if (!has_next) break;
        if (!keep)
#pragma unroll
        for (int a = 0; a < 2; ++a)
#pragma unroll
            for (int b = 0; b < 2; ++b)
#pragma unroll
                for (int m = 0; m < 4; ++m)
#pragma unroll
                    for (int n = 0; n < 2; ++n) acc[a][b][m][n] = (f32x4){0.f, 0.f, 0.f, 0.f};
        cur = nxt; cA = nA; cB = nB; ++ui;
    }
    PG8_WAIT_V(0);
    if (wr == 0) PG8_BAR;
    PG8_BAR;
#undef PG8_SA
#undef PG8_SB
#undef PG8_STAGE
#undef PG8_LDA
#undef PG8_LDB
#undef PG8_MMA
#undef PG8_WAIT_V
#undef PG8_WAIT_L
#undef PG8_BAR
#undef PG8_SCHED
}
}
#define XB_TMO      128
#define XB_XCNT(j)  (256  + 64 * (j))
#define XB_XSUB(j)  (1280 + 64 * (j))
#define XB_XGEN(j)  (2304 + 64 * (j))
#define XB_TOP      3328
#define XB_TOPGEN   3392
#define XCD_BAR_WORDS 3456
#define XB_SPIN_CAP (1u << 18)

__device__ __forceinline__ unsigned xb_ld(unsigned* p)              { return __hip_atomic_load(p, __ATOMIC_RELAXED, __HIP_MEMORY_SCOPE_AGENT); }
__device__ __forceinline__ unsigned xb_add(unsigned* p, unsigned v) { return __hip_atomic_fetch_add(p, v, __ATOMIC_RELAXED, __HIP_MEMORY_SCOPE_AGENT); }
__device__ __forceinline__ unsigned xb_xcc_id() { return (unsigned)__builtin_amdgcn_s_getreg((3 << 11) | 20) & 0xFu; }
#define XB_SPIN(cond, bar) do { unsigned _sp = 0; while (cond) { __builtin_amdgcn_s_sleep(1); \
    if ((++_sp & 255u) == 0u) { if (xb_ld(&(bar)[XB_TMO])) break; if (_sp > XB_SPIN_CAP) { atomicAdd(&(bar)[XB_TMO], 1u); break; } } } } while (0)

struct XcdBarrier {
    unsigned* bar; unsigned x;
    volatile LAS unsigned* st;
};

__device__ __forceinline__ XcdBarrier xcd_barrier_post(unsigned* bar, volatile LAS unsigned* st) {
    XcdBarrier b; b.bar = bar; b.x = xb_xcc_id(); b.st = st;
    if (threadIdx.x == 0) (void)xb_add(&bar[XB_XCNT(b.x)], 1u);
    return b;
}
__device__ __forceinline__ void xcd_barrier_complete(unsigned* bar, unsigned x, unsigned& nloc, unsigned& nx) {
    const unsigned G = gridDim.x * gridDim.y * gridDim.z;
    unsigned sum, cnt, mine, sp = 0u;
    for (;;) {
        sum = 0u; cnt = 0u; mine = 0u;
#pragma unroll
        for (unsigned j = 0; j < 16; ++j) { const unsigned c = xb_ld(&bar[XB_XCNT(j)]); sum += c; cnt += (c > 0u) ? 1u : 0u; mine = (j == x) ? c : mine; }
        if (sum == G) break;
        __builtin_amdgcn_s_sleep(1);
        if ((++sp & 255u) == 0u) { if (xb_ld(&bar[XB_TMO])) break; if (sp > XB_SPIN_CAP) { atomicAdd(&bar[XB_TMO], 1u); break; } }
    }
    nloc = mine > 0u ? mine : 1u; nx = cnt > 0u ? cnt : 1u;
}

__device__ __forceinline__ void xcd_barrier(const XcdBarrier& b) {
    asm volatile("s_waitcnt vmcnt(0)" ::: "memory");
    __syncthreads();
    if (threadIdx.x == 0) {
        unsigned* bar = b.bar;
        __builtin_amdgcn_s_waitcnt(0);
        unsigned nloc = b.st[0], nx = b.st[1];
        if (nloc == 0u) { xcd_barrier_complete(bar, b.x, nloc, nx); b.st[0] = nloc; b.st[1] = nx; }
        const unsigned old = xb_add(&bar[XB_XSUB(b.x)], 1u);
        const unsigned gen = old / nloc;
        if (old + 1u == (gen + 1u) * nloc) {
            __builtin_amdgcn_fence(__ATOMIC_RELEASE, "agent");
            asm volatile("s_waitcnt vmcnt(0)" ::: "memory");
            const unsigned og = xb_add(&bar[XB_TOP], 1u);
            const unsigned tg = og / nx;
            if (og + 1u == (tg + 1u) * nx) xb_add(&bar[XB_TOPGEN], 1u);
            else XB_SPIN(xb_ld(&bar[XB_TOPGEN]) == tg, bar);
            __builtin_amdgcn_fence(__ATOMIC_ACQUIRE, "agent");
            xb_add(&bar[XB_XGEN(b.x)], 1u);
            asm volatile("s_waitcnt vmcnt(0)" ::: "memory");
        } else {
            XB_SPIN(xb_ld(&bar[XB_XGEN(b.x)]) == gen, bar);
            __builtin_amdgcn_fence(__ATOMIC_ACQUIRE, "agent");
            asm volatile("s_waitcnt vmcnt(0)" ::: "memory");
        }
    }
    __syncthreads();
}

constexpr int LDS_BYTES = 163840;
constexpr int LDS_MISC = 162816;

DI void tr_tile(const Frame& F, const float* src, int ld, int k0, int c0, bf16_t* dst, int K, int n0, LAS float* tile) {
    const int kr = F.tid >> 4, c4 = (F.tid & 15) * 4;
#pragma unroll
    for (int ps = 0; ps < 2; ++ps) { const int k = kr + 32 * ps; const f32x4 v = *(const f32x4*)(src + (size_t)(k0 + k) * ld + c0 + c4);
        tile[k * 65 + c4] = v[0]; tile[k * 65 + c4 + 1] = v[1]; tile[k * 65 + c4 + 2] = v[2]; tile[k * 65 + c4 + 3] = v[3]; }
    __syncthreads();
    const int n = F.tid >> 3, kc = (F.tid & 7) * 8;
    float v[8];
#pragma unroll
    for (int i = 0; i < 8; ++i) v[i] = tile[(kc + i) * 65 + n];
    u32x4 w; w.x = pack2(v[0], v[1]); w.y = pack2(v[2], v[3]); w.z = pack2(v[4], v[5]); w.w = pack2(v[6], v[7]);
    *(u32x4*)(dst + (size_t)(n0 + n) * K + k0 + kc) = w;
    __syncthreads();
}

DI void phase0(const Frame& F, LAS unsigned char* lds) {
    const int G = F.G, bid = F.bid;
    { float* wsm = (float*)(F.ws + WS_WSM); float* wrt = (float*)(F.ws + WS_WRT);
      for (int idx = bid * NT + F.tid; idx < 2 * 16 * 1024 + 16 * 1024; idx += G * NT) {
          if (idx < 2 * 16 * 1024) { const int L = idx >> 14, j = (idx >> 10) & 15, k = idx & 1023; wsm[idx] = F.inp(8)[((size_t)L * 1024 + k) * PW + 2048 + j]; }
          else { const int q = idx - 2 * 16 * 1024, j = q >> 10, k = q & 1023; wrt[q] = F.inp(24)[k * 16 + j]; } } }
    { bf16_t* wgt = (bf16_t*)(F.ws + WS_WGT);
      for (int idx = bid * NT + F.tid; idx < 2 * 131072; idx += G * NT) { const int j = idx & 63, k = (idx >> 6) & 63, hi = idx >> 12;
          wgt[idx] = f2bf(F.inp(19)[((size_t)hi * 64 + j) * 64 + k]); } }
    { LAS float* sil = (LAS float*)lds; LAS float* red = sil + 9 * 1024;
      for (int it = bid; it < 96; it += G) {
          const int L = it / 48, cb = it % 48;
          __syncthreads();
          for (int i = F.tid; i < 9 * 1024; i += NT) { const int r = i >> 10, k = i & 1023; const float c = r < 8 ? F.inp(1)[r * 1024 + k] : F.inp(3)[k]; sil[i] = silu_f(c); }
          __syncthreads();
          const int cl = F.tid & 127, kq = F.tid >> 7, col = cb * 128 + cl; const float* wm = F.inp(4) + (size_t)L * 1024 * 6144 + (size_t)(kq * 256) * 6144 + col;
          float acc[9];
#pragma unroll
          for (int r = 0; r < 9; ++r) acc[r] = 0.f;
          for (int k = 0; k < 256; ++k) { const float w = wm[(size_t)k * 6144];
#pragma unroll
              for (int r = 0; r < 9; ++r) acc[r] += sil[r * 1024 + kq * 256 + k] * w; }
#pragma unroll
          for (int r = 0; r < 9; ++r) red[(kq * 9 + r) * 128 + cl] = acc[r];
          __syncthreads();
          if (kq == 0) { const float bias = F.inp(5)[L * 6144 + col];
#pragma unroll
              for (int r = 0; r < 9; ++r) F.mod(L, r)[col] = ((red[(0 * 9 + r) * 128 + cl] + red[(1 * 9 + r) * 128 + cl]) + (red[(2 * 9 + r) * 128 + cl] + red[(3 * 9 + r) * 128 + cl])) + bias; }
      }
      __syncthreads(); }
}

DI void convert_weights(const Frame& F, int L, LAS unsigned char* lds) {
    const int G = F.G, bid = F.bid;
    { LAS float* tile = (LAS float*)lds; bf16_t* wb = F.wb(L);
      __syncthreads();
      for (int it = bid; it < 8704; it += G) {
          int q = it;
          if (q < 1920) { const int kt = q / 120, nt = q % 120, n0 = nt * 64, c0 = n0 < 2048 ? n0 : n0 + 16;
              tr_tile(F, F.inp(8) + (size_t)L * 1024 * PW, PW, kt * 64, c0, wb + W_IN, 1024, n0, tile); continue; }
          q -= 1920;
          if (q < 384) { const int br = q >> 7, r = q & 127, kt = r >> 4, nt = r & 15;
              tr_tile(F, F.inp(22) + (size_t)(L * 3 + br) * 512 * 1024, 1024, kt * 64, nt * 64, wb + W_BR + (size_t)br * 1024 * 512, 512, nt * 64, tile); continue; }
          q -= 384;
          if (q < 256) { const int kt = q >> 4, nt = q & 15;
              tr_tile(F, F.inp(23) + (size_t)L * 1024 * 1024, 1024, kt * 64, nt * 64, wb + W_OUT, 1024, nt * 64, tile); continue; }
          q -= 256;
          if (q < 4096) { const int e = q >> 8, r = q & 255, kt = r >> 4, nt = r & 15, n0 = nt * 64, t256 = n0 >> 8, wi = n0 & 255;
              const int c0 = wi < 128 ? t256 * 128 + wi : 512 + t256 * 128 + (wi - 128);
              tr_tile(F, F.inp(26) + (size_t)(L * 16 + e) * 1024 * 1024, 1024, kt * 64, c0, wb + W_GU + (size_t)e * 1024 * 1024, 1024, n0, tile); continue; }
          q -= 4096;
          { const int e = q >> 7, r = q & 127, kt = r >> 4, nt = r & 15;
              tr_tile(F, F.inp(27) + (size_t)(L * 16 + e) * 512 * 1024, 1024, kt * 64, nt * 64, wb + W_DN + (size_t)e * 1024 * 512, 512, nt * 64, tile); }
      } }
}

DI void norm_phase(const Frame& F, int L, int which, LAS unsigned char* lds, const bool dry = false) {
    const int G = F.G;
    LAS float* swl = (LAS float*)lds;
    { const float* src = which == 1 ? (const float*)(F.ws + WS_WSM) + (size_t)L * 16 * 1024 : (const float*)(F.ws + WS_WRT);
      __syncthreads();
      for (int i = F.tid; i < 4096; i += NT) *(LAS f32x4*)(swl + i * 4) = *(const f32x4*)(src + i * 4);
      __syncthreads(); }
    const float* gain = (which == 1 ? F.inp(6) : F.inp(7)) + L * 1024;
    float* xs = F.xs(); bf16_t* H = F.h(); unsigned* route = F.route();
    const bf16_t* ys = F.slot(8);
    auto row_src = [&](int r) -> const float* { const int b = r / TT, t = r - b * TT;
        if (which == 1 && L == 0) return t < CTX ? F.inp(2) + ((size_t)b * CTX + t) * 1024 : F.inp(0) + ((size_t)b * SEQ + (t - CTX)) * 1024;
        return xs + (size_t)r * 1024; };
    f32x4 xn[4]; u32x2 ya[4], yb[4]; float nw0 = 0.f, nw1 = 0.f;
    auto fetch = [&](int r) { const float* src = row_src(r);
#pragma unroll
        for (int i = 0; i < 4; ++i) xn[i] = *(const f32x4*)(src + F.lane * 4 + 256 * i);
        if (which == 1 && L > 0) { const unsigned* rt = route + (size_t)r * 8; nw0 = __uint_as_float(rt[2]); nw1 = __uint_as_float(rt[3]); const int p0 = (int)rt[4], p1 = (int)rt[5];
#pragma unroll
            for (int i = 0; i < 4; ++i) { const int c = F.lane * 4 + 256 * i; ya[i] = *(const u32x2*)(ys + (size_t)p0 * 1024 + c); yb[i] = *(const u32x2*)(ys + (size_t)p1 * 1024 + c); } } };
    const int rfirst = F.bid * 8 + F.wave;
    if (rfirst < MROWS) fetch(rfirst);
    for (int r = rfirst; r < MROWS; r += G * 8) {
        const int b = r / TT, t = r - b * TT, mi = t < CTX ? 8 : b;
        if (which == 2 && L == 1 && t < CTX) { const int rn = r + G * 8; fetch(rn < MROWS ? rn : r); continue; }
        f32x4 x[4];
#pragma unroll
        for (int i = 0; i < 4; ++i) x[i] = xn[i];
        if (which == 1 && L > 0) {
            const float w0 = nw0, w1 = nw1;
            const float* m5 = F.mod(L - 1, mi) + 5 * 1024;
#pragma unroll
            for (int i = 0; i < 4; ++i) { const int c = F.lane * 4 + 256 * i;
                const u32x2 a = ya[i], bq = yb[i]; const f32x4 g = *(const f32x4*)(m5 + c);
                x[i][0] += g[0] * (w0 * __uint_as_float(a.x << 16) + w1 * __uint_as_float(bq.x << 16));
                x[i][1] += g[1] * (w0 * __uint_as_float(a.x & 0xffff0000u) + w1 * __uint_as_float(bq.x & 0xffff0000u));
                x[i][2] += g[2] * (w0 * __uint_as_float(a.y << 16) + w1 * __uint_as_float(bq.y << 16));
                x[i][3] += g[3] * (w0 * __uint_as_float(a.y & 0xffff0000u) + w1 * __uint_as_float(bq.y & 0xffff0000u)); }
        }
        { const int rn = r + G * 8; fetch(rn < MROWS ? rn : r); }
        if (which == 1 && !dry) {
#pragma unroll
            for (int i = 0; i < 4; ++i) *(f32x4*)(xs + (size_t)r * 1024 + F.lane * 4 + 256 * i) = x[i];
        }
        float ss = 0.f;
#pragma unroll
        for (int i = 0; i < 4; ++i) ss += x[i][0] * x[i][0] + x[i][1] * x[i][1] + x[i][2] * x[i][2] + x[i][3] * x[i][3];
        ss = wave_sum_fast(ss);
        const float rstd = rsqrtf(ss * (1.f / 1024.f) + EPS);
        const float* mv = F.mod(L, mi) + (which == 1 ? 0 : 3 * 1024);
        f32x4 hh[4];
#pragma unroll
        for (int i = 0; i < 4; ++i) { const int c = F.lane * 4 + 256 * i; const f32x4 g = *(const f32x4*)(gain + c), sh = *(const f32x4*)(mv + c), sc = *(const f32x4*)(mv + 1024 + c);
#pragma unroll
            for (int q = 0; q < 4; ++q) hh[i][q] = (x[i][q] * rstd * g[q]) * (1.f + sc[q]) + sh[q];
            u32x2 w; w.x = pack2(hh[i][0], hh[i][1]); w.y = pack2(hh[i][2], hh[i][3]);
            if (!dry) *(u32x2*)(H + (size_t)r * 1024 + c) = w; }
        float dv = 0.f;
#pragma unroll 1
        for (int j0 = 0; j0 < 16; j0 += 8) {
            float a[8];
#pragma unroll
            for (int j = 0; j < 8; ++j) { a[j] = 0.f;
#pragma unroll
                for (int i = 0; i < 4; ++i) { const f32x4 w = *(const LAS f32x4*)(swl + (j0 + j) * 1024 + F.lane * 4 + 256 * i); a[j] += hh[i][0] * w[0] + hh[i][1] * w[1] + hh[i][2] * w[2] + hh[i][3] * w[3]; } }
#pragma unroll
            for (int j = 0; j < 8; ++j) a[j] = row16_sum_dpp(a[j]);
#pragma unroll
            for (int j = 0; j < 8; ++j) a[j] += __shfl_xor(a[j], 16);
#pragma unroll
            for (int j = 0; j < 8; ++j) a[j] += __shfl_xor(a[j], 32);
#pragma unroll
            for (int j = 0; j < 8; ++j) dv = (F.lane == j0 + j) ? a[j] : dv;
        }
        if (which == 1) {
            float* ba = (float*)(F.ws + WS_BA) + (size_t)r * 16;
            if (F.lane < 16 && !dry) ba[F.lane] = dv;
        } else {
            float p[16], mx = -3.0e38f;
#pragma unroll
            for (int j = 0; j < 16; ++j) { p[j] = __shfl(dv, j) + F.inp(25)[j]; mx = fmaxf(mx, p[j]); }
            float sum = 0.f;
#pragma unroll
            for (int j = 0; j < 16; ++j) { p[j] = __expf(p[j] - mx); sum += p[j]; }
            const float inv = 1.f / sum;
            float bs = -1.f, bp0 = 0.f, bp1 = 0.f; int be0 = 0, be1 = 1;
#pragma unroll
            for (int g = 0; g < 4; ++g) { float a = -1.f, c2 = -1.f; int ia = 0, ib = 0;
#pragma unroll
                for (int i = 0; i < 4; ++i) { const float v = p[g * 4 + i] * inv; if (v > a) { c2 = a; ib = ia; a = v; ia = i; } else if (v > c2) { c2 = v; ib = i; } }
                const float sc = a + c2; if (sc > bs) { bs = sc; bp0 = a; bp1 = c2; be0 = g * 4 + ia; be1 = g * 4 + ib; } }
            if (F.lane == 0 && !dry) {
                unsigned* cnt = F.ctl() + L * 16;
                const int pos0 = (int)atomicAdd(cnt + be0, 1u), pos1 = (int)atomicAdd(cnt + be1, 1u);
                unsigned* rt = route + (size_t)r * 8; const float wsum = bp0 + bp1;
                rt[0] = (unsigned)be0; rt[1] = (unsigned)be1; rt[2] = __float_as_uint(bp0 / wsum); rt[3] = __float_as_uint(bp1 / wsum); rt[6] = (unsigned)pos0; rt[7] = (unsigned)pos1;
            }
        }
    }
}

DI void moe_tile_bases(const Frame& F, int L, LAS int* tb) {
    if (F.tid == 0) { const unsigned* cnt = F.ctl() + L * 16; int acc = 0;
        for (int e = 0; e < 16; ++e) { tb[e] = acc; acc += (int)((cnt[e] + 255u) >> 8); }
        tb[16] = acc; }
    __syncthreads();
}

DI void sort_phase(const Frame& F, int L, LAS int* tb) {
    moe_tile_bases(F, L, tb);
    const int G = F.G; const bf16_t* H = F.h(); bf16_t* h2s = F.slot(0); unsigned* route = F.route();
    for (int r = F.bid * 8 + F.wave; r < MROWS; r += G * 8) {
        if (L == 1 && r % TT < CTX) continue;
        unsigned* rt = route + (size_t)r * 8;
        const int e0 = (int)rt[0], e1 = (int)rt[1]; const int d0 = tb[e0] * 256 + (int)rt[6], d1 = tb[e1] * 256 + (int)rt[7];
        const u32x4 a = *(const u32x4*)(H + (size_t)r * 1024 + F.lane * 8), c = *(const u32x4*)(H + (size_t)r * 1024 + 512 + F.lane * 8);
        *(u32x4*)(h2s + (size_t)d0 * 1024 + F.lane * 8) = a; *(u32x4*)(h2s + (size_t)d0 * 1024 + 512 + F.lane * 8) = c;
        *(u32x4*)(h2s + (size_t)d1 * 1024 + F.lane * 8) = a; *(u32x4*)(h2s + (size_t)d1 * 1024 + 512 + F.lane * 8) = c;
        if (F.lane == 0) { rt[4] = (unsigned)d0; rt[5] = (unsigned)d1; }
    }
}

DI void final_phase(const Frame& F) {
    const int G = F.G; const float* xs = F.xs(); const bf16_t* ys = F.slot(8); const unsigned* route = F.route();
    for (int o = F.bid * 8 + F.wave; o < NB * SEQ; o += G * 8) {
        const int b = o / SEQ, s = o - b * SEQ, r = b * TT + CTX + s;
        const unsigned* rt = route + (size_t)r * 8;
        const float w0 = __uint_as_float(rt[2]), w1 = __uint_as_float(rt[3]); const int p0 = (int)rt[4], p1 = (int)rt[5];
        const float* m5 = F.mod(1, b) + 5 * 1024;
#pragma unroll
        for (int i = 0; i < 4; ++i) { const int c = F.lane * 4 + 256 * i;
            f32x4 x = *(const f32x4*)(xs + (size_t)r * 1024 + c);
            const u32x2 a = *(const u32x2*)(ys + (size_t)p0 * 1024 + c), bq = *(const u32x2*)(ys + (size_t)p1 * 1024 + c); const f32x4 g = *(const f32x4*)(m5 + c);
            x[0] += g[0] * (w0 * __uint_as_float(a.x << 16) + w1 * __uint_as_float(bq.x << 16));
            x[1] += g[1] * (w0 * __uint_as_float(a.x & 0xffff0000u) + w1 * __uint_as_float(bq.x & 0xffff0000u));
            x[2] += g[2] * (w0 * __uint_as_float(a.y << 16) + w1 * __uint_as_float(bq.y << 16));
            x[3] += g[3] * (w0 * __uint_as_float(a.y & 0xffff0000u) + w1 * __uint_as_float(bq.y & 0xffff0000u));
            *(f32x4*)(F.out + (size_t)o * 1024 + c) = x; }
    }
}
DI float row16_sum(float v) {
#pragma unroll
    for (int o = 8; o >= 1; o >>= 1) v += __shfl_xor(v, o);
    return v;
}
DI void rope_table(const Frame& F, LAS unsigned char* lds) {
    LAS float* rt = (LAS float*)(lds + 69632);
    __syncthreads();
    for (int i = F.tid; i < 1024; i += NT) { const int id = i >> 4, fi = i & 15; const float inv_freq = exp2f(-(float)fi * (13.287712379549449f / 16.f));
        float sn, cs; sincosf((float)id * inv_freq, &sn, &cs); rt[i * 2] = cs; rt[i * 2 + 1] = sn; }
    __syncthreads();
}
DI void attn_prep_item(const Frame& F, int L, int b, int tt, LAS unsigned char* lds) {
    const int t0 = tt * 64;
    const bf16_t* Pq = F.slot(4); const bf16_t* Pk = F.slot(5); const bf16_t* Pv = F.slot(6);
    bf16_t* Qn = F.slot(9); bf16_t* Kn = F.slot(10); bf16_t* Vt = F.slot(11);
    const LAS float* rt = (const LAS float*)(lds + 69632);
    {
        const int li = F.tid & 15, grp = F.tid >> 4, d0 = 4 * li;
        const f32x4 gq = *(const f32x4*)(F.inp(13) + L * 64 + d0), gk = *(const f32x4*)(F.inp(14) + L * 64 + d0);
        for (int v0 = grp; v0 < 1024; v0 += 256) {
            u32x2 raws[8];
#pragma unroll
            for (int u = 0; u < 8; ++u) { const int v = v0 + 32 * u, tok = v >> 4, rest = v & 15, qk = rest >> 3, hd = (rest >> 1) & 3, c = rest & 1;
                raws[u] = *(const u32x2*)((qk ? Pk : Pq) + ((size_t)b * TT + t0 + tok) * 512 + hd * 128 + c * 64 + d0); }
#pragma unroll
            for (int u = 0; u < 8; ++u) {
            const int v = v0 + 32 * u;
            const int tok = v >> 4, rest = v & 15, qk = rest >> 3, hd = (rest >> 1) & 3, c = rest & 1;
            const int t = t0 + tok;
            const u32x2 raw = raws[u];
            float x[4] = {__uint_as_float(raw.x << 16), __uint_as_float(raw.x & 0xffff0000u), __uint_as_float(raw.y << 16), __uint_as_float(raw.y & 0xffff0000u)};
            const float ss = row16_sum_dpp(x[0] * x[0] + x[1] * x[1] + x[2] * x[2] + x[3] * x[3]);
            const float rs = rsqrtf(ss * (1.f / 64.f) + EPS);
            const f32x4 g = qk ? gk : gq;
#pragma unroll
            for (int e = 0; e < 4; ++e) x[e] *= rs * g[e];
            if (t >= CTX) {
                const int pos = t - CTX, id = (li & 8) ? (pos & 63) : (pos >> 6), fi0 = 4 * (li & 3);
                const bool lowhalf = (li & 4) == 0;
#pragma unroll
                for (int e = 0; e < 4; ++e) { const float other = __shfl_xor(x[e], 4); const float cs = rt[(id * 16 + fi0 + e) * 2], sn = rt[(id * 16 + fi0 + e) * 2 + 1];
                    x[e] = lowhalf ? x[e] * cs - other * sn : x[e] * cs + other * sn; }
            }
            if (!qk) {
#pragma unroll
                for (int e = 0; e < 4; ++e) x[e] *= 0.125f * 1.4426950408889634f;
            }
            u32x2 w; w.x = pack2(x[0], x[1]); w.y = pack2(x[2], x[3]);
            *(u32x2*)((qk ? Kn : Qn) + ((size_t)((b * 4 + hd) * 2 + c) * TT + t) * 64 + d0) = w;
            }
        }
    }
    LAS bf16_t* tl = (LAS bf16_t*)lds;
    __syncthreads();
    for (int ch = F.tid; ch < 4096; ch += NT) { const int tok = ch >> 6, c8 = (ch & 63) * 8;
        *(LAS u32x4*)(tl + tok * 520 + c8) = *(const u32x4*)(Pv + ((size_t)b * TT + t0 + tok) * 512 + c8); }
    __syncthreads();
    { const int col = F.tid; bf16_t* dst = Vt + ((size_t)b * 512 + col) * TT + t0;
#pragma unroll
      for (int g = 0; g < 8; ++g) { unsigned w[4];
#pragma unroll
          for (int q = 0; q < 4; ++q) w[q] = (unsigned)tl[(g * 8 + 2 * q) * 520 + col] | ((unsigned)tl[(g * 8 + 2 * q + 1) * 520 + col] << 16);
          u32x4 v; v.x = w[0]; v.y = w[1]; v.z = w[2]; v.w = w[3];
          *(u32x4*)(dst + g * 8) = v; } }
    __syncthreads();
}

constexpr int XC_PITCH = 520;
DI void lru_chunk(const Frame& F, int L, int b, int c32, int mode, LAS unsigned char* lds) {
    LAS bf16_t* xcl = (LAS bf16_t*)lds;
    const int t0 = c32 * 32, seg_lo = t0 < CTX ? 0 : CTX, seg_hi = t0 < CTX ? CTX : TT;
    const bf16_t* Px = F.slot(7); const bf16_t* Py = F.slot(8); bf16_t* Yc = F.slot(6);
    float* lrs = (float*)(F.ws + WS_LRS);
    const bf16_t* wgt = (const bf16_t*)(F.ws + WS_WGT) + (size_t)L * 131072;
    LAS bf16_t* rawl = (LAS bf16_t*)(lds + 34816);
    __syncthreads();
    { u32x4 pre[5];
#pragma unroll
      for (int j = 0; j < 5; ++j) { int id = F.tid + j * NT; id = id < 35 * 64 ? id : 35 * 64 - 1; const int row = id >> 6, c8 = (id & 63) * 8; int t = t0 - 2 + row; t = t < seg_lo ? seg_lo : (t >= seg_hi ? seg_hi - 1 : t);
          pre[j] = *(const u32x4*)(Px + ((size_t)b * TT + t) * 512 + c8); }
#pragma unroll
      for (int j = 0; j < 5; ++j) { const int id = F.tid + j * NT; if (id < 35 * 64) { const int row = id >> 6, c8 = (id & 63) * 8, t = t0 - 2 + row;
          const bool in = t >= seg_lo && t < seg_hi; u32x4 v = pre[j]; v.x = in ? v.x : 0u; v.y = in ? v.y : 0u; v.z = in ? v.z : 0u; v.w = in ? v.w : 0u;
          *(LAS u32x4*)(rawl + row * XC_PITCH + c8) = v; } } }
    __syncthreads();
    { const int ch = F.tid;
      const float w0 = F.inp(17)[(L * 4 + 0) * 512 + ch], w1 = F.inp(17)[(L * 4 + 1) * 512 + ch], w2 = F.inp(17)[(L * 4 + 2) * 512 + ch], w3 = F.inp(17)[(L * 4 + 3) * 512 + ch], cb = F.inp(18)[L * 512 + ch];
      float r0 = bf2f(rawl[0 * XC_PITCH + ch]), r1 = bf2f(rawl[1 * XC_PITCH + ch]), r2 = bf2f(rawl[2 * XC_PITCH + ch]);
#pragma unroll 8
      for (int tok = 0; tok < 32; ++tok) { const float r3 = bf2f(rawl[(tok + 3) * XC_PITCH + ch]);
          xcl[tok * XC_PITCH + ch] = f2bf(w0 * r0 + w1 * r1 + w2 * r2 + w3 * r3 + cb); r0 = r1; r1 = r2; r2 = r3; } }
    __syncthreads();
    const int n = F.wave, l31 = F.lane & 31, hh = F.lane >> 5;
#pragma unroll 1
    for (int nt = 0; nt < 2; ++nt) {
        const int ch = n * 64 + 32 * nt + l31;
        float hf[16];
#pragma unroll
        for (int dir = 0; dir < 2; ++dir) {
            f32x16 aR, aI;
            { const float br = F.inp(20)[((L * 2 + dir) * 2 + 0) * 512 + ch], bi = F.inp(20)[((L * 2 + dir) * 2 + 1) * 512 + ch];
#pragma unroll
              for (int i = 0; i < 16; ++i) { aR[i] = br; aI[i] = bi; } }
#pragma unroll
            for (int s = 0; s < 4; ++s) {
                const bf16x8 A = *(const LAS bf16x8*)(xcl + l31 * XC_PITCH + n * 64 + 16 * s + 8 * hh);
                const bf16x8 Br = *(const bf16x8*)(wgt + ((size_t)(((dir * 2 + 0) * 8 + n) * 64 + 32 * nt + l31)) * 64 + 16 * s + 8 * hh);
                const bf16x8 Bi = *(const bf16x8*)(wgt + ((size_t)(((dir * 2 + 1) * 8 + n) * 64 + 32 * nt + l31)) * 64 + 16 * s + 8 * hh);
                aR = MFMA32(A, Br, aR); aI = MFMA32(A, Bi, aI);
            }
            const float sp = softplus_f(-F.inp(21)[(L * 2 + dir) * 512 + ch]);
#pragma unroll
            for (int i = 0; i < 16; ++i) { const int tok = 8 * (i >> 2) + 4 * hh + (i & 3);
                const float la = -8.f * sigmoid_f(aR[i]) * sp;
                const float bb = __builtin_amdgcn_sqrtf(fmaxf(neg_expm1_f(2.f * la), 0.f)) * sigmoid_f(aI[i]) * bf2f(xcl[tok * XC_PITCH + ch]);
                aR[i] = __expf(la); aI[i] = bb; }
            float GA[4], GB[4], PA[4], PB[4];
#pragma unroll
            for (int g = 0; g < 4; ++g) { float A_ = 1.f, B_ = 0.f;
#pragma unroll
                for (int q = 0; q < 4; ++q) { const int e = dir ? 3 - q : q; const float a = aR[4 * g + e]; A_ *= a; B_ = a * B_ + aI[4 * g + e]; }
                GA[g] = A_; GB[g] = B_; PA[g] = __shfl_xor(A_, 32); PB[g] = __shfl_xor(B_, 32); }
            float h = 0.f;
            if (mode == 1) h = lrs[((size_t)((b * 2 + dir) * NLC + c32) * 512 + ch) * 2 + 1];
            float hs[4] = {0.f, 0.f, 0.f, 0.f}, ap = 1.f;
#pragma unroll
            for (int q = 0; q < 8; ++q) { const int qi = dir ? 7 - q : q, g = qi >> 1, hp = qi & 1;
                const bool mine = (hp == hh);
                const float A_ = mine ? GA[g] : PA[g], B_ = mine ? GB[g] : PB[g];
                hs[g] = mine ? h : hs[g];
                h = A_ * h + B_; ap *= A_; }
            if (mode == 0) { if (hh == 0) { float* s = lrs + ((size_t)((b * 2 + dir) * NLC + c32) * 512 + ch) * 2; s[0] = ap; s[1] = h; } }
            else {
#pragma unroll
                for (int g = 0; g < 4; ++g) { float hv = hs[g];
#pragma unroll
                    for (int q = 0; q < 4; ++q) { const int e = dir ? 3 - q : q, i = 4 * g + e; hv = aR[i] * hv + aI[i];
                        if (dir == 0) hf[i] = hv;
                        else { const int tok = 8 * g + 4 * hh + e; const size_t r = (size_t)b * TT + t0 + tok;
                            Yc[r * 512 + ch] = f2bf((hf[i] + hv) * gelu_tanh_f(bf2f(Py[r * 512 + ch]))); } } }
            }
        }
    }
}

DI void lru_carry_item(const Frame& F, int b, int dir, unsigned* done) {
    float* s = (float*)(F.ws + WS_LRS) + ((size_t)((b * 2 + dir) * NLC) * 512 + F.tid) * 2;
    float h = 0.f;
    for (int i0 = 0; i0 < NLC; i0 += 8) { f32x2 ab[8]; int cc[8];
#pragma unroll
        for (int j = 0; j < 8; ++j) { const int i = i0 + j; cc[j] = dir == 0 ? i : (i < 8 ? 7 - i : NLC + 7 - i); ab[j] = *(const f32x2*)(s + (size_t)cc[j] * 1024); }
#pragma unroll
        for (int j = 0; j < 8; ++j) { s[(size_t)cc[j] * 1024 + 1] = h; h = ab[j][0] * h + ab[j][1]; } }
    asm volatile("s_waitcnt vmcnt(0)" ::: "memory");
    __syncthreads();
    if (F.tid == 0) { __builtin_amdgcn_fence(__ATOMIC_RELEASE, "agent"); asm volatile("s_waitcnt vmcnt(0)" ::: "memory");
        __hip_atomic_fetch_add(done, 1u, __ATOMIC_RELAXED, __HIP_MEMORY_SCOPE_AGENT); }
}
DI void lru_wait_carries(const Frame& F, unsigned* done) {
    if (F.tid == 0) { unsigned spins = 0;
        while (__hip_atomic_load(done, __ATOMIC_RELAXED, __HIP_MEMORY_SCOPE_AGENT) < 16u && ++spins < (1u << 24)) __builtin_amdgcn_s_sleep(8);
        __builtin_amdgcn_fence(__ATOMIC_ACQUIRE, "agent"); asm volatile("s_waitcnt vmcnt(0)" ::: "memory"); }
    __syncthreads();
}

constexpr int GP_PITCH = 264;
DI void gdn_prep_item(const Frame& F, int L, int b, int hd, int tt, LAS unsigned char* lds) {
    LAS float* qk = (LAS float*)lds;
    LAS bf16_t* rawl = (LAS bf16_t*)(lds + 65536);
    LAS float* sc = (LAS float*)(lds + 100912);
    LAS unsigned char* Qi = lds + 102960;
    LAS unsigned char* Ki = lds + 120368;
    LAS float* KKs = (LAS float*)(lds + 137776);
    LAS float* QKs = (LAS float*)(lds + 146224);
    const int t0 = tt * 64, seg_lo = t0 < CTX ? 0 : CTX, seg_hi = t0 < CTX ? CTX : TT;
    const bf16_t* Pq = F.slot(0); const bf16_t* Pk = F.slot(1); const bf16_t* Pv = F.slot(2);
    bf16_t* QH = (bf16_t*)(F.ws + WS_GQ); bf16_t* KH = QH + GQ_ELEMS; bf16_t* VH = KH + GQ_ELEMS;
    const float* ba = (const float*)(F.ws + WS_BA);
    const float* cw = F.inp(9) + (size_t)L * 4 * 1536;
    const size_t hrow = (size_t)(b * 4 + hd) * TT;
    { u32x4 pre[5];
#pragma unroll
      for (int j = 0; j < 5; ++j) { int id = F.tid + j * NT; id = id < 67 * 32 ? id : 67 * 32 - 1; const int row = id >> 5, c = id & 31; int t = t0 - 2 + row; t = t < seg_lo ? seg_lo : (t >= seg_hi ? seg_hi - 1 : t);
          const size_t r = (size_t)b * TT + t; pre[j] = *(const u32x4*)((c < 16 ? Pq : Pk) + r * 512 + hd * 128 + (c & 15) * 8); }
      __syncthreads();
#pragma unroll
      for (int j = 0; j < 5; ++j) { const int id = F.tid + j * NT; if (id < 67 * 32) { const int row = id >> 5, c = id & 31, t = t0 - 2 + row; const bool in = t >= seg_lo && t < seg_hi;
          u32x4 v = pre[j]; v.x = in ? v.x : 0u; v.y = in ? v.y : 0u; v.z = in ? v.z : 0u; v.w = in ? v.w : 0u; *(LAS u32x4*)(rawl + row * GP_PITCH + c * 8) = v; } } }
    __syncthreads();
    u32x4 prev[3];
#pragma unroll
    for (int j = 0; j < 3; ++j) { int id = F.tid + j * NT; id = id < 67 * 16 ? id : 67 * 16 - 1; const int row = id >> 4, c = id & 15; int t = t0 - 2 + row; t = t < seg_lo ? seg_lo : (t >= seg_hi ? seg_hi - 1 : t);
        prev[j] = *(const u32x4*)(Pv + ((size_t)b * TT + t) * 512 + hd * 128 + c * 8); }
    { const int c2 = F.tid & 255, th = F.tid >> 8, isk = c2 >> 7, dd = c2 & 127, wcn = isk * 512 + hd * 128 + dd;
      const float w0 = cw[0 * 1536 + wcn], w1 = cw[1 * 1536 + wcn], w2 = cw[2 * 1536 + wcn], w3 = cw[3 * 1536 + wcn];
      const int r0i = th * 32;
      float r0 = bf2f(rawl[(r0i + 0) * GP_PITCH + c2]), r1 = bf2f(rawl[(r0i + 1) * GP_PITCH + c2]), r2 = bf2f(rawl[(r0i + 2) * GP_PITCH + c2]);
#pragma unroll 8
      for (int i = 0; i < 32; ++i) { const float r3 = bf2f(rawl[(r0i + i + 3) * GP_PITCH + c2]);
          qk[(r0i + i) * 256 + c2] = silu_f(w0 * r0 + w1 * r1 + w2 * r2 + w3 * r3); r0 = r1; r1 = r2; r2 = r3; } }
    if (F.tid < 128) { const int tl = F.tid & 63, dir = F.tid >> 6; const size_t r = (size_t)b * TT + t0 + tl;
        const float neg_a = -__expf(F.inp(10)[(L * 2 + dir) * 4 + hd]), dtb = F.inp(11)[(L * 2 + dir) * 4 + hd];
        sc[tl * 8 + 2 + dir] = sigmoid_f(ba[r * 16 + dir * 4 + hd]);
        sc[tl * 8 + 4 + dir] = neg_a * softplus_f(ba[r * 16 + 8 + dir * 4 + hd] + dtb); }
    __syncthreads();
    { const int pair = F.tid >> 2, part = F.tid & 3, tl = pair >> 1, isk = pair & 1; float a = 0.f;
      for (int i = 0; i < 32; ++i) { const float x = qk[tl * 256 + isk * 128 + part * 32 + ((i + pair) & 31)]; a += x * x; }
      a += __shfl_xor(a, 1); a += __shfl_xor(a, 2);
      if (part == 0) sc[tl * 8 + isk] = rsqrtf(a + EPS) * (isk ? 1.f : 0.08838834764831845f); }
#pragma unroll
    for (int j = 0; j < 3; ++j) { const int id = F.tid + j * NT; if (id < 67 * 16) { const int row = id >> 4, c = id & 15, t = t0 - 2 + row; const bool in = t >= seg_lo && t < seg_hi;
        u32x4 v = prev[j]; v.x = in ? v.x : 0u; v.y = in ? v.y : 0u; v.z = in ? v.z : 0u; v.w = in ? v.w : 0u; *(LAS u32x4*)(rawl + row * GP_PITCH + c * 8) = v; } }
    __syncthreads();
    { const int c2 = F.tid & 255, th = F.tid >> 8, isk = c2 >> 7, dd = c2 & 127;
      bf16_t* dstg = (isk ? KH : QH) + (hrow + t0) * 128 + dd; LAS unsigned char* img = isk ? Ki : Qi;
#pragma unroll 8
      for (int i = 0; i < 32; ++i) { const int tl = th * 32 + i; const bf16_t v = f2bf(qk[tl * 256 + c2] * sc[tl * 8 + isk]);
          dstg[(size_t)tl * 128] = v; *(LAS bf16_t*)(img + tl * 272 + dd * 2) = v; } }
    { const int col = F.tid & 127, tq = F.tid >> 7, wcn = 1024 + hd * 128 + col;
      const float w0 = cw[0 * 1536 + wcn], w1 = cw[1 * 1536 + wcn], w2 = cw[2 * 1536 + wcn], w3 = cw[3 * 1536 + wcn];
      const int r0i = tq * 16;
      float r0 = bf2f(rawl[(r0i + 0) * GP_PITCH + col]), r1 = bf2f(rawl[(r0i + 1) * GP_PITCH + col]), r2 = bf2f(rawl[(r0i + 2) * GP_PITCH + col]);
#pragma unroll 8
      for (int i = 0; i < 16; ++i) { const float r3 = bf2f(rawl[(r0i + i + 3) * GP_PITCH + col]);
          VH[(hrow + t0 + r0i + i) * 128 + col] = f2bf(silu_f(w0 * r0 + w1 * r1 + w2 * r2 + w3 * r3)); r0 = r1; r1 = r2; r2 = r3; } }
    __syncthreads();
    const int l31 = F.lane & 31, hh = F.lane >> 5;
    if (F.wave < 4) { const int mat = F.wave >> 1, c = F.wave & 1;
        f32x16 acc;
#pragma unroll
        for (int i = 0; i < 16; ++i) acc[i] = 0.f;
#pragma unroll
        for (int s = 0; s < 8; ++s) { const bf16x8 A = *(const LAS bf16x8*)((mat ? Qi : Ki) + (32 * c + l31) * 272 + (16 * s + 8 * hh) * 2);
            const bf16x8 B = *(const LAS bf16x8*)(Ki + (32 * c + l31) * 272 + (16 * s + 8 * hh) * 2); acc = MFMA32(A, B, acc); }
        LAS float* dst = (mat ? QKs : KKs) + c * 1056;
#pragma unroll
        for (int i = 0; i < 16; ++i) dst[(8 * (i >> 2) + 4 * hh + (i & 3)) * 33 + l31] = acc[i]; }
    __syncthreads();
    if (F.wave < 4) { const int c = F.wave & 1, dir = F.wave >> 1, c32 = 2 * tt + c;
        LAS float* As = (LAS float*)lds + F.wave * 2112; LAS float* Tl = As + 1056;
        const size_t cd = ((size_t)(b * 4 + hd) * 2 + dir) * 72 + c32;
        const int p = l31, tau = dir ? 31 - p : p, tl = 32 * c + tau;
        const float bet = sc[tl * 8 + 2 + dir]; float G = sc[tl * 8 + 4 + dir];
#pragma unroll
        for (int o = 1; o < 32; o <<= 1) { const float up = __shfl_up(G, o, 32); G += (p >= o) ? up : 0.f; }
        const float Glast = __shfl(G, 31, 32);
        if (hh == 0) { float* gs = (float*)(F.ws + WS_GSC) + (cd * 32 + p) * 4; f32x4 v; v[0] = bet; v[1] = __expf(G); v[2] = __expf(Glast - G); v[3] = 0.f; *(f32x4*)gs = v; }
        const LAS float* KKc = KKs + c * 1056; const LAS float* QKc = QKs + c * 1056;
        bf16_t* Tg = (bf16_t*)(F.ws + WS_GT) + cd * 1024; bf16_t* QKg = (bf16_t*)(F.ws + WS_GQK) + cd * 1024;
        for (int i = 0; i < 32; ++i) { const float bi = __shfl(bet, i, 32), Gi = __shfl(G, i, 32); const int ti = dir ? 31 - i : i;
            const float dec = __expf(fminf(Gi - G, 0.f));
            const float a = (i > p) ? bi * KKc[ti * 33 + tau] * dec : 0.f;
            if (hh == 0) { As[i * 33 + p] = a; QKg[i * 32 + p] = f2bf((i >= p) ? QKc[ti * 33 + tau] * dec : 0.f); } }
        for (int i = 0; i < 32; ++i) { float s = (i == p) ? 1.f : 0.f;
#pragma unroll 8
            for (int j = 0; j < i; ++j) s -= As[i * 33 + j] * Tl[j * 33 + p];
            if (hh == 0) { Tl[i * 33 + p] = s; Tg[i * 32 + p] = f2bf(s); } }
    }
    __syncthreads();
}

constexpr int GS_KI = 0, GS_QI = 8448, GS_VI = 16896, GS_KT = 25344, GS_TI = 34560, GS_QK = 36864, GS_SC = 39168, GS_BUF = 40960;
DI bf16x8 frag8(const LAS unsigned char* base, int byteoff) { const s16x4 lo = *(const LAS s16x4*)(base + byteoff), hi = *(const LAS s16x4*)(base + byteoff + 16); return __builtin_shufflevector(lo, hi, 0, 1, 2, 3, 4, 5, 6, 7); }
DI bf16x8 pack8v(const f32x16& x, int s) {
    u32x4 p; p.x = pack2(x[8 * s], x[8 * s + 1]); p.y = pack2(x[8 * s + 2], x[8 * s + 3]); p.z = pack2(x[8 * s + 4], x[8 * s + 5]); p.w = pack2(x[8 * s + 6], x[8 * s + 7]);
    return __builtin_bit_cast(bf16x8, p);
}
DI void gdn_scan_item(const Frame& F, int L, int b, int hd, int dir, LAS unsigned char* lds) {
    const bf16_t* QH = (const bf16_t*)(F.ws + WS_GQ); const bf16_t* KH = QH + GQ_ELEMS; const bf16_t* VH = KH + GQ_ELEMS;
    const bf16_t* Tg = (const bf16_t*)(F.ws + WS_GT); const bf16_t* QKg = (const bf16_t*)(F.ws + WS_GQK); const float* gsc = (const float*)(F.ws + WS_GSC);
    bf16_t* og = F.slot(12 + dir);
    const size_t hrow = (size_t)(b * 4 + hd) * TT, cdb = ((size_t)(b * 4 + hd) * 2 + dir) * 72;
    const int l31 = F.lane & 31, hh = F.lane >> 5;
    auto chunk_of = [&](int s) { return dir == 0 ? s : (s < 8 ? 7 - s : 79 - s); };
    if (F.wave >= 4) {
        const int h = F.tid - 256;
        struct HSet { u32x4 rk[2], rq[2], rv[2], rt, rs; unsigned kt[8]; };
        auto issue = [&](HSet& R, int s) { const int c32 = chunk_of(s < 72 ? s : 71); const size_t tb0 = hrow + (size_t)c32 * 32, cd = cdb + c32;
#pragma unroll
            for (int j = 0; j < 2; ++j) { const int id = h + 256 * j, r = id >> 4, c16 = id & 15; const size_t off = (tb0 + r) * 128 + c16 * 8;
                R.rk[j] = *(const u32x4*)(KH + off); R.rq[j] = *(const u32x4*)(QH + off); R.rv[j] = *(const u32x4*)(VH + off); }
            { const int id = h & 127; R.rt = *(const u32x4*)((h < 128 ? Tg : QKg) + cd * 1024 + id * 8); }
            R.rs = *(const u32x4*)(gsc + (cd * 32 + (h & 31)) * 4);
            { const bf16_t* kc = KH + (tb0 + 16 * (h >> 7)) * 128 + (h & 127);
#pragma unroll
              for (int i = 0; i < 8; ++i) R.kt[i] = (unsigned)kc[(2 * i) * 128] | ((unsigned)kc[(2 * i + 1) * 128] << 16); } };
        auto put = [&](const HSet& R, LAS unsigned char* B) {
#pragma unroll
            for (int j = 0; j < 2; ++j) { const int id = h + 256 * j, r = id >> 4, c16 = id & 15, p = dir ? 31 - r : r;
                { u32x2 a; a.x = R.rk[j].x; a.y = R.rk[j].y; u32x2 c; c.x = R.rk[j].z; c.y = R.rk[j].w; *(LAS u32x2*)(B + GS_KI + p * 264 + c16 * 16) = a; *(LAS u32x2*)(B + GS_KI + p * 264 + c16 * 16 + 8) = c; }
                { u32x2 a; a.x = R.rq[j].x; a.y = R.rq[j].y; u32x2 c; c.x = R.rq[j].z; c.y = R.rq[j].w; *(LAS u32x2*)(B + GS_QI + p * 264 + c16 * 16) = a; *(LAS u32x2*)(B + GS_QI + p * 264 + c16 * 16 + 8) = c; }
                { u32x2 a; a.x = R.rv[j].x; a.y = R.rv[j].y; u32x2 c; c.x = R.rv[j].z; c.y = R.rv[j].w; *(LAS u32x2*)(B + GS_VI + p * 264 + c16 * 16) = a; *(LAS u32x2*)(B + GS_VI + p * 264 + c16 * 16 + 8) = c; }
            }
            {
              const int d = h & 127, rh = h >> 7; unsigned w[8];
#pragma unroll
              for (int i = 0; i < 8; ++i) { const unsigned x = R.kt[dir ? 7 - i : i]; w[i] = dir ? ((x >> 16) | (x << 16)) : x; }
              LAS unsigned char* dst = B + GS_KT + d * 72 + (dir ? 16 * (1 - rh) : 16 * rh) * 2;
#pragma unroll
              for (int i = 0; i < 4; ++i) { u32x2 v; v.x = w[2 * i]; v.y = w[2 * i + 1]; *(LAS u32x2*)(dst + 8 * i) = v; } }
            { const int id = h & 127, i = id >> 2, c = id & 3; LAS unsigned char* dst = B + (h < 128 ? GS_TI : GS_QK) + i * 72 + c * 16;
              u32x2 a; a.x = R.rt.x; a.y = R.rt.y; u32x2 c2; c2.x = R.rt.z; c2.y = R.rt.w; *(LAS u32x2*)dst = a; *(LAS u32x2*)(dst + 8) = c2; }
            if (h < 32) *(LAS u32x4*)(B + GS_SC + h * 16) = R.rs; };
        HSet R0, R1, R2;
        __syncthreads();
        issue(R0, 0); put(R0, lds); issue(R1, 1); issue(R2, 2); issue(R0, 3);
        __syncthreads();
#define GS_BAR() do { asm volatile("s_waitcnt lgkmcnt(0)" ::: "memory"); __builtin_amdgcn_s_barrier(); asm volatile("" ::: "memory"); } while (0)
        for (int s = 0; s < 72; s += 3) {
            put(R1, lds + ((s + 1) & 1) * GS_BUF); issue(R1, s + 4);
            GS_BAR();
            put(R2, lds + ((s + 2) & 1) * GS_BUF); issue(R2, s + 5);
            GS_BAR();
            if (s + 3 < 72) put(R0, lds + ((s + 3) & 1) * GS_BUF); issue(R0, s + 6);
            GS_BAR();
        }
        asm volatile("s_waitcnt vmcnt(0)" ::: "memory");
    } else {
        const int eq = F.wave;
        f32x16 S[4];
#pragma unroll
        for (int m = 0; m < 4; ++m)
#pragma unroll
            for (int i = 0; i < 16; ++i) S[m][i] = 0.f;
        __syncthreads();
        __syncthreads();
#pragma unroll 1
        for (int s = 0; s < 72; ++s) {
            int ln_ = F.lane; asm volatile("" : "+v"(ln_));
            const int l31 = ln_ & 31, hh = ln_ >> 5;
            const LAS unsigned char* B = lds + (s & 1) * GS_BUF;
            const int c32 = chunk_of(s);
            f32x16 ks, oq;
#pragma unroll
            for (int i = 0; i < 16; ++i) { ks[i] = 0.f; oq[i] = 0.f; }
#pragma unroll
            for (int m = 0; m < 4; ++m)
#pragma unroll
                for (int t = 0; t < 2; ++t) { const bf16x8 Sp = pack8v(S[m], t);
                    ks = MFMA32(frag8(B + GS_KI, l31 * 264 + (32 * m + 16 * t + 4 * hh) * 2), Sp, ks);
                    oq = MFMA32(frag8(B + GS_QI, l31 * 264 + (32 * m + 16 * t + 4 * hh) * 2), Sp, oq); }
            f32x16 X;
#pragma unroll
            for (int i = 0; i < 16; ++i) { const int pos = 8 * (i >> 2) + 4 * hh + (i & 3); const f32x4 s4 = *(const LAS f32x4*)(B + GS_SC + pos * 16);
                const float v = bf2f(*(const LAS bf16_t*)(B + GS_VI + pos * 264 + (32 * eq + l31) * 2));
                X[i] = s4[0] * (v - s4[1] * ks[i]); oq[i] *= s4[1]; }
            f32x16 vn;
#pragma unroll
            for (int i = 0; i < 16; ++i) vn[i] = 0.f;
#pragma unroll
            for (int t = 0; t < 2; ++t) vn = MFMA32(frag8(B + GS_TI, l31 * 72 + (16 * t + 4 * hh) * 2), pack8v(X, t), vn);
            { const bf16x8 vp0 = pack8v(vn, 0), vp1 = pack8v(vn, 1);
              oq = MFMA32(frag8(B + GS_QK, l31 * 72 + (4 * hh) * 2), vp0, oq); oq = MFMA32(frag8(B + GS_QK, l31 * 72 + (16 + 4 * hh) * 2), vp1, oq); }
            { bf16_t* dst = og + ((size_t)b * TT + (size_t)c32 * 32) * 512 + hd * 128 + 32 * eq + l31;
#pragma unroll
              for (int i = 0; i < 16; ++i) { const int pos = 8 * (i >> 2) + 4 * hh + (i & 3), tk = dir ? 31 - pos : pos; dst[(size_t)tk * 512] = f2bf(oq[i]); } }
            const float gl = (*(const LAS f32x4*)(B + GS_SC + 31 * 16))[1];
#pragma unroll
            for (int i = 0; i < 16; ++i) { const int pos = 8 * (i >> 2) + 4 * hh + (i & 3); vn[i] *= (*(const LAS f32x4*)(B + GS_SC + pos * 16))[2]; }
            const bf16x8 wp0 = pack8v(vn, 0), wp1 = pack8v(vn, 1);
#pragma unroll
            for (int m = 0; m < 4; ++m) {
#pragma unroll
                for (int i = 0; i < 16; ++i) S[m][i] *= gl;
                S[m] = MFMA32(frag8(B + GS_KT, (32 * m + l31) * 72 + (4 * hh) * 2), wp0, S[m]);
                S[m] = MFMA32(frag8(B + GS_KT, (32 * m + l31) * 72 + (16 + 4 * hh) * 2), wp1, S[m]); }
            GS_BAR();
        }
    }
#undef GS_BAR
}

DI void gdn_post(const Frame& F, int L) {
    const int G = F.G; const bf16_t* of = F.slot(12); const bf16_t* obk = F.slot(13); const bf16_t* Pz = F.slot(3); bf16_t* Ya = F.slot(4);
    const float* gain = F.inp(12) + L * 128;
    for (int r = F.bid * 8 + F.wave; r < MROWS; r += G * 8) {
        const size_t off = (size_t)r * 512 + F.lane * 8;
        const u32x4 a = *(const u32x4*)(of + off), c = *(const u32x4*)(obk + off), z = *(const u32x4*)(Pz + off);
        const unsigned aa[4] = {a.x, a.y, a.z, a.w}, cc[4] = {c.x, c.y, c.z, c.w}, zz[4] = {z.x, z.y, z.z, z.w};
        float o[8]; float ss = 0.f;
#pragma unroll
        for (int q = 0; q < 4; ++q) { o[2 * q] = __uint_as_float(aa[q] << 16) + __uint_as_float(cc[q] << 16); o[2 * q + 1] = __uint_as_float(aa[q] & 0xffff0000u) + __uint_as_float(cc[q] & 0xffff0000u);
            ss += o[2 * q] * o[2 * q] + o[2 * q + 1] * o[2 * q + 1]; }
        ss = row16_sum_dpp(ss);
        const float rstd = rsqrtf(ss * (1.f / 128.f) + EPS);
        const int e0 = (F.lane & 15) * 8;
        float y[8];
#pragma unroll
        for (int q = 0; q < 4; ++q) { y[2 * q] = o[2 * q] * rstd * gain[e0 + 2 * q] * silu_f(__uint_as_float(zz[q] << 16)); y[2 * q + 1] = o[2 * q + 1] * rstd * gain[e0 + 2 * q + 1] * silu_f(__uint_as_float(zz[q] & 0xffff0000u)); }
        u32x4 w; w.x = pack2(y[0], y[1]); w.y = pack2(y[2], y[3]); w.z = pack2(y[4], y[5]); w.w = pack2(y[6], y[7]);
        *(u32x4*)(Ya + off) = w;
    }
}
DI bf16x8 pack8(const f32x16& x, int s) {
    u32x4 p; p.x = pack2(x[8 * s], x[8 * s + 1]); p.y = pack2(x[8 * s + 2], x[8 * s + 3]); p.z = pack2(x[8 * s + 4], x[8 * s + 5]); p.w = pack2(x[8 * s + 6], x[8 * s + 7]);
    return __builtin_bit_cast(bf16x8, p);
}
constexpr int AK_PITCH = 272, AV_PITCH = 136, AK_BYTES = 64 * AK_PITCH, AV_BYTES = 128 * AV_PITCH;

DI void attn_item(const Frame& F, int L, int b, int hd, int qt, float lam, float lam_init, float bound2, LAS unsigned char* lds) {
    const bf16_t* Qn = F.slot(9); const bf16_t* Kn = F.slot(10); const bf16_t* Vt = F.slot(11); bf16_t* Yb = F.slot(5);
    const int qbase = qt < 8 ? CTX + qt * 256 : 0, nkt = qt < 8 ? 36 : 4;
    int tid_ = F.tid; asm volatile("" : "+v"(tid_));
    const int lane_ = tid_ & 63, l31 = lane_ & 31, hh = lane_ >> 5;
    const int tq = qbase + 32 * F.wave + l31;
    LAS unsigned char* Kl = lds; LAS unsigned char* Vl = lds + AK_BYTES;
    LAS unsigned char* Ql = lds + AK_BYTES + AV_BYTES + F.wave * 8192 + lane_ * 16;
    __syncthreads();
#pragma unroll
    for (int c = 0; c < 2; ++c)
#pragma unroll
        for (int s = 0; s < 4; ++s) *(LAS bf16x8*)(Ql + (c * 4 + s) * 1024) = *(const bf16x8*)(Qn + ((size_t)((b * 4 + hd) * 2 + c) * TT + tq) * 64 + 16 * s + 8 * hh);
    f32x16 O[2][4];
#pragma unroll
    for (int c = 0; c < 2; ++c)
#pragma unroll
        for (int e = 0; e < 4; ++e)
#pragma unroll
            for (int i = 0; i < 16; ++i) O[c][e][i] = 0.f;
    float lsum[2] = {0.f, 0.f};
    const int kkey = tid_ >> 3, kch = tid_ & 7;
    const bf16_t* kb = Kn + (size_t)((b * 4 + hd) * 2) * TT * 64;
    const bf16_t* vbs = Vt + (size_t)(b * 4 + hd) * 128 * TT;
    const unsigned koff = (unsigned)(kkey * 64 + kch * 8);
    const int ve0 = tid_ >> 3, ve1 = ve0 + 64, vch = tid_ & 7;
    const unsigned voff = (unsigned)(ve0 * TT + vch * 8);
    u32x4 rk0, rk1, rv0, rv1;
    rk0 = *(const u32x4*)(kb + koff); rk1 = *(const u32x4*)(kb + TT * 64 + koff); rv0 = *(const u32x4*)(vbs + voff); rv1 = *(const u32x4*)(vbs + 64 * TT + voff);
    for (int kt = 0; kt < nkt; ++kt) {
        __syncthreads();
        *(LAS u32x4*)(Kl + kkey * AK_PITCH + kch * 16) = rk0;
        *(LAS u32x4*)(Kl + kkey * AK_PITCH + 128 + kch * 16) = rk1;
        { u32x2 a; a.x = rv0.x; a.y = rv0.y; u32x2 c; c.x = rv0.z; c.y = rv0.w; *(LAS u32x2*)(Vl + ve0 * AV_PITCH + vch * 16) = a; *(LAS u32x2*)(Vl + ve0 * AV_PITCH + vch * 16 + 8) = c; }
        { u32x2 a; a.x = rv1.x; a.y = rv1.y; u32x2 c; c.x = rv1.z; c.y = rv1.w; *(LAS u32x2*)(Vl + ve1 * AV_PITCH + vch * 16) = a; *(LAS u32x2*)(Vl + ve1 * AV_PITCH + vch * 16 + 8) = c; }
        __syncthreads();
        if (kt + 1 < nkt) { const bf16_t* kn = kb + (kt + 1) * 4096; const bf16_t* vn = vbs + (kt + 1) * 64;
            rk0 = *(const u32x4*)(kn + koff); rk1 = *(const u32x4*)(kn + TT * 64 + koff); rv0 = *(const u32x4*)(vn + voff); rv1 = *(const u32x4*)(vn + 64 * TT + voff); }
#pragma unroll 1
        for (int u = 0; u < 2; ++u) {
            bf16x8 Pf[2][2];
#pragma unroll
            for (int c = 0; c < 2; ++c) {
                f32x16 S;
#pragma unroll
                for (int i = 0; i < 16; ++i) S[i] = 0.f;
#pragma unroll
                for (int s = 0; s < 4; ++s) { const bf16x8 A = *(const LAS bf16x8*)(Kl + (32 * u + l31) * AK_PITCH + c * 128 + (16 * s + 8 * hh) * 2); const bf16x8 Bq = *(const LAS bf16x8*)(Ql + (c * 4 + s) * 1024); S = MFMA32(A, Bq, S); }
#pragma unroll
                for (int i = 0; i < 16; ++i) { S[i] = __builtin_amdgcn_exp2f(S[i] - bound2); lsum[c] += S[i]; }
                Pf[c][0] = pack8(S, 0); Pf[c][1] = pack8(S, 1);
            }
#pragma unroll
            for (int s = 0; s < 2; ++s) {
                __builtin_amdgcn_sched_barrier(0);
#pragma unroll
                for (int e = 0; e < 4; ++e) {
                    const LAS unsigned char* vb = Vl + (32 * e + l31) * AV_PITCH + (32 * u + 16 * s + 4 * hh) * 2;
                    const s16x4 lo = *(const LAS s16x4*)vb, hi = *(const LAS s16x4*)(vb + 16);
                    const bf16x8 A = __builtin_shufflevector(lo, hi, 0, 1, 2, 3, 4, 5, 6, 7);
                    O[0][e] = MFMA32(A, Pf[0][s], O[0][e]); O[1][e] = MFMA32(A, Pf[1][s], O[1][e]);
                }
            }
            __builtin_amdgcn_sched_barrier(0);
        }
    }
    const float l0 = lsum[0] + __shfl_xor(lsum[0], 32), l1 = lsum[1] + __shfl_xor(lsum[1], 32);
    const float i0 = 1.f / l0, i1 = lam / l1;
    float ss = 0.f;
#pragma unroll
    for (int e = 0; e < 4; ++e)
#pragma unroll
        for (int i = 0; i < 16; ++i) { const float o = O[0][e][i] * i0 - O[1][e][i] * i1; O[0][e][i] = o; ss += o * o; }
    ss += __shfl_xor(ss, 32);
    const float rstd = rsqrtf(ss * (1.f / 128.f) + EPS) * (1.f - lam_init);
    const float* og = F.inp(16) + L * 128;
    bf16_t* dst = Yb + ((size_t)b * TT + tq) * 512 + hd * 128;
#pragma unroll
    for (int e = 0; e < 4; ++e)
#pragma unroll
        for (int g = 0; g < 4; ++g) { const int e0 = 32 * e + 8 * g + 4 * hh; const f32x4 gv = *(const f32x4*)(og + e0);
            u32x2 w; w.x = pack2(O[0][e][4 * g] * rstd * gv[0], O[0][e][4 * g + 1] * rstd * gv[1]); w.y = pack2(O[0][e][4 * g + 2] * rstd * gv[2], O[0][e][4 * g + 3] * rstd * gv[3]);
            *(u32x2*)(dst + e0) = w; }
}

__global__ void __launch_bounds__(NT) mk_fwd(Params p) {
    extern __shared__ __attribute__((aligned(16))) unsigned char lds_raw[];
    LAS unsigned char* lds = (LAS unsigned char*)lds_raw;
    cg::grid_group grid = cg::this_grid();
    LAS int* tb = (LAS int*)(lds + LDS_MISC);
    LAS unsigned long long* itab = (LAS unsigned long long*)(lds + LDS_MISC + 256);
    LAS unsigned* scal = (LAS unsigned*)(lds + LDS_MISC + 512);
    volatile LAS unsigned* xbst = (volatile LAS unsigned*)(lds + LDS_MISC + 640);
    if (threadIdx.x < 4) xbst[threadIdx.x] = 0u;
    if (threadIdx.x < 28) itab[threadIdx.x] = (unsigned long long)p.in[threadIdx.x];
    if (threadIdx.x == 0) { const unsigned long long w = (unsigned long long)p.ws, o = (unsigned long long)p.out;
        scal[0] = (unsigned)w; scal[1] = (unsigned)(w >> 32); scal[2] = (unsigned)o; scal[3] = (unsigned)(o >> 32); scal[4] = gridDim.x; scal[5] = blockIdx.x; }
    __syncthreads();
    XcdBarrier xbar = xcd_barrier_post((unsigned*)(__attribute__((address_space(1))) unsigned*)(p.ws + WS_CTL + 4096), xbst);
    for (int ph = p.ph_lo; ph < p.ph_hi; ++ph) {
        int tid_ = threadIdx.x; asm volatile("" : "+v"(tid_));
        const unsigned w0 = __builtin_amdgcn_readfirstlane(scal[0]), w1 = __builtin_amdgcn_readfirstlane(scal[1]), o0 = __builtin_amdgcn_readfirstlane(scal[2]), o1 = __builtin_amdgcn_readfirstlane(scal[3]);
        unsigned char* ws_ = (unsigned char*)(__attribute__((address_space(1))) unsigned char*)(((unsigned long long)w1 << 32) | w0); float* out_ = (float*)(__attribute__((address_space(1))) float*)(((unsigned long long)o1 << 32) | o0);
        const int G = __builtin_amdgcn_readfirstlane(scal[4]), bid = __builtin_amdgcn_readfirstlane(scal[5]);
        Frame F; F.itab = itab; F.out = out_; F.ws = ws_; F.tid = tid_; F.lane = tid_ & 63; F.wave = __builtin_amdgcn_readfirstlane(tid_ >> 6); F.G = G; F.bid = bid;
        if (ph == 0) { phase0(F, lds); convert_weights(F, 0, lds); }
        else if (ph == 23) final_phase(F);
        else {
            int L = (ph - 1) / 11; const int k = (ph - 1) % 11;
            if (tid_ == 0) scal[6] = (unsigned)L;
            bf16_t* wb = F.wb(L);
            const bool dry = (p.sub & 8) != 0;
            if (k == 0) { norm_phase(F, L, 1, lds, dry); if (L == 1 && !(p.sub & 16)) convert_weights(F, 1, lds); }
            else if (k == 1) {
                pg8::Gemm g{F.h(), wb + W_IN, 1024}; pg8::StaticOrder S{72, 18, G, bid, 0};
                pg8::EpiSlots E{F.slot(0), {0, 1, 2, 3, 4, 5, 6, 7, 8}};
                pg8::gemm_phase(lds, g, S, E, F.tid);
            } else if (k == 2) {
                const int sub = p.sub;
                for (;;) {
                    LAS int* slot = (LAS int*)(lds + LDS_MISC + 192);
                    __syncthreads(); if (F.tid == 0) *slot = (int)atomicAdd(F.ctl() + 64 + ph + (p.sub & 32), 1u); __syncthreads();
                    const int it = __builtin_amdgcn_readfirstlane(*slot);
                    if (it >= 2016) break;
                    { int t_ = threadIdx.x; asm volatile("" : "+v"(t_)); F.tid = t_; F.lane = t_ & 63; F.wave = __builtin_amdgcn_readfirstlane(t_ >> 6);
                      const unsigned a0 = __builtin_amdgcn_readfirstlane(scal[0]), a1 = __builtin_amdgcn_readfirstlane(scal[1]); F.ws = (unsigned char*)(__attribute__((address_space(1))) unsigned char*)(((unsigned long long)a1 << 32) | a0);
                      L = __builtin_amdgcn_readfirstlane(scal[6]); }
                    if (it < 1152) { if (sub & 1) { const int rem = it % 144; gdn_prep_item(F, L, it / 144, rem / 36, rem % 36, lds); } }
                    else if (it < 1440) { if (sub & 2) { const int i2 = it - 1152; rope_table(F, lds); attn_prep_item(F, L, i2 / 36, i2 % 36, lds); } }
                    else if (sub & 4) { const int i2 = it - 1440; lru_chunk(F, L, i2 / NLC, i2 % NLC, 0, lds); }
                }
            } else if (k == 3) {
                const int sub = p.sub;
                LAS float* lamv = (LAS float*)(lds + LDS_MISC + 208);
                if (F.tid == 0) { const float* lv = F.inp(15) + L * 256; float s01 = 0.f, s23 = 0.f;
                    for (int i = 0; i < 64; ++i) { s01 += lv[i] * lv[64 + i]; s23 += lv[128 + i] * lv[192 + i]; }
                    const float lam_init = 0.8f - 0.6f * expf(-0.3f * (float)L);
                    float mq = 0.f, mk = 0.f;
                    for (int i = 0; i < 64; ++i) { mq = fmaxf(mq, fabsf(F.inp(13)[L * 64 + i])); mk = fmaxf(mk, fabsf(F.inp(14)[L * 64 + i])); }
                    lamv[0] = expf(s01) - expf(s23) + lam_init; lamv[1] = lam_init; lamv[2] = 8.f * mq * mk * 1.4426950408889634f; }
                for (;;) {
                    LAS int* slot = (LAS int*)(lds + LDS_MISC + 192);
                    __syncthreads(); if (F.tid == 0) *slot = (int)atomicAdd(F.ctl() + 64 + ph + (p.sub & 32), 1u); __syncthreads();
                    const int it = __builtin_amdgcn_readfirstlane(*slot);
                    const int nat = L == 0 ? 288 : 256, ntot = 80 + nat + NB * NLC;
                    if (it >= ntot) break;
                    { int t_ = threadIdx.x; asm volatile("" : "+v"(t_)); F.tid = t_; F.lane = t_ & 63; F.wave = __builtin_amdgcn_readfirstlane(t_ >> 6);
                      const unsigned a0 = __builtin_amdgcn_readfirstlane(scal[0]), a1 = __builtin_amdgcn_readfirstlane(scal[1]); F.ws = (unsigned char*)(__attribute__((address_space(1))) unsigned char*)(((unsigned long long)a1 << 32) | a0);
                      L = __builtin_amdgcn_readfirstlane(scal[6]); }
                    const float lam = lamv[0], lam_init = lamv[1], bound2 = lamv[2];
                    unsigned* done = F.ctl() + 128 + L + ((p.sub & 32) >> 4);
                    if (it < 64) { if (sub & 1) gdn_scan_item(F, L, it >> 3, (it >> 1) & 3, it & 1, lds); }
                    else if (it < 80) { if (sub & 4) { const int i2 = it - 64; lru_carry_item(F, i2 >> 1, i2 & 1, done); } }
                    else if (it < 80 + nat) { if (sub & 2) { const int i2 = it - 80;
                        if (i2 < 256) attn_item(F, L, i2 >> 5, (i2 >> 3) & 3, i2 & 7, lam, lam_init, bound2, lds);
                        else attn_item(F, L, (i2 - 256) >> 2, (i2 - 256) & 3, 8, lam, lam_init, bound2, lds); } }
                    else if (sub & 4) { const int i2 = it - 80 - nat;
                        if (!(L == 1 && i2 % NLC < 8)) { lru_wait_carries(F, done); lru_chunk(F, L, i2 / NLC, i2 % NLC, 1, lds); } }
                }
            } else if (k == 4) {
                gdn_post(F, L);
                pg8::Gemm g{F.h(), wb + W_IN + (size_t)4608 * 1024, 1024}; pg8::StaticOrder S{72, 12, G, bid, L == 1};
                pg8::EpiSlots E{F.slot(0), {0, 1, 2, 9, 10, 11, 0, 0, 0}};
                pg8::gemm_phase(lds, g, S, E, F.tid);
            } else if (k == 5) {
                pg8::Gemm g{F.slot(4), wb + W_BR, 512}; pg8::MergeOrder S{G, bid, L == 1};
                pg8::EpiMerge E{F.h(), F.slot(0)};
                pg8::gemm_phase(lds, g, S, E, F.tid);
            } else if (k == 6) {
                pg8::Gemm g{F.h(), wb + W_OUT, 1024}; pg8::StaticOrder S{72, 4, G, bid, L == 1};
                pg8::EpiResid E{F.xs(), F.mod(L, 0), dry};
                pg8::gemm_phase(lds, g, S, E, F.tid);
            } else if (k == 7) norm_phase(F, L, 2, lds, dry);
            else if (k == 8) sort_phase(F, L, tb);
            else if (k == 9) {
                moe_tile_bases(F, L, tb);
                pg8::Gemm g{F.slot(0), wb + W_GU, 1024}; pg8::MoeOrder S{tb, G, bid};
                pg8::EpiMoe1 E{F.slot(5)};
                pg8::gemm_phase(lds, g, S, E, F.tid);
            } else {
                moe_tile_bases(F, L, tb);
                pg8::Gemm g{F.slot(5), wb + W_DN, 512}; pg8::MoeOrder S{tb, G, bid};
                pg8::EpiMoe2 E{F.slot(8)};
                pg8::gemm_phase(lds, g, S, E, F.tid);
            }
        }
        if (ph + 1 < p.ph_hi) { if (ph == 0) grid.sync(); else xcd_barrier(xbar); }
    }
}

extern "C" void kernel_launch(void* const* d_in, const int* in_sizes, int n_in, void* d_out, int out_size, void* d_ws, size_t ws_size, hipStream_t stream) {
    static int grid = 0;
    if (grid == 0) {
        if (n_in != 28 || out_size != NB * SEQ * DM || ws_size < WS_END) { fprintf(stderr, "kernel_launch: unexpected shapes (n_in %d out %d ws %zu need %zu)\n", n_in, out_size, ws_size, (size_t)WS_END); grid = -1; return; }
        int dev = 0, cus = 0, per_cu = 0;
        hipGetDevice(&dev); hipDeviceGetAttribute(&cus, hipDeviceAttributeMultiprocessorCount, dev);
        hipFuncSetAttribute((const void*)mk_fwd, hipFuncAttributeMaxDynamicSharedMemorySize, LDS_BYTES);
        hipOccupancyMaxActiveBlocksPerMultiprocessor(&per_cu, (const void*)mk_fwd, NT, LDS_BYTES);
        if (per_cu < 1) { fprintf(stderr, "kernel_launch: occupancy query says %d blocks per CU\n", per_cu); per_cu = 1; }
        grid = cus;
        (void)hipGetLastError();
    }
    if (grid < 0) return;
    hipMemsetAsync((char*)d_ws + WS_CTL, 0, ZERO_BYTES, stream);
    Params p{};
    for (int i = 0; i < 28; ++i) p.in[i] = (const float*)d_in[i];
    p.out = (float*)d_out; p.ws = (unsigned char*)d_ws;
#if defined(MK_PER_PHASE)
#ifndef MK_SUB
#define MK_SUB 7
#endif
    for (int ph = 0; ph < 24; ++ph) { p.ph_lo = ph; p.ph_hi = ph + 1;
        int nrep = (ph >= 1 && ph < 23 && ((MK_PER_PHASE >> ((ph - 1) % 11)) & 2)) ? 2 : 1;
        if (ph == 0 && (MK_PER_PHASE & (1 << 13))) nrep = 2; if (ph == 23 && (MK_PER_PHASE & (1 << 14))) nrep = 2; if (ph == 1 && (MK_PER_PHASE & (1 << 15))) nrep = 2;
        for (int rep = 0; rep < nrep; ++rep) { p.sub = rep == 0 ? 7 : (MK_SUB | 32); hipLaunchKernelGGL(mk_fwd, dim3(grid), dim3(NT), LDS_BYTES, stream, p); } }
#else
    p.ph_lo = 0; p.ph_hi = 24; p.sub = 7;
    void* args[] = {&p};
    hipError_t e = hipLaunchCooperativeKernel((const void*)mk_fwd, dim3(grid), dim3(NT), args, LDS_BYTES, stream);
    if (e != hipSuccess) fprintf(stderr, "cooperative launch failed: %s (grid %d)\n", hipGetErrorString(e), grid);
#endif
}
```

```cpp
#define PROBE_TSET 0
#include <hip/hip_runtime.h>
#include <hip/hip_cooperative_groups.h>
#include <cstdio>
namespace cg = cooperative_groups;

#define DI __device__ __forceinline__
#define LAS __attribute__((address_space(3)))
typedef unsigned short bf16_t;
typedef short bf16x8 __attribute__((ext_vector_type(8)));
typedef short s16x4 __attribute__((ext_vector_type(4)));
typedef float f32x4 __attribute__((ext_vector_type(4)));
typedef float f32x2 __attribute__((ext_vector_type(2)));
typedef float f32x16 __attribute__((ext_vector_type(16)));
typedef unsigned u32x4 __attribute__((ext_vector_type(4)));
typedef unsigned u32x2 __attribute__((ext_vector_type(2)));

constexpr int NB = 8, SEQ = 2048, CTX = 256, TT = 2304, DM = 1024, MROWS = NB * TT, NLAYER = 2;
constexpr int PW = 7696;
constexpr int NT = 512;
constexpr float EPS = 1e-6f;
constexpr size_t SLOT_ELEMS = (size_t)MROWS * 512;
constexpr int MPAD = 40960;
constexpr int NLC = 72;

constexpr size_t W_IN = 0, W_BR = W_IN + (size_t)7936 * 1024,
                 W_OUT = W_BR + (size_t)3 * 1024 * 512, W_GU = W_OUT + (size_t)1024 * 1024,
                 W_DN = W_GU + (size_t)16 * 1024 * 1024, W_LAYER = W_DN + (size_t)16 * 1024 * 512;

constexpr size_t WS_CTL = 0;
constexpr size_t WS_MOD = 65536;
constexpr size_t ZERO_BYTES = WS_MOD + (size_t)2 * 9 * 6144 * 4;
constexpr size_t WS_WSM = 524288;
constexpr size_t WS_WRT = WS_WSM + (size_t)2 * 16 * 1024 * 4;
constexpr size_t WS_BA = WS_WRT + (size_t)16 * 1024 * 4;
constexpr size_t WS_LRS = WS_BA + (size_t)MROWS * 16 * 4;
constexpr size_t WS_ROUTE = WS_LRS + (size_t)NB * 2 * NLC * 512 * 2 * 4;
constexpr size_t WS_WGT = WS_ROUTE + (size_t)MROWS * 8 * 4;
constexpr size_t WS_GSC = WS_WGT + (size_t)2 * 131072 * 2;
constexpr size_t NCD = (size_t)NB * 4 * 2 * 72;
constexpr size_t WS_GT = WS_GSC + NCD * 32 * 4 * 4;
constexpr size_t WS_GQK = WS_GT + NCD * 1024 * 2;
constexpr size_t WS_GQ = WS_GQK + NCD * 1024 * 2;
constexpr size_t GQ_ELEMS = (size_t)NB * 4 * TT * 128;
constexpr size_t WS_WB = WS_GQ + 3 * GQ_ELEMS * 2;
constexpr size_t WS_XS = WS_WB + (size_t)W_LAYER * 2;
constexpr size_t WS_H = WS_XS + (size_t)MROWS * 1024 * 4;
constexpr size_t WS_SLOT = WS_H + (size_t)MROWS * 1024 * 2;
constexpr size_t WS_END = WS_SLOT + (size_t)14 * SLOT_ELEMS * 2;
static_assert(WS_END <= (size_t)536870912, "workspace layout exceeds 512 MiB");

struct Params {
    const float* in[28];
    float* out;
    unsigned char* ws;
    int ph_lo, ph_hi, sub, pad;
};

struct Frame {
    const LAS unsigned long long* itab;
    float* out;
    unsigned char* ws;
    int tid, lane, wave, G, bid;
    DI const float* inp(int i) const { const unsigned long long v = itab[i];
        const unsigned lo = __builtin_amdgcn_readfirstlane((unsigned)v), hi = __builtin_amdgcn_readfirstlane((unsigned)(v >> 32));
        return (const float*)(const __attribute__((address_space(1))) float*)(((unsigned long long)hi << 32) | lo); }
    DI bf16_t* slot(int s) const { return (bf16_t*)(ws + WS_SLOT) + (size_t)s * SLOT_ELEMS; }
    DI bf16_t* wb(int) const { return (bf16_t*)(ws + WS_WB); }
    DI float* mod(int L, int mi) const { return (float*)(ws + WS_MOD) + (size_t)(L * 9 + mi) * 6144; }
    DI float* xs() const { return (float*)(ws + WS_XS); }
    DI bf16_t* h() const { return (bf16_t*)(ws + WS_H); }
    DI unsigned* ctl() const { return (unsigned*)(ws + WS_CTL); }
    DI unsigned* route() const { return (unsigned*)(ws + WS_ROUTE); }
};

DI float bf2f(bf16_t b) { return __uint_as_float(((unsigned)b) << 16); }
DI bf16_t f2bf(float f) { return __builtin_bit_cast(unsigned short, (__bf16)f); }
DI unsigned pack2(float a, float b) { typedef __bf16 v2 __attribute__((ext_vector_type(2))); v2 v; v[0] = (__bf16)a; v[1] = (__bf16)b; return __builtin_bit_cast(unsigned, v); }
DI float sigmoid_f(float x) { return __builtin_amdgcn_rcpf(1.f + __expf(-x)); }
DI float silu_f(float x) { return x * __builtin_amdgcn_rcpf(1.f + __expf(-x)); }
DI float softplus_f(float x) { return fmaxf(x, 0.f) + log1pf(__expf(-fabsf(x))); }
DI float gelu_tanh_f(float x) { const float u = 0.7978845608028654f * (x + 0.044715f * x * x * x); return x * __builtin_amdgcn_rcpf(1.f + __expf(-2.f * u)); }
DI float neg_expm1_f(float x) { const float p = -x * (1.f + x * (0.5f + x * (0.16666667f + x * (0.041666668f + x * (0.0083333338f + x * 0.0013888889f))))); return x > -0.25f ? p : 1.f - __expf(x); }
DI float wave_sum(float v) {
#pragma unroll
    for (int o = 32; o >= 1; o >>= 1) v += __shfl_xor(v, o);
    return v;
}
template <int CTRL> DI float dpp_add(float v) { return v + __int_as_float(__builtin_amdgcn_update_dpp(0, __float_as_int(v), CTRL, 0xf, 0xf, false)); }
DI float row16_sum_dpp(float v) { v = dpp_add<0xB1>(v); v = dpp_add<0x4E>(v); v = dpp_add<0x124>(v); v = dpp_add<0x128>(v); return v; }
DI float wave_sum_fast(float v) { v = row16_sum_dpp(v); v += __shfl_xor(v, 16); v += __shfl_xor(v, 32); return v; }
DI int modidx(int r) { const int b = r / TT, t = r - b * TT; return t < CTX ? 8 : b; }
#define MFMA32(a, b, c) __builtin_amdgcn_mfma_f32_32x32x16_bf16((a), (b), (c), 0, 0, 0)
namespace pg8 {
constexpr int BM = 256, BK = 64, HALF = 128, HTB = HALF * BK * 2  , STAGE_BYTES = 8 * HTB, NXCD = 8, WGM = 8;

__host__ __device__ __forceinline__ int lds_byte(int r, int c) { const int st = (r >> 4) * 2 + (c >> 5), rr = r & 15, cc = c & 31, ob = rr * 64 + cc * 2; return st * 1024 + (ob ^ (((ob >> 9) & 1) << 5)); }
__host__ __device__ __forceinline__ void stage_rc(int b, int& R, int& C) { const int st = b / 1024, sb = b % 1024, swz = sb ^ (((sb >> 9) & 1) << 5); R = (st >> 1) * 16 + swz / 64; C = (st & 1) * 32 + (swz % 64) / 2; }
__host__ __device__ __forceinline__ int perm32(int rho) { const int n = rho >> 4, i = rho & 15; return 8 * (i >> 2) + 4 * n + (i & 3); }

struct Unit { int pm, pn; };
struct Gemm { const bf16_t* A; const bf16_t* Bt; int K; };

DI bool grid_unit(int nM, int nN, long L, Unit& u) {
    const int nwg = nM * nN; if (L >= nwg) return false;
    int wgid = (int)L; { const int q = nwg / NXCD, r = nwg % NXCD, xcd = wgid % NXCD, off = wgid / NXCD; wgid = (xcd < r ? xcd * (q + 1) : r * (q + 1) + (xcd - r) * q) + off; }
    const int nig = WGM * nN, gid = wgid / nig, fm = gid * WGM, gsz = (nM - fm) < WGM ? (nM - fm) : WGM;
    u.pm = fm + ((wgid % nig) % gsz); u.pn = (wgid % nig) / gsz; return true;
}
DI int lat_tile(int j) { return (j >> 3) * 9 + 1 + (j & 7); }
struct StaticOrder {
    int nM, nN, G, c, lat;
    DI bool next(int i, Unit& u) const { if (!grid_unit(lat ? 64 : nM, nN, (long)i * G + c, u)) return false; if (lat) u.pm = lat_tile(u.pm); return true; }
};
struct MergeOrder {
    int G, c, lat;
    DI bool next(int i, Unit& u) const {
        const int n = i % 3; Unit t; if (!grid_unit(lat ? 64 : 72, 4, (long)(i / 3) * G + c, t)) return false;
        if (lat) t.pm = lat_tile(t.pm);
        u.pm = n * 72 + t.pm; u.pn = n * 4 + t.pn; return true;
    }
};
struct MoeOrder {
    const LAS int* tb; int G, c;
    DI bool next(int i, Unit& u) const {
        const int nrt = __builtin_amdgcn_readfirstlane(tb[16]); Unit t; if (!grid_unit(nrt, 4, (long)i * G + c, t)) return false;
        const int pm = t.pm, j = t.pn; int e = 0;
#pragma unroll
        for (int q = 1; q < 16; ++q) e += (pm >= __builtin_amdgcn_readfirstlane(tb[q])) ? 1 : 0;
        u.pm = pm; u.pn = e * 4 + j; return true;
    }
};

typedef f32x4 (&AccRef)[2][2][4][2];

struct EpiSlots {
    static constexpr bool PERM = true;
    bf16_t* base; int smap[9]; float* ba; bool sig;
    DI bool operator()(AccRef acc, const Unit& u, int wr, int wc, int fr, int fq) const {
        if (u.pn == 18) {
            if (wc == 0 && fq < 2) { const int row0 = u.pm * BM + wr * 64 + fr;
#pragma unroll
                for (int ai = 0; ai < 2; ++ai)
#pragma unroll
                    for (int m = 0; m < 4; ++m) { float* rp = ba + (size_t)(row0 + ai * HALF + m * 16) * 16 + 8 * fq; *(f32x4*)rp = acc[ai][0][m][0]; *(f32x4*)(rp + 4) = acc[ai][0][m][1]; } }
            return false; }
        int sl = 0;
#pragma unroll
        for (int q = 0; q < 9; ++q) sl = ((u.pn >> 1) == q) ? smap[q] : sl;
        bf16_t* O = base + (size_t)sl * SLOT_ELEMS;
        const int row0 = u.pm * BM + wr * 64 + fr, col0 = (u.pn & 1) * 256 + wc * 32 + 8 * fq;
#pragma unroll
        for (int ai = 0; ai < 2; ++ai)
#pragma unroll
            for (int m = 0; m < 4; ++m) { bf16_t* rowp = O + (size_t)(row0 + ai * HALF + m * 16) * 512 + col0;
#pragma unroll
                for (int bj = 0; bj < 2; ++bj) { f32x4 v0 = acc[ai][bj][m][0], v1 = acc[ai][bj][m][1];
                    if (sig) {
#pragma unroll
                        for (int q = 0; q < 4; ++q) { v0[q] = sigmoid_f(v0[q]); v1[q] = sigmoid_f(v1[q]); } }
                    u32x4 w; w.x = pack2(v0[0], v0[1]); w.y = pack2(v0[2], v0[3]); w.z = pack2(v1[0], v1[1]); w.w = pack2(v1[2], v1[3]);
                    *(u32x4*)(rowp + bj * HALF) = w; } }
        return false;
    }
};
struct EpiMerge {
    static constexpr bool PERM = true;
    bf16_t* merged; const bf16_t* slots;
    DI bool operator()(AccRef acc, const Unit& u, int wr, int wc, int fr, int fq) const {
        const int n = u.pm / 72, pm = u.pm - n * 72, pn = u.pn & 3;
        const int row0 = pm * BM + wr * 64 + fr, col0 = pn * 256 + wc * 32 + 8 * fq;
        const int j = 2 * n + (col0 >> 9), gs = j < 3 ? j : j + 6;
        const int j2 = n < 2 ? j + 2 : j, gs2 = j2 < 3 ? j2 : j2 + 6;
        const bf16_t* G = slots + (size_t)gs * SLOT_ELEMS; const bf16_t* G2 = slots + (size_t)gs2 * SLOT_ELEMS;
        const int gcol0 = col0 & 511;
#pragma unroll
        for (int ai = 0; ai < 2; ++ai)
#pragma unroll
            for (int m = 0; m < 4; ++m) { const size_t row = (size_t)(row0 + ai * HALF + m * 16);
#pragma unroll
                for (int bj = 0; bj < 2; ++bj) {
                    const u32x4 gw = *(const u32x4*)(G + row * 512 + gcol0 + bj * HALF);
                    const unsigned gg[4] = {gw.x, gw.y, gw.z, gw.w};
                    float f[8];
#pragma unroll
                    for (int q = 0; q < 4; ++q) { f[2 * q] = __uint_as_float(gg[q] << 16); f[2 * q + 1] = __uint_as_float(gg[q] & 0xffff0000u); }
                    if (n < 2) {
                        const u32x4 hw = *(const u32x4*)(G2 + row * 512 + gcol0 + bj * HALF);
                        const unsigned hh2[4] = {hw.x, hw.y, hw.z, hw.w};
#pragma unroll
                        for (int q = 0; q < 4; ++q) { f[2 * q] *= __builtin_amdgcn_rcpf(fmaxf(__uint_as_float(hh2[q] << 16), 1e-30f)); f[2 * q + 1] *= __builtin_amdgcn_rcpf(fmaxf(__uint_as_float(hh2[q] & 0xffff0000u), 1e-30f)); }
#pragma unroll
                        for (int q = 0; q < 4; ++q) { acc[ai][bj][m][0][q] *= f[q]; acc[ai][bj][m][1][q] *= f[4 + q]; }
                    } else {
                        bf16_t* mp = merged + row * 1024 + col0 + bj * HALF;
                        float v[8];
#pragma unroll
                        for (int q = 0; q < 4; ++q) { v[q] = acc[ai][bj][m][0][q] * f[q]; v[4 + q] = acc[ai][bj][m][1][q] * f[4 + q]; }
                        u32x4 w; w.x = pack2(v[0], v[1]); w.y = pack2(v[2], v[3]); w.z = pack2(v[4], v[5]); w.w = pack2(v[6], v[7]);
                        *(u32x4*)mp = w; } } }
        return n < 2;
    }
};
struct EpiResid {
    static constexpr bool PERM = false;
    float* xs; const float* modL; bool dry;
    DI bool operator()(AccRef acc, const Unit& u, int wr, int wc, int fr, int fq) const {
        const int row0 = u.pm * BM + wr * 64 + fr, col0 = u.pn * BM + wc * 32 + 4 * fq;
#pragma unroll
        for (int ai = 0; ai < 2; ++ai)
#pragma unroll
            for (int m = 0; m < 4; ++m) { const int row = row0 + ai * HALF + m * 16; float* rowp = xs + (size_t)row * 1024 + col0;
                const float* g = modL + (size_t)modidx(row) * 6144 + 2048 + col0;
#pragma unroll
                for (int bj = 0; bj < 2; ++bj)
#pragma unroll
                    for (int n = 0; n < 2; ++n) { const f32x4 gv = *(const f32x4*)(g + bj * HALF + n * 16); f32x4 x = *(f32x4*)(rowp + bj * HALF + n * 16);
                        x += gv * acc[ai][bj][m][n]; if (!dry) *(f32x4*)(rowp + bj * HALF + n * 16) = x; } }
        return false;
    }
};
struct EpiMoe1 {
    static constexpr bool PERM = true;
    bf16_t* act;
    DI bool operator()(AccRef acc, const Unit& u, int wr, int wc, int fr, int fq) const {
        const int row0 = u.pm * BM + wr * 64 + fr, col0 = (u.pn & 3) * 128 + wc * 32 + 8 * fq;
#pragma unroll
        for (int ai = 0; ai < 2; ++ai)
#pragma unroll
            for (int m = 0; m < 4; ++m) { bf16_t* rowp = act + (size_t)(row0 + ai * HALF + m * 16) * 512 + col0;
                float v[8];
#pragma unroll
                for (int q = 0; q < 4; ++q) { v[q] = silu_f(acc[ai][0][m][0][q]) * acc[ai][1][m][0][q]; v[4 + q] = silu_f(acc[ai][0][m][1][q]) * acc[ai][1][m][1][q]; }
                u32x4 w; w.x = pack2(v[0], v[1]); w.y = pack2(v[2], v[3]); w.z = pack2(v[4], v[5]); w.w = pack2(v[6], v[7]);
                *(u32x4*)rowp = w; }
        return false;
    }
};
struct EpiMoe2 {
    static constexpr bool PERM = true;
    bf16_t* ys; bool dry;
    DI bool operator()(AccRef acc, const Unit& u, int wr, int wc, int fr, int fq) const {
        const int row0 = u.pm * BM + wr * 64 + fr, col0 = (u.pn & 3) * 256 + wc * 32 + 8 * fq;
#pragma unroll
        for (int ai = 0; ai < 2; ++ai)
#pragma unroll
            for (int m = 0; m < 4; ++m) { bf16_t* rowp = ys + (size_t)(row0 + ai * HALF + m * 16) * 1024 + col0;
#pragma unroll
                for (int bj = 0; bj < 2; ++bj) { const f32x4 v0 = acc[ai][bj][m][0], v1 = acc[ai][bj][m][1];
                    u32x4 w; w.x = pack2(v0[0], v0[1]); w.y = pack2(v0[2], v0[3]); w.z = pack2(v1[0], v1[1]); w.w = pack2(v1[2], v1[3]);
                    if (!dry) *(u32x4*)(rowp + bj * HALF) = w; else asm volatile("" :: "v"(w.x), "v"(w.y), "v"(w.z), "v"(w.w)); } }
        return false;
    }
};

template <class Epi, class Sched>
DI void gemm_phase(LAS unsigned char* lds, const Gemm g, const Sched& S, const Epi& E, const int tid) {
    const int wid = __builtin_amdgcn_readfirstlane(tid >> 6), lane = tid & 63, wr = wid >> 2, wc = wid & 3, fr = lane & 15, fq = lane >> 4;
    const int K = g.K, nt = K / BK;
    unsigned voffA[2], voffB[2];
#pragma unroll
    for (int i = 0; i < 2; ++i) { int R, C; stage_rc(tid * 16 + i * 8192, R, C); const int Rb = Epi::PERM ? ((R & ~31) + perm32(R & 31)) : R;
        voffA[i] = (unsigned)(R * K + C) * 2u; voffB[i] = (unsigned)(Rb * K + C) * 2u; }
    const size_t kstep = (size_t)(BK * 2);
    const size_t hstep = (size_t)HALF * K * 2;
    const size_t tstep = 2 * hstep;
    const unsigned ldsw = (unsigned)wid * 1024u;
    const int aoff = lds_byte(wr * 64 + fr, fq * 8), boff = lds_byte(wc * 32 + fr, fq * 8);
#define PG8_SA(b, h) (((b) * 2 + (h)) * HTB)
#define PG8_SB(b, h) ((4 + (b) * 2 + (h)) * HTB)
#define PG8_STAGE(bufoff, gbase, voff) do { _Pragma("unroll") for (int _i = 0; _i < 2; ++_i) \
        __builtin_amdgcn_global_load_lds((const unsigned*)((const char*)(gbase) + (voff)[_i]), (LAS unsigned*)(lds + (bufoff) + ldsw + _i * 8192), 16, 0, 0); } while (0)
#define PG8_LDA(dst, b, h) do { _Pragma("unroll") for (int m = 0; m < 4; ++m) _Pragma("unroll") for (int k = 0; k < 2; ++k) dst[m][k] = *(const LAS bf16x8*)(lds + PG8_SA(b, h) + aoff + m * 2048 + k * 1024); } while (0)
#define PG8_LDB(dst, b, h) do { _Pragma("unroll") for (int n = 0; n < 2; ++n) _Pragma("unroll") for (int k = 0; k < 2; ++k) dst[n][k] = *(const LAS bf16x8*)(lds + PG8_SB(b, h) + boff + n * 2048 + k * 1024); } while (0)
#define PG8_MMA(ai, bj, At, Bt) do { __builtin_amdgcn_s_setprio(1); _Pragma("unroll") for (int m = 0; m < 4; ++m) _Pragma("unroll") for (int n = 0; n < 2; ++n) _Pragma("unroll") for (int k = 0; k < 2; ++k) \
        acc[ai][bj][m][n] = __builtin_amdgcn_mfma_f32_16x16x32_bf16(Bt[n][k], At[m][k], acc[ai][bj][m][n], 0, 0, 0); __builtin_amdgcn_s_setprio(0); } while (0)
#define PG8_WAIT_V(n) asm volatile("s_waitcnt vmcnt(" #n ")" ::: "memory")
#define PG8_WAIT_L(n) asm volatile("s_waitcnt lgkmcnt(" #n ")" ::: "memory")
#define PG8_BAR __builtin_amdgcn_s_barrier()
#define PG8_SCHED __builtin_amdgcn_sched_barrier(0)
    Unit cur, nxt; int ui = 0;
    if (!S.next(0, cur)) return;
    f32x4 acc[2][2][4][2];
#pragma unroll
    for (int a = 0; a < 2; ++a)
#pragma unroll
        for (int b = 0; b < 2; ++b)
#pragma unroll
            for (int m = 0; m < 4; ++m)
#pragma unroll
                for (int n = 0; n < 2; ++n) acc[a][b][m][n] = (f32x4){0.f, 0.f, 0.f, 0.f};
    bf16x8 At[4][2], B0[2][2], B1[2][2];
    const char* cA = (const char*)g.A + (size_t)cur.pm * tstep; const char* cB = (const char*)g.Bt + (size_t)cur.pn * tstep;
    PG8_STAGE(PG8_SB(0, 0), cB, voffB); PG8_STAGE(PG8_SA(0, 0), cA, voffA); PG8_STAGE(PG8_SB(0, 1), cB + hstep, voffB); PG8_STAGE(PG8_SA(0, 1), cA + hstep, voffA);
    if (wr == 1) PG8_BAR;
    PG8_WAIT_V(4); PG8_BAR;
    PG8_STAGE(PG8_SB(1, 0), cB + kstep, voffB); PG8_STAGE(PG8_SA(1, 0), cA + kstep, voffA); PG8_STAGE(PG8_SB(1, 1), cB + hstep + kstep, voffB);
    PG8_WAIT_V(6); PG8_BAR;
    for (;;) {
        const bool has_next = S.next(ui + 1, nxt);
        const char* nA = has_next ? (const char*)g.A + (size_t)nxt.pm * tstep : cA; const char* nB = has_next ? (const char*)g.Bt + (size_t)nxt.pn * tstep : cB;
        for (int t = 0; t < nt; t += 2) {
            const bool last = (t == nt - 2);
            const char* a1 = cA + (size_t)(t + 1) * kstep;
            const char* a2 = last ? nA : cA + (size_t)(t + 2) * kstep; const char* b2 = last ? nB : cB + (size_t)(t + 2) * kstep;
            const char* a3 = a2 + kstep; const char* b3 = b2 + kstep;
            PG8_LDB(B0, 0, 0); PG8_SCHED; PG8_LDA(At, 0, 0); PG8_STAGE(PG8_SA(1, 1), a1 + hstep, voffA);
            PG8_WAIT_L(8); PG8_BAR; PG8_WAIT_L(0); PG8_MMA(0, 0, At, B0); PG8_BAR; PG8_SCHED;
            PG8_LDB(B1, 0, 1); PG8_STAGE(PG8_SB(0, 0), b2, voffB);
            PG8_BAR; PG8_WAIT_L(0); PG8_MMA(0, 1, At, B1); PG8_BAR;
            PG8_LDA(At, 0, 1); PG8_STAGE(PG8_SA(0, 0), a2, voffA);
            PG8_BAR; PG8_WAIT_L(0); PG8_MMA(1, 0, At, B0); PG8_BAR; PG8_SCHED;
            PG8_STAGE(PG8_SB(0, 1), b2 + hstep, voffB);
            PG8_WAIT_V(6); PG8_BAR; PG8_MMA(1, 1, At, B1); PG8_BAR;
            PG8_LDB(B0, 1, 0); PG8_SCHED; PG8_LDA(At, 1, 0); PG8_STAGE(PG8_SA(0, 1), a2 + hstep, voffA);
            PG8_WAIT_L(8); PG8_BAR; PG8_WAIT_L(0); PG8_MMA(0, 0, At, B0); PG8_BAR; PG8_SCHED;
            PG8_LDB(B1, 1, 1); PG8_STAGE(PG8_SB(1, 0), b3, voffB);
            PG8_BAR; PG8_WAIT_L(0); PG8_MMA(0, 1, At, B1); PG8_BAR;
            PG8_LDA(At, 1, 1); PG8_STAGE(PG8_SA(1, 0), a3, voffA);
            PG8_BAR; PG8_WAIT_L(0); PG8_MMA(1, 0, At, B0); PG8_BAR; PG8_SCHED;
            PG8_STAGE(PG8_SB(1, 1), b3 + hstep, voffB);
            PG8_WAIT_V(6); PG8_BAR; PG8_MMA(1, 1, At, B1); PG8_BAR;
        }
        const bool keep = E(acc, cur, wr, wc, fr, fq);
        if (!has_next) break;
        if (!keep)
#pragma unroll
        for (int a = 0; a < 2; ++a)
#pragma unroll
            for (int b = 0; b < 2; ++b)
#pragma unroll
                for (int m = 0; m < 4; ++m)
#pragma unroll
                    for (int n = 0; n < 2; ++n) acc[a][b][m][n] = (f32x4){0.f, 0.f, 0.f, 0.f};
        cur = nxt; cA = nA; cB = nB; ++ui;
    }
    PG8_WAIT_V(0);
    if (wr == 0) PG8_BAR;
    PG8_BAR;
#undef PG8_SA
#undef PG8_SB
#undef PG8_STAGE
#undef PG8_LDA
#undef PG8_LDB
#undef PG8_MMA
#undef PG8_WAIT_V
#undef PG8_WAIT_L
#undef PG8_BAR
#undef PG8_SCHED
}
}
#define XB_TMO      128
#define XB_XCNT(j)  (256  + 64 * (j))
#define XB_XSUB(j)  (1280 + 64 * (j))
#define XB_XGEN(j)  (2304 + 64 * (j))
#define XB_TOP      3328
#define XB_TOPGEN   3392
#define XCD_BAR_WORDS 3456
#define XB_SPIN_CAP (1u << 18)

__device__ __forceinline__ unsigned xb_ld(unsigned* p)              { return __hip_atomic_load(p, __ATOMIC_RELAXED, __HIP_MEMORY_SCOPE_AGENT); }
__device__ __forceinline__ unsigned xb_add(unsigned* p, unsigned v) { return __hip_atomic_fetch_add(p, v, __ATOMIC_RELAXED, __HIP_MEMORY_SCOPE_AGENT); }
__device__ __forceinline__ unsigned xb_xcc_id() { return (unsigned)__builtin_amdgcn_s_getreg((3 << 11) | 20) & 0xFu; }
#define XB_SPIN(cond, bar) do { unsigned _sp = 0; while (cond) { __builtin_amdgcn_s_sleep(1); \
    if ((++_sp & 255u) == 0u) { if (xb_ld(&(bar)[XB_TMO])) break; if (_sp > XB_SPIN_CAP) { atomicAdd(&(bar)[XB_TMO], 1u); break; } } } } while (0)

struct XcdBarrier {
    unsigned* bar; unsigned x;
    volatile LAS unsigned* st;
};

__device__ __forceinline__ XcdBarrier xcd_barrier_post(unsigned* bar, volatile LAS unsigned* st) {
    XcdBarrier b; b.bar = bar; b.x = xb_xcc_id(); b.st = st;
    if (threadIdx.x == 0) (void)xb_add(&bar[XB_XCNT(b.x)], 1u);
    return b;
}
__device__ __forceinline__ void xcd_barrier_complete(unsigned* bar, unsigned x, unsigned& nloc, unsigned& nx) {
    const unsigned G = gridDim.x * gridDim.y * gridDim.z;
    unsigned sum, cnt, mine, sp = 0u;
    for (;;) {
        sum = 0u; cnt = 0u; mine = 0u;
#pragma unroll
        for (unsigned j = 0; j < 16; ++j) { const unsigned c = xb_ld(&bar[XB_XCNT(j)]); sum += c; cnt += (c > 0u) ? 1u : 0u; mine = (j == x) ? c : mine; }
        if (sum == G) break;
        __builtin_amdgcn_s_sleep(1);
        if ((++sp & 255u) == 0u) { if (xb_ld(&bar[XB_TMO])) break; if (sp > XB_SPIN_CAP) { atomicAdd(&bar[XB_TMO], 1u); break; } }
    }
    nloc = mine > 0u ? mine : 1u; nx = cnt > 0u ? cnt : 1u;
}

__device__ __forceinline__ void xcd_barrier(const XcdBarrier& b) {
    asm volatile("s_waitcnt vmcnt(0)" ::: "memory");
    __syncthreads();
    if (threadIdx.x == 0) {
        unsigned* bar = b.bar;
        __builtin_amdgcn_s_waitcnt(0);
        unsigned nloc = b.st[0], nx = b.st[1];
        if (nloc == 0u) { xcd_barrier_complete(bar, b.x, nloc, nx); b.st[0] = nloc; b.st[1] = nx; }
        const unsigned old = xb_add(&bar[XB_XSUB(b.x)], 1u);
        const unsigned gen = old / nloc;
        if (old + 1u == (gen + 1u) * nloc) {
            __builtin_amdgcn_fence(__ATOMIC_RELEASE, "agent");
            asm volatile("s_waitcnt vmcnt(0)" ::: "memory");
            const unsigned og = xb_add(&bar[XB_TOP], 1u);
            const unsigned tg = og / nx;
            if (og + 1u == (tg + 1u) * nx) xb_add(&bar[XB_TOPGEN], 1u);
            else XB_SPIN(xb_ld(&bar[XB_TOPGEN]) == tg, bar);
            __builtin_amdgcn_fence(__ATOMIC_ACQUIRE, "agent");
            xb_add(&bar[XB_XGEN(b.x)], 1u);
            asm volatile("s_waitcnt vmcnt(0)" ::: "memory");
        } else {
            XB_SPIN(xb_ld(&bar[XB_XGEN(b.x)]) == gen, bar);
            __builtin_amdgcn_fence(__ATOMIC_ACQUIRE, "agent");
            asm volatile("s_waitcnt vmcnt(0)" ::: "memory");
        }
    }
    __syncthreads();
}

constexpr int LDS_BYTES = 163840;
constexpr int LDS_MISC = 162816;

DI void phase0(const Frame& F, LAS unsigned char* lds) {
    const int G = F.G, bid = F.bid;
    { float* wsm = (float*)(F.ws + WS_WSM); float* wrt = (float*)(F.ws + WS_WRT);
      for (int idx = bid * NT + F.tid; idx < 2 * 16 * 1024 + 16 * 1024; idx += G * NT) {
          if (idx < 2 * 16 * 1024) { const int L = idx >> 14, j = (idx >> 10) & 15, k = idx & 1023; wsm[idx] = F.inp(8)[((size_t)L * 1024 + k) * PW + 2048 + j]; }
          else { const int q = idx - 2 * 16 * 1024, j = q >> 10, k = q & 1023; wrt[q] = F.inp(24)[k * 16 + j]; } } }
    { bf16_t* wgt = (bf16_t*)(F.ws + WS_WGT);
      for (int idx = bid * NT + F.tid; idx < 2 * 131072; idx += G * NT) { const int j = idx & 63, k = (idx >> 6) & 63, hi = idx >> 12;
          wgt[idx] = f2bf(F.inp(19)[((size_t)hi * 64 + j) * 64 + k]); } }
    { LAS float* sil = (LAS float*)lds; LAS float* red = sil + 9 * 1024;
      for (int it = bid; it < 96; it += G) {
          const int L = it / 48, cb = it % 48;
          __syncthreads();
          for (int i = F.tid; i < 9 * 1024; i += NT) { const int r = i >> 10, k = i & 1023; const float c = r < 8 ? F.inp(1)[r * 1024 + k] : F.inp(3)[k]; sil[i] = silu_f(c); }
          __syncthreads();
          const int cl = F.tid & 127, kq = F.tid >> 7, col = cb * 128 + cl; const float* wm = F.inp(4) + (size_t)L * 1024 * 6144 + (size_t)(kq * 256) * 6144 + col;
          float acc[9];
#pragma unroll
          for (int r = 0; r < 9; ++r) acc[r] = 0.f;
          for (int k = 0; k < 256; ++k) { const float w = wm[(size_t)k * 6144];
#pragma unroll
              for (int r = 0; r < 9; ++r) acc[r] += sil[r * 1024 + kq * 256 + k] * w; }
#pragma unroll
          for (int r = 0; r < 9; ++r) red[(kq * 9 + r) * 128 + cl] = acc[r];
          __syncthreads();
          if (kq == 0) { const float bias = F.inp(5)[L * 6144 + col];
#pragma unroll
              for (int r = 0; r < 9; ++r) F.mod(L, r)[col] = ((red[(0 * 9 + r) * 128 + cl] + red[(1 * 9 + r) * 128 + cl]) + (red[(2 * 9 + r) * 128 + cl] + red[(3 * 9 + r) * 128 + cl])) + bias; }
      }
      __syncthreads(); }
}

struct TrDesc { const float* src; bf16_t* dst; int ld, K; };
DI TrDesc tr_decode(const Frame& F, int L, int it) {
    bf16_t* wb = F.wb(L); int q = it; TrDesc d;
    if (q < 1984) { const int kt = q / 124, nt = q % 124, n0 = nt * 64;
        const int c0 = n0 < 2048 ? n0 : (n0 < 4608 ? n0 + 16 : (n0 < 4864 ? 2048 + (n0 - 4608) : n0 - 256 + 16));
        d.src = F.inp(8) + (size_t)L * 1024 * PW + (size_t)(kt * 64) * PW + c0; d.ld = PW; d.K = 1024; d.dst = wb + W_IN + (size_t)n0 * 1024 + kt * 64; return d; }
    q -= 1984;
    if (q < 384) { const int br = q >> 7, r = q & 127, kt = r >> 4, nt = r & 15;
        d.src = F.inp(22) + (size_t)(L * 3 + br) * 512 * 1024 + (size_t)(kt * 64) * 1024 + nt * 64; d.ld = 1024; d.K = 512; d.dst = wb + W_BR + (size_t)br * 1024 * 512 + (size_t)(nt * 64) * 512 + kt * 64; return d; }
    q -= 384;
    if (q < 256) { const int kt = q >> 4, nt = q & 15;
        d.src = F.inp(23) + (size_t)L * 1024 * 1024 + (size_t)(kt * 64) * 1024 + nt * 64; d.ld = 1024; d.K = 1024; d.dst = wb + W_OUT + (size_t)(nt * 64) * 1024 + kt * 64; return d; }
    q -= 256;
    if (q < 4096) { const int e = q >> 8, r = q & 255, kt = r >> 4, nt = r & 15, n0 = nt * 64, t256 = n0 >> 8, wi = n0 & 255;
        const int c0 = wi < 128 ? t256 * 128 + wi : 512 + t256 * 128 + (wi - 128);
        d.src = F.inp(26) + (size_t)(L * 16 + e) * 1024 * 1024 + (size_t)(kt * 64) * 1024 + c0; d.ld = 1024; d.K = 1024; d.dst = wb + W_GU + (size_t)e * 1024 * 1024 + (size_t)n0 * 1024 + kt * 64; return d; }
    q -= 4096;
    { const int e = q >> 7, r = q & 127, kt = r >> 4, nt = r & 15;
        d.src = F.inp(27) + (size_t)(L * 16 + e) * 512 * 1024 + (size_t)(kt * 64) * 1024 + nt * 64; d.ld = 1024; d.K = 512; d.dst = wb + W_DN + (size_t)e * 1024 * 512 + (size_t)(nt * 64) * 512 + kt * 64; return d; }
}
DI void convert_weights(const Frame& F, int L, LAS unsigned char* lds) {
    const int G = F.G, bid = F.bid;
    const int kr = F.tid >> 4, c4 = (F.tid & 15) * 4, n = F.tid >> 3, kc = (F.tid & 7) * 8;
    __syncthreads();
    if (bid >= 8768) return;
    TrDesc cur = tr_decode(F, L, bid);
    f32x4 v0 = *(const f32x4*)(cur.src + (size_t)kr * cur.ld + c4), v1 = *(const f32x4*)(cur.src + (size_t)(kr + 32) * cur.ld + c4);
    int buf = 0;
    for (int it = bid; it < 8768; it += G) {
        const int itn = it + G < 8768 ? it + G : it;
        const TrDesc nxt = tr_decode(F, L, itn);
        const f32x4 n0 = *(const f32x4*)(nxt.src + (size_t)kr * nxt.ld + c4), n1 = *(const f32x4*)(nxt.src + (size_t)(kr + 32) * nxt.ld + c4);
        LAS float* tile = (LAS float*)lds + buf * (64 * 65);
        tile[kr * 65 + c4] = v0[0]; tile[kr * 65 + c4 + 1] = v0[1]; tile[kr * 65 + c4 + 2] = v0[2]; tile[kr * 65 + c4 + 3] = v0[3];
        tile[(kr + 32) * 65 + c4] = v1[0]; tile[(kr + 32) * 65 + c4 + 1] = v1[1]; tile[(kr + 32) * 65 + c4 + 2] = v1[2]; tile[(kr + 32) * 65 + c4 + 3] = v1[3];
        __syncthreads();
        float v[8];
#pragma unroll
        for (int i = 0; i < 8; ++i) v[i] = tile[(kc + i) * 65 + n];
        u32x4 w; w.x = pack2(v[0], v[1]); w.y = pack2(v[2], v[3]); w.z = pack2(v[4], v[5]); w.w = pack2(v[6], v[7]);
        *(u32x4*)(cur.dst + (size_t)n * cur.K + kc) = w;
        cur = nxt; v0 = n0; v1 = n1; buf ^= 1;
    }
    __syncthreads();
}

DI void norm_phase(const Frame& F, int L, int which, LAS unsigned char* lds, const bool dry = false) {
    const int G = F.G;
    LAS float* swl = (LAS float*)lds;
    if (which == 2) { const float* src = (const float*)(F.ws + WS_WRT);
      __syncthreads();
      if (F.tid < 32) ((LAS unsigned*)(lds + 65536))[F.tid] = 0u;
      for (int i = F.tid; i < 4096; i += NT) *(LAS f32x4*)(swl + i * 4) = *(const f32x4*)(src + i * 4);
      __syncthreads(); }
    const float* gain = (which == 1 ? F.inp(6) : F.inp(7)) + L * 1024;
    float* xs = F.xs(); bf16_t* H = F.h(); unsigned* route = F.route();
    const bf16_t* ys = F.slot(8);
    auto row_src = [&](int r) -> const float* { const int b = r / TT, t = r - b * TT;
        if (which == 1 && L == 0) return t < CTX ? F.inp(2) + ((size_t)b * CTX + t) * 1024 : F.inp(0) + ((size_t)b * SEQ + (t - CTX)) * 1024;
        return xs + (size_t)r * 1024; };
    struct RowBuf { f32x4 x[4]; u32x2 ya[4], yb[4]; float w0, w1; };
    auto fetch = [&](RowBuf& R, int r) { const float* src = row_src(r); R.w0 = 0.f; R.w1 = 0.f;
#pragma unroll
        for (int i = 0; i < 4; ++i) R.x[i] = *(const f32x4*)(src + F.lane * 4 + 256 * i);
        if (which == 1 && L > 0) { const unsigned* rt = route + (size_t)r * 8; R.w0 = __uint_as_float(rt[2]); R.w1 = __uint_as_float(rt[3]); const int p0 = (int)rt[4], p1 = (int)rt[5];
#pragma unroll
            for (int i = 0; i < 4; ++i) { const int c = F.lane * 4 + 256 * i; R.ya[i] = *(const u32x2*)(ys + (size_t)p0 * 1024 + c); R.yb[i] = *(const u32x2*)(ys + (size_t)p1 * 1024 + c); } } };
    const int rfirst = F.bid * 8 + F.wave, rstep = G * 8;
    RowBuf Ra, Rb;
    if (rfirst < MROWS) { fetch(Ra, rfirst); fetch(Rb, rfirst + rstep < MROWS ? rfirst + rstep : rfirst); }
    for (int r = rfirst; r < MROWS; r += rstep) {
        const int b = r / TT, t = r - b * TT, mi = t < CTX ? 8 : b;
        const RowBuf Rc = Ra; Ra = Rb; { const int rn = r + 2 * rstep; fetch(Rb, rn < MROWS ? rn : r); }
        if (which == 2 && L == 1 && t < CTX) continue;
        f32x4 x[4];
#pragma unroll
        for (int i = 0; i < 4; ++i) x[i] = Rc.x[i];
        if (which == 1 && L > 0) {
            const float w0 = Rc.w0, w1 = Rc.w1;
            const float* m5 = F.mod(L - 1, mi) + 5 * 1024;
#pragma unroll
            for (int i = 0; i < 4; ++i) { const int c = F.lane * 4 + 256 * i;
                const u32x2 a = Rc.ya[i], bq = Rc.yb[i]; const f32x4 g = *(const f32x4*)(m5 + c);
                x[i][0] += g[0] * (w0 * __uint_as_float(a.x << 16) + w1 * __uint_as_float(bq.x << 16));
                x[i][1] += g[1] * (w0 * __uint_as_float(a.x & 0xffff0000u) + w1 * __uint_as_float(bq.x & 0xffff0000u));
                x[i][2] += g[2] * (w0 * __uint_as_float(a.y << 16) + w1 * __uint_as_float(bq.y << 16));
                x[i][3] += g[3] * (w0 * __uint_as_float(a.y & 0xffff0000u) + w1 * __uint_as_float(bq.y & 0xffff0000u)); }
        }
        if (which == 1 && !dry) {
#pragma unroll
            for (int i = 0; i < 4; ++i) *(f32x4*)(xs + (size_t)r * 1024 + F.lane * 4 + 256 * i) = x[i];
        }
        float ss = 0.f;
#pragma unroll
        for (int i = 0; i < 4; ++i) ss += x[i][0] * x[i][0] + x[i][1] * x[i][1] + x[i][2] * x[i][2] + x[i][3] * x[i][3];
        ss = wave_sum_fast(ss);
        const float rstd = rsqrtf(ss * (1.f / 1024.f) + EPS);
        const float* mv = F.mod(L, mi) + (which == 1 ? 0 : 3 * 1024);
        f32x4 hh[4];
#pragma unroll
        for (int i = 0; i < 4; ++i) { const int c = F.lane * 4 + 256 * i; const f32x4 g = *(const f32x4*)(gain + c), sh = *(const f32x4*)(mv + c), sc = *(const f32x4*)(mv + 1024 + c);
#pragma unroll
            for (int q = 0; q < 4; ++q) hh[i][q] = (x[i][q] * rstd * g[q]) * (1.f + sc[q]) + sh[q];
            u32x2 w; w.x = pack2(hh[i][0], hh[i][1]); w.y = pack2(hh[i][2], hh[i][3]);
            if (!dry) *(u32x2*)(H + (size_t)r * 1024 + c) = w; }
        float dv = 0.f;
#pragma unroll 1
        for (int j0 = 0; j0 < (which == 2 ? 16 : 0); j0 += 8) {
            float a[8];
#pragma unroll
            for (int j = 0; j < 8; ++j) { a[j] = 0.f;
#pragma unroll
                for (int i = 0; i < 4; ++i) { const f32x4 w = *(const LAS f32x4*)(swl + (j0 + j) * 1024 + F.lane * 4 + 256 * i); a[j] += hh[i][0] * w[0] + hh[i][1] * w[1] + hh[i][2] * w[2] + hh[i][3] * w[3]; } }
#pragma unroll
            for (int j = 0; j < 8; ++j) a[j] = row16_sum_dpp(a[j]);
#pragma unroll
            for (int j = 0; j < 8; ++j) a[j] += __shfl_xor(a[j], 16);
#pragma unroll
            for (int j = 0; j < 8; ++j) a[j] += __shfl_xor(a[j], 32);
#pragma unroll
            for (int j = 0; j < 8; ++j) dv = (F.lane == j0 + j) ? a[j] : dv;
        }
        if (which == 2) {
            float p[16], mx = -3.0e38f;
#pragma unroll
            for (int j = 0; j < 16; ++j) { p[j] = __shfl(dv, j) + F.inp(25)[j]; mx = fmaxf(mx, p[j]); }
            float sum = 0.f;
#pragma unroll
            for (int j = 0; j < 16; ++j) { p[j] = __expf(p[j] - mx); sum += p[j]; }
            const float inv = 1.f / sum;
            float bs = -1.f, bp0 = 0.f, bp1 = 0.f; int be0 = 0, be1 = 1;
#pragma unroll
            for (int g = 0; g < 4; ++g) { float a = -1.f, c2 = -1.f; int ia = 0, ib = 0;
#pragma unroll
                for (int i = 0; i < 4; ++i) { const float v = p[g * 4 + i] * inv; if (v > a) { c2 = a; ib = ia; a = v; ia = i; } else if (v > c2) { c2 = v; ib = i; } }
                const float sc = a + c2; if (sc > bs) { bs = sc; bp0 = a; bp1 = c2; be0 = g * 4 + ia; be1 = g * 4 + ib; } }
            if (F.lane == 0 && !dry) {
                LAS unsigned* lcnt = (LAS unsigned*)(lds + 65536);
                const int pos0 = (int)__hip_atomic_fetch_add(lcnt + be0, 1u, __ATOMIC_RELAXED, __HIP_MEMORY_SCOPE_WORKGROUP), pos1 = (int)__hip_atomic_fetch_add(lcnt + be1, 1u, __ATOMIC_RELAXED, __HIP_MEMORY_SCOPE_WORKGROUP);
                unsigned* rt = route + (size_t)r * 8; const float wsum = bp0 + bp1;
                rt[0] = (unsigned)be0; rt[1] = (unsigned)be1; rt[2] = __float_as_uint(bp0 / wsum); rt[3] = __float_as_uint(bp1 / wsum); rt[6] = (unsigned)pos0; rt[7] = (unsigned)pos1;
            }
        }
    }
    if (which == 2 && !dry) {
        LAS unsigned* lcnt = (LAS unsigned*)(lds + 65536);
        __syncthreads();
        if (F.tid < 16) { const unsigned n = lcnt[F.tid]; lcnt[16 + F.tid] = n ? atomicAdd(F.ctl() + L * 16 + F.tid, n) : 0u; }
        __syncthreads();
        if (F.lane == 0) for (int r = rfirst; r < MROWS; r += rstep) { const int t = r % TT; if (L == 1 && t < CTX) continue;
            unsigned* rt = route + (size_t)r * 8; rt[6] += lcnt[16 + rt[0]]; rt[7] += lcnt[16 + rt[1]]; }
    }
}

DI void moe_tile_bases(const Frame& F, int L, LAS int* tb) {
    if (F.tid == 0) { const unsigned* cnt = F.ctl() + L * 16; int acc = 0;
        for (int e = 0; e < 16; ++e) { tb[e] = acc; acc += (int)((cnt[e] + 255u) >> 8); }
        tb[16] = acc; }
    __syncthreads();
}

DI void sort_phase(const Frame& F, int L, LAS int* tb) {
    moe_tile_bases(F, L, tb);
    const int G = F.G; const bf16_t* H = F.h(); bf16_t* h2s = F.slot(0); unsigned* route = F.route();
    for (int r = F.bid * 8 + F.wave; r < MROWS; r += G * 8) {
        if (L == 1 && r % TT < CTX) continue;
        unsigned* rt = route + (size_t)r * 8;
        const int e0 = (int)rt[0], e1 = (int)rt[1]; const int d0 = tb[e0] * 256 + (int)rt[6], d1 = tb[e1] * 256 + (int)rt[7];
        const u32x4 a = *(const u32x4*)(H + (size_t)r * 1024 + F.lane * 8), c = *(const u32x4*)(H + (size_t)r * 1024 + 512 + F.lane * 8);
        *(u32x4*)(h2s + (size_t)d0 * 1024 + F.lane * 8) = a; *(u32x4*)(h2s + (size_t)d0 * 1024 + 512 + F.lane * 8) = c;
        *(u32x4*)(h2s + (size_t)d1 * 1024 + F.lane * 8) = a; *(u32x4*)(h2s + (size_t)d1 * 1024 + 512 + F.lane * 8) = c;
        if (F.lane == 0) { rt[4] = (unsigned)d0; rt[5] = (unsigned)d1; }
    }
}

DI void final_phase(const Frame& F) {
    const int G = F.G; const float* xs = F.xs(); const bf16_t* ys = F.slot(8); const unsigned* route = F.route();
    for (int o = F.bid * 8 + F.wave; o < NB * SEQ; o += G * 8) {
        const int b = o / SEQ, s = o - b * SEQ, r = b * TT + CTX + s;
        const unsigned* rt = route + (size_t)r * 8;
        const float w0 = __uint_as_float(rt[2]), w1 = __uint_as_float(rt[3]); const int p0 = (int)rt[4], p1 = (int)rt[5];
        const float* m5 = F.mod(1, b) + 5 * 1024;
#pragma unroll
        for (int i = 0; i < 4; ++i) { const int c = F.lane * 4 + 256 * i;
            f32x4 x = *(const f32x4*)(xs + (size_t)r * 1024 + c);
            const u32x2 a = *(const u32x2*)(ys + (size_t)p0 * 1024 + c), bq = *(const u32x2*)(ys + (size_t)p1 * 1024 + c); const f32x4 g = *(const f32x4*)(m5 + c);
            x[0] += g[0] * (w0 * __uint_as_float(a.x << 16) + w1 * __uint_as_float(bq.x << 16));
            x[1] += g[1] * (w0 * __uint_as_float(a.x & 0xffff0000u) + w1 * __uint_as_float(bq.x & 0xffff0000u));
            x[2] += g[2] * (w0 * __uint_as_float(a.y << 16) + w1 * __uint_as_float(bq.y << 16));
            x[3] += g[3] * (w0 * __uint_as_float(a.y & 0xffff0000u) + w1 * __uint_as_float(bq.y & 0xffff0000u));
            *(f32x4*)(F.out + (size_t)o * 1024 + c) = x; }
    }
}
DI float row16_sum(float v) {
#pragma unroll
    for (int o = 8; o >= 1; o >>= 1) v += __shfl_xor(v, o);
    return v;
}
DI void rope_table(const Frame& F, LAS unsigned char* lds) {
    LAS float* rt = (LAS float*)(lds + 69632);
    __syncthreads();
    for (int i = F.tid; i < 1024; i += NT) { const int id = i >> 4, fi = i & 15; const float inv_freq = exp2f(-(float)fi * (13.287712379549449f / 16.f));
        float sn, cs; sincosf((float)id * inv_freq, &sn, &cs); rt[i * 2] = cs; rt[i * 2 + 1] = sn; }
    __syncthreads();
}
DI void attn_prep_item(const Frame& F, int L, int b, int tt, LAS unsigned char* lds) {
    const int t0 = tt * 64;
    const bf16_t* Pq = F.slot(4); const bf16_t* Pk = F.slot(5); const bf16_t* Pv = F.slot(6);
    bf16_t* Qn = F.slot(9); bf16_t* Kn = F.slot(10); bf16_t* Vt = F.slot(11);
    const LAS float* rt = (const LAS float*)(lds + 69632);
    {
        const int li = F.tid & 15, grp = F.tid >> 4, d0 = 4 * li;
        const f32x4 gq = *(const f32x4*)(F.inp(13) + L * 64 + d0), gk = *(const f32x4*)(F.inp(14) + L * 64 + d0);
        for (int v0 = grp; v0 < 1024; v0 += 256) {
            u32x2 raws[8];
#pragma unroll
            for (int u = 0; u < 8; ++u) { const int v = v0 + 32 * u, tok = v >> 4, rest = v & 15, qk = rest >> 3, hd = (rest >> 1) & 3, c = rest & 1;
                raws[u] = *(const u32x2*)((qk ? Pk : Pq) + ((size_t)b * TT + t0 + tok) * 512 + hd * 128 + c * 64 + d0); }
#pragma unroll
            for (int u = 0; u < 8; ++u) {
            const int v = v0 + 32 * u;
            const int tok = v >> 4, rest = v & 15, qk = rest >> 3, hd = (rest >> 1) & 3, c = rest & 1;
            const int t = t0 + tok;
            const u32x2 raw = raws[u];
            float x[4] = {__uint_as_float(raw.x << 16), __uint_as_float(raw.x & 0xffff0000u), __uint_as_float(raw.y << 16), __uint_as_float(raw.y & 0xffff0000u)};
            const float ss = row16_sum_dpp(x[0] * x[0] + x[1] * x[1] + x[2] * x[2] + x[3] * x[3]);
            const float rs = rsqrtf(ss * (1.f / 64.f) + EPS);
            const f32x4 g = qk ? gk : gq;
#pragma unroll
            for (int e = 0; e < 4; ++e) x[e] *= rs * g[e];
            if (t >= CTX) {
                const int pos = t - CTX, id = (li & 8) ? (pos & 63) : (pos >> 6), fi0 = 4 * (li & 3);
                const bool lowhalf = (li & 4) == 0;
#pragma unroll
                for (int e = 0; e < 4; ++e) { const float other = __shfl_xor(x[e], 4); const float cs = rt[(id * 16 + fi0 + e) * 2], sn = rt[(id * 16 + fi0 + e) * 2 + 1];
                    x[e] = lowhalf ? x[e] * cs - other * sn : x[e] * cs + other * sn; }
            }
            if (!qk) {
#pragma unroll
                for (int e = 0; e < 4; ++e) x[e] *= 0.125f * 1.4426950408889634f;
            }
            u32x2 w; w.x = pack2(x[0], x[1]); w.y = pack2(x[2], x[3]);
            *(u32x2*)((qk ? Kn : Qn) + ((size_t)((b * 4 + hd) * 2 + c) * TT + t) * 64 + d0) = w;
            }
        }
    }
    LAS bf16_t* tl = (LAS bf16_t*)lds;
    __syncthreads();
    for (int ch = F.tid; ch < 4096; ch += NT) { const int tok = ch >> 6, c8 = (ch & 63) * 8;
        *(LAS u32x4*)(tl + tok * 520 + c8) = *(const u32x4*)(Pv + ((size_t)b * TT + t0 + tok) * 512 + c8); }
    __syncthreads();
    { const int col = F.tid; bf16_t* dst = Vt + ((size_t)b * 512 + col) * TT + t0;
#pragma unroll
      for (int g = 0; g < 8; ++g) { unsigned w[4];
#pragma unroll
          for (int q = 0; q < 4; ++q) w[q] = (unsigned)tl[(g * 8 + 2 * q) * 520 + col] | ((unsigned)tl[(g * 8 + 2 * q + 1) * 520 + col] << 16);
          u32x4 v; v.x = w[0]; v.y = w[1]; v.z = w[2]; v.w = w[3];
          *(u32x4*)(dst + g * 8) = v; } }
    __syncthreads();
}

constexpr int XC_PITCH = 520;
DI void lru_chunk(const Frame& F, int L, int b, int c32, int mode, LAS unsigned char* lds) {
    LAS bf16_t* xcl = (LAS bf16_t*)lds;
    const int t0 = c32 * 32, seg_lo = t0 < CTX ? 0 : CTX, seg_hi = t0 < CTX ? CTX : TT;
    const bf16_t* Px = F.slot(7); const bf16_t* Py = F.slot(8); bf16_t* Yc = F.slot(6);
    float* lrs = (float*)(F.ws + WS_LRS);
    const bf16_t* wgt = (const bf16_t*)(F.ws + WS_WGT) + (size_t)L * 131072;
    LAS bf16_t* rawl = (LAS bf16_t*)(lds + 34816);
    __syncthreads();
    { u32x4 pre[5];
#pragma unroll
      for (int j = 0; j < 5; ++j) { int id = F.tid + j * NT; id = id < 35 * 64 ? id : 35 * 64 - 1; const int row = id >> 6, c8 = (id & 63) * 8; int t = t0 - 2 + row; t = t < seg_lo ? seg_lo : (t >= seg_hi ? seg_hi - 1 : t);
          pre[j] = *(const u32x4*)(Px + ((size_t)b * TT + t) * 512 + c8); }
#pragma unroll
      for (int j = 0; j < 5; ++j) { const int id = F.tid + j * NT; if (id < 35 * 64) { const int row = id >> 6, c8 = (id & 63) * 8, t = t0 - 2 + row;
          const bool in = t >= seg_lo && t < seg_hi; u32x4 v = pre[j]; v.x = in ? v.x : 0u; v.y = in ? v.y : 0u; v.z = in ? v.z : 0u; v.w = in ? v.w : 0u;
          *(LAS u32x4*)(rawl + row * XC_PITCH + c8) = v; } } }
    __syncthreads();
    { const int ch = F.tid;
      const float w0 = F.inp(17)[(L * 4 + 0) * 512 + ch], w1 = F.inp(17)[(L * 4 + 1) * 512 + ch], w2 = F.inp(17)[(L * 4 + 2) * 512 + ch], w3 = F.inp(17)[(L * 4 + 3) * 512 + ch], cb = F.inp(18)[L * 512 + ch];
      float r0 = bf2f(rawl[0 * XC_PITCH + ch]), r1 = bf2f(rawl[1 * XC_PITCH + ch]), r2 = bf2f(rawl[2 * XC_PITCH + ch]);
#pragma unroll 8
      for (int tok = 0; tok < 32; ++tok) { const float r3 = bf2f(rawl[(tok + 3) * XC_PITCH + ch]);
          xcl[tok * XC_PITCH + ch] = f2bf(w0 * r0 + w1 * r1 + w2 * r2 + w3 * r3 + cb); r0 = r1; r1 = r2; r2 = r3; } }
    __syncthreads();
    const int n = F.wave, l31 = F.lane & 31, hh = F.lane >> 5;
#pragma unroll 1
    for (int nt = 0; nt < 2; ++nt) {
        const int ch = n * 64 + 32 * nt + l31;
        float hf[16];
        float brv[2], biv[2], lmv[2], cinv[2];
        { const float* bgp = F.inp(20) + (size_t)L * 2048 + ch; const float* lmp = F.inp(21) + L * 1024 + ch;
#pragma unroll
          for (int d2 = 0; d2 < 2; ++d2) { brv[d2] = bgp[(d2 * 2 + 0) * 512]; biv[d2] = bgp[(d2 * 2 + 1) * 512]; lmv[d2] = lmp[d2 * 512];
              cinv[d2] = mode == 1 ? lrs[((size_t)((b * 2 + d2) * NLC + c32) * 512 + ch) * 2 + 1] : 0.f; } }
#pragma unroll
        for (int dir = 0; dir < 2; ++dir) {
            f32x16 aR, aI;
            { const float br = brv[dir], bi = biv[dir];
#pragma unroll
              for (int i = 0; i < 16; ++i) { aR[i] = br; aI[i] = bi; } }
#pragma unroll
            for (int s = 0; s < 4; ++s) {
                const bf16x8 A = *(const LAS bf16x8*)(xcl + l31 * XC_PITCH + n * 64 + 16 * s + 8 * hh);
                const bf16x8 Br = *(const bf16x8*)(wgt + ((size_t)(((dir * 2 + 0) * 8 + n) * 64 + 32 * nt + l31)) * 64 + 16 * s + 8 * hh);
                const bf16x8 Bi = *(const bf16x8*)(wgt + ((size_t)(((dir * 2 + 1) * 8 + n) * 64 + 32 * nt + l31)) * 64 + 16 * s + 8 * hh);
                aR = MFMA32(A, Br, aR); aI = MFMA32(A, Bi, aI);
            }
            const float sp = softplus_f(-lmv[dir]);
#pragma unroll
            for (int i = 0; i < 16; ++i) { const int tok = 8 * (i >> 2) + 4 * hh + (i & 3);
                const float la = -8.f * sigmoid_f(aR[i]) * sp;
                const float bb = __builtin_amdgcn_sqrtf(fmaxf(neg_expm1_f(2.f * la), 0.f)) * sigmoid_f(aI[i]) * bf2f(xcl[tok * XC_PITCH + ch]);
                aR[i] = __expf(la); aI[i] = bb; }
            float GA[4], GB[4], PA[4], PB[4];
#pragma unroll
            for (int g = 0; g < 4; ++g) { float A_ = 1.f, B_ = 0.f;
#pragma unroll
                for (int q = 0; q < 4; ++q) { const int e = dir ? 3 - q : q; const float a = aR[4 * g + e]; A_ *= a; B_ = a * B_ + aI[4 * g + e]; }
                GA[g] = A_; GB[g] = B_; PA[g] = __shfl_xor(A_, 32); PB[g] = __shfl_xor(B_, 32); }
            float h = 0.f;
            if (mode == 1) h = cinv[dir];
            float hs[4] = {0.f, 0.f, 0.f, 0.f}, ap = 1.f;
#pragma unroll
            for (int q = 0; q < 8; ++q) { const int qi = dir ? 7 - q : q, g = qi >> 1, hp = qi & 1;
                const bool mine = (hp == hh);
                const float A_ = mine ? GA[g] : PA[g], B_ = mine ? GB[g] : PB[g];
                hs[g] = mine ? h : hs[g];
                h = A_ * h + B_; ap *= A_; }
            if (mode == 0) { if (hh == 0) { float* s = lrs + ((size_t)((b * 2 + dir) * NLC + c32) * 512 + ch) * 2; s[0] = ap; s[1] = h; } }
            else {
                bf16_t yv[16];
                if (dir == 1) {
#pragma unroll
                    for (int i = 0; i < 16; ++i) { const int tok = 8 * (i >> 2) + 4 * hh + (i & 3); yv[i] = Py[((size_t)b * TT + t0 + tok) * 512 + ch]; } }
#pragma unroll
                for (int g = 0; g < 4; ++g) { float hv = hs[g];
#pragma unroll
                    for (int q = 0; q < 4; ++q) { const int e = dir ? 3 - q : q, i = 4 * g + e; hv = aR[i] * hv + aI[i];
                        if (dir == 0) hf[i] = hv;
                        else { const int tok = 8 * g + 4 * hh + e; const size_t r = (size_t)b * TT + t0 + tok;
                            Yc[r * 512 + ch] = f2bf((hf[i] + hv) * gelu_tanh_f(bf2f(yv[i]))); } } }
            }
        }
    }
}

DI void lru_carry_item(const Frame& F, int b, int dir, unsigned* done) {
    float* s = (float*)(F.ws + WS_LRS) + ((size_t)((b * 2 + dir) * NLC) * 512 + F.tid) * 2;
    float h = 0.f;
    for (int i0 = 0; i0 < NLC; i0 += 8) { f32x2 ab[8]; int cc[8];
#pragma unroll
        for (int j = 0; j < 8; ++j) { const int i = i0 + j; cc[j] = dir == 0 ? i : (i < 8 ? 7 - i : NLC + 7 - i); ab[j] = *(const f32x2*)(s + (size_t)cc[j] * 1024); }
#pragma unroll
        for (int j = 0; j < 8; ++j) { s[(size_t)cc[j] * 1024 + 1] = h; h = ab[j][0] * h + ab[j][1]; } }
    asm volatile("s_waitcnt vmcnt(0)" ::: "memory");
    __syncthreads();
    if (F.tid == 0) { __builtin_amdgcn_fence(__ATOMIC_RELEASE, "agent"); asm volatile("s_waitcnt vmcnt(0)" ::: "memory");
        __hip_atomic_fetch_add(done, 1u, __ATOMIC_RELAXED, __HIP_MEMORY_SCOPE_AGENT); }
}
DI void lru_wait_carries(const Frame& F, unsigned* done) {
    if (F.tid == 0) { unsigned spins = 0;
        while (__hip_atomic_load(done, __ATOMIC_RELAXED, __HIP_MEMORY_SCOPE_AGENT) < 16u && ++spins < (1u << 24)) __builtin_amdgcn_s_sleep(8);
        __builtin_amdgcn_fence(__ATOMIC_ACQUIRE, "agent"); asm volatile("s_waitcnt vmcnt(0)" ::: "memory"); }
    __syncthreads();
}

constexpr int GP_PITCH = 264;
DI void gdn_prep_item(const Frame& F, int L, int b, int hd, int tt, LAS unsigned char* lds) {
    LAS float* qk = (LAS float*)lds;
    LAS bf16_t* rawl = (LAS bf16_t*)(lds + 65536);
    LAS float* sc = (LAS float*)(lds + 100912);
    LAS unsigned char* Qi = lds + 102960;
    LAS unsigned char* Ki = lds + 120368;
    LAS float* KKs = (LAS float*)(lds + 137776);
    LAS float* QKs = (LAS float*)(lds + 146224);
    const int t0 = tt * 64, seg_lo = t0 < CTX ? 0 : CTX, seg_hi = t0 < CTX ? CTX : TT;
    const bf16_t* Pq = F.slot(0); const bf16_t* Pk = F.slot(1); const bf16_t* Pv = F.slot(2);
    bf16_t* QH = (bf16_t*)(F.ws + WS_GQ); bf16_t* KH = QH + GQ_ELEMS; bf16_t* VH = KH + GQ_ELEMS;
    const float* ba = (const float*)(F.ws + WS_BA);
    const float* cw = F.inp(9) + (size_t)L * 4 * 1536;
    const size_t hrow = (size_t)(b * 4 + hd) * TT;
    { u32x4 pre[5];
#pragma unroll
      for (int j = 0; j < 5; ++j) { int id = F.tid + j * NT; id = id < 67 * 32 ? id : 67 * 32 - 1; const int row = id >> 5, c = id & 31; int t = t0 - 2 + row; t = t < seg_lo ? seg_lo : (t >= seg_hi ? seg_hi - 1 : t);
          const size_t r = (size_t)b * TT + t; pre[j] = *(const u32x4*)((c < 16 ? Pq : Pk) + r * 512 + hd * 128 + (c & 15) * 8); }
      __syncthreads();
#pragma unroll
      for (int j = 0; j < 5; ++j) { const int id = F.tid + j * NT; if (id < 67 * 32) { const int row = id >> 5, c = id & 31, t = t0 - 2 + row; const bool in = t >= seg_lo && t < seg_hi;
          u32x4 v = pre[j]; v.x = in ? v.x : 0u; v.y = in ? v.y : 0u; v.z = in ? v.z : 0u; v.w = in ? v.w : 0u; *(LAS u32x4*)(rawl + row * GP_PITCH + c * 8) = v; } } }
    __syncthreads();
    u32x4 prev[3];
#pragma unroll
    for (int j = 0; j < 3; ++j) { int id = F.tid + j * NT; id = id < 67 * 16 ? id : 67 * 16 - 1; const int row = id >> 4, c = id & 15; int t = t0 - 2 + row; t = t < seg_lo ? seg_lo : (t >= seg_hi ? seg_hi - 1 : t);
        prev[j] = *(const u32x4*)(Pv + ((size_t)b * TT + t) * 512 + hd * 128 + c * 8); }
    { const int c2 = F.tid & 255, th = F.tid >> 8, isk = c2 >> 7, dd = c2 & 127, wcn = isk * 512 + hd * 128 + dd;
      const float w0 = cw[0 * 1536 + wcn], w1 = cw[1 * 1536 + wcn], w2 = cw[2 * 1536 + wcn], w3 = cw[3 * 1536 + wcn];
      const int r0i = th * 32;
      float r0 = bf2f(rawl[(r0i + 0) * GP_PITCH + c2]), r1 = bf2f(rawl[(r0i + 1) * GP_PITCH + c2]), r2 = bf2f(rawl[(r0i + 2) * GP_PITCH + c2]);
#pragma unroll 8
      for (int i = 0; i < 32; ++i) { const float r3 = bf2f(rawl[(r0i + i + 3) * GP_PITCH + c2]);
          qk[(r0i + i) * 256 + c2] = silu_f(w0 * r0 + w1 * r1 + w2 * r2 + w3 * r3); r0 = r1; r1 = r2; r2 = r3; } }
    if (F.tid < 128) { const int tl = F.tid & 63, dir = F.tid >> 6; const size_t r = (size_t)b * TT + t0 + tl;
        const float neg_a = -__expf(F.inp(10)[(L * 2 + dir) * 4 + hd]), dtb = F.inp(11)[(L * 2 + dir) * 4 + hd];
        sc[tl * 8 + 2 + dir] = sigmoid_f(ba[r * 16 + dir * 4 + hd]);
        sc[tl * 8 + 4 + dir] = neg_a * softplus_f(ba[r * 16 + 8 + dir * 4 + hd] + dtb); }
    __syncthreads();
    { const int pair = F.tid >> 2, part = F.tid & 3, tl = pair >> 1, isk = pair & 1; float a = 0.f;
      for (int i = 0; i < 32; ++i) { const float x = qk[tl * 256 + isk * 128 + part * 32 + ((i + pair) & 31)]; a += x * x; }
      a += __shfl_xor(a, 1); a += __shfl_xor(a, 2);
      if (part == 0) sc[tl * 8 + isk] = rsqrtf(a + EPS) * (isk ? 1.f : 0.08838834764831845f); }
#pragma unroll
    for (int j = 0; j < 3; ++j) { const int id = F.tid + j * NT; if (id < 67 * 16) { const int row = id >> 4, c = id & 15, t = t0 - 2 + row; const bool in = t >= seg_lo && t < seg_hi;
        u32x4 v = prev[j]; v.x = in ? v.x : 0u; v.y = in ? v.y : 0u; v.z = in ? v.z : 0u; v.w = in ? v.w : 0u; *(LAS u32x4*)(rawl + row * GP_PITCH + c * 8) = v; } }
    __syncthreads();
    { const int c2 = F.tid & 255, th = F.tid >> 8, isk = c2 >> 7, dd = c2 & 127;
      bf16_t* dstg = (isk ? KH : QH) + (hrow + t0) * 128 + dd; LAS unsigned char* img = isk ? Ki : Qi;
#pragma unroll 8
      for (int i = 0; i < 32; ++i) { const int tl = th * 32 + i; const bf16_t v = f2bf(qk[tl * 256 + c2] * sc[tl * 8 + isk]);
          dstg[(size_t)tl * 128] = v; *(LAS bf16_t*)(img + tl * 272 + dd * 2) = v; } }
    { const int col = F.tid & 127, tq = F.tid >> 7, wcn = 1024 + hd * 128 + col;
      const float w0 = cw[0 * 1536 + wcn], w1 = cw[1 * 1536 + wcn], w2 = cw[2 * 1536 + wcn], w3 = cw[3 * 1536 + wcn];
      const int r0i = tq * 16;
      float r0 = bf2f(rawl[(r0i + 0) * GP_PITCH + col]), r1 = bf2f(rawl[(r0i + 1) * GP_PITCH + col]), r2 = bf2f(rawl[(r0i + 2) * GP_PITCH + col]);
#pragma unroll 8
      for (int i = 0; i < 16; ++i) { const float r3 = bf2f(rawl[(r0i + i + 3) * GP_PITCH + col]);
          VH[(hrow + t0 + r0i + i) * 128 + col] = f2bf(silu_f(w0 * r0 + w1 * r1 + w2 * r2 + w3 * r3)); r0 = r1; r1 = r2; r2 = r3; } }
    __syncthreads();
    const int l31 = F.lane & 31, hh = F.lane >> 5;
    if (F.wave < 4) { const int mat = F.wave >> 1, c = F.wave & 1;
        f32x16 acc;
#pragma unroll
        for (int i = 0; i < 16; ++i) acc[i] = 0.f;
#pragma unroll
        for (int s = 0; s < 8; ++s) { const bf16x8 A = *(const LAS bf16x8*)((mat ? Qi : Ki) + (32 * c + l31) * 272 + (16 * s + 8 * hh) * 2);
            const bf16x8 B = *(const LAS bf16x8*)(Ki + (32 * c + l31) * 272 + (16 * s + 8 * hh) * 2); acc = MFMA32(A, B, acc); }
        LAS float* dst = (mat ? QKs : KKs) + c * 1056;
#pragma unroll
        for (int i = 0; i < 16; ++i) dst[(8 * (i >> 2) + 4 * hh + (i & 3)) * 33 + l31] = acc[i]; }
    __syncthreads();
    if (F.wave < 4) { const int c = F.wave & 1, dir = F.wave >> 1, c32 = 2 * tt + c;
        LAS float* As = (LAS float*)lds + F.wave * 2112; LAS float* Tl = As + 1056;
        const size_t cd = ((size_t)(b * 4 + hd) * 2 + dir) * 72 + c32;
        const int p = l31, tau = dir ? 31 - p : p, tl = 32 * c + tau;
        const float bet = sc[tl * 8 + 2 + dir]; float G = sc[tl * 8 + 4 + dir];
#pragma unroll
        for (int o = 1; o < 32; o <<= 1) { const float up = __shfl_up(G, o, 32); G += (p >= o) ? up : 0.f; }
        const float Glast = __shfl(G, 31, 32);
        if (hh == 0) { float* gs = (float*)(F.ws + WS_GSC) + (cd * 32 + p) * 4; f32x4 v; v[0] = bet; v[1] = __expf(G); v[2] = __expf(Glast - G); v[3] = 0.f; *(f32x4*)gs = v; }
        const LAS float* KKc = KKs + c * 1056; const LAS float* QKc = QKs + c * 1056;
        bf16_t* Tg = (bf16_t*)(F.ws + WS_GT) + cd * 1024; bf16_t* QKg = (bf16_t*)(F.ws + WS_GQK) + cd * 1024;
        for (int i = 0; i < 32; ++i) { const float bi = __shfl(bet, i, 32), Gi = __shfl(G, i, 32); const int ti = dir ? 31 - i : i;
            const float dec = __expf(fminf(Gi - G, 0.f));
            const float a = (i > p) ? bi * KKc[ti * 33 + tau] * dec : 0.f;
            if (hh == 0) { As[i * 33 + p] = a; QKg[i * 32 + p] = f2bf((i >= p) ? QKc[ti * 33 + tau] * dec : 0.f); } }
        for (int i = 0; i < 32; ++i) { float s = (i == p) ? 1.f : 0.f;
#pragma unroll 8
            for (int j = 0; j < i; ++j) s -= As[i * 33 + j] * Tl[j * 33 + p];
            if (hh == 0) { Tl[i * 33 + p] = s; Tg[i * 32 + p] = f2bf(s); } }
    }
    __syncthreads();
}

constexpr int GS_KI = 0, GS_QI = 8448, GS_VI = 16896, GS_KT = 25344, GS_TI = 34560, GS_QK = 36864, GS_SC = 39168, GS_BUF = 40960;
DI bf16x8 frag8(const LAS unsigned char* base, int byteoff) { const s16x4 lo = *(const LAS s16x4*)(base + byteoff), hi = *(const LAS s16x4*)(base + byteoff + 16); return __builtin_shufflevector(lo, hi, 0, 1, 2, 3, 4, 5, 6, 7); }
DI bf16x8 pack8v(const f32x16& x, int s) {
    u32x4 p; p.x = pack2(x[8 * s], x[8 * s + 1]); p.y = pack2(x[8 * s + 2], x[8 * s + 3]); p.z = pack2(x[8 * s + 4], x[8 * s + 5]); p.w = pack2(x[8 * s + 6], x[8 * s + 7]);
    return __builtin_bit_cast(bf16x8, p);
}
DI void gdn_scan_item(const Frame& F, int L, int b, int hd, int dir, LAS unsigned char* lds) {
    const bf16_t* QH = (const bf16_t*)(F.ws + WS_GQ); const bf16_t* KH = QH + GQ_ELEMS; const bf16_t* VH = KH + GQ_ELEMS;
    const bf16_t* Tg = (const bf16_t*)(F.ws + WS_GT); const bf16_t* QKg = (const bf16_t*)(F.ws + WS_GQK); const float* gsc = (const float*)(F.ws + WS_GSC);
    bf16_t* og = F.slot(12 + dir);
    const size_t hrow = (size_t)(b * 4 + hd) * TT, cdb = ((size_t)(b * 4 + hd) * 2 + dir) * 72;
    const int l31 = F.lane & 31, hh = F.lane >> 5;
    auto chunk_of = [&](int s) { return dir == 0 ? s : (s < 8 ? 7 - s : 79 - s); };
    if (F.wave >= 4) {
        const int h = F.tid - 256;
        struct HSet { u32x4 rk[2], rq[2], rv[2], rt, rs; unsigned kt[8]; };
        auto issue = [&](HSet& R, int s) { const int c32 = chunk_of(s < 72 ? s : 71); const size_t tb0 = hrow + (size_t)c32 * 32, cd = cdb + c32;
#pragma unroll
            for (int j = 0; j < 2; ++j) { const int id = h + 256 * j, r = id >> 4, c16 = id & 15; const size_t off = (tb0 + r) * 128 + c16 * 8;
                R.rk[j] = *(const u32x4*)(KH + off); R.rq[j] = *(const u32x4*)(QH + off); R.rv[j] = *(const u32x4*)(VH + off); }
            { const int id = h & 127; R.rt = *(const u32x4*)((h < 128 ? Tg : QKg) + cd * 1024 + id * 8); }
            R.rs = *(const u32x4*)(gsc + (cd * 32 + (h & 31)) * 4);
            { const bf16_t* kc = KH + (tb0 + 16 * (h >> 7)) * 128 + (h & 127);
#pragma unroll
              for (int i = 0; i < 8; ++i) R.kt[i] = (unsigned)kc[(2 * i) * 128] | ((unsigned)kc[(2 * i + 1) * 128] << 16); } };
        auto put = [&](const HSet& R, LAS unsigned char* B) {
#pragma unroll
            for (int j = 0; j < 2; ++j) { const int id = h + 256 * j, r = id >> 4, c16 = id & 15, p = dir ? 31 - r : r;
                { u32x2 a; a.x = R.rk[j].x; a.y = R.rk[j].y; u32x2 c; c.x = R.rk[j].z; c.y = R.rk[j].w; *(LAS u32x2*)(B + GS_KI + p * 264 + c16 * 16) = a; *(LAS u32x2*)(B + GS_KI + p * 264 + c16 * 16 + 8) = c; }
                { u32x2 a; a.x = R.rq[j].x; a.y = R.rq[j].y; u32x2 c; c.x = R.rq[j].z; c.y = R.rq[j].w; *(LAS u32x2*)(B + GS_QI + p * 264 + c16 * 16) = a; *(LAS u32x2*)(B + GS_QI + p * 264 + c16 * 16 + 8) = c; }
                { u32x2 a; a.x = R.rv[j].x; a.y = R.rv[j].y; u32x2 c; c.x = R.rv[j].z; c.y = R.rv[j].w; *(LAS u32x2*)(B + GS_VI + p * 264 + c16 * 16) = a; *(LAS u32x2*)(B + GS_VI + p * 264 + c16 * 16 + 8) = c; }
            }
            {
              const int d = h & 127, rh = h >> 7; unsigned w[8];
#pragma unroll
              for (int i = 0; i < 8; ++i) { const unsigned x = R.kt[dir ? 7 - i : i]; w[i] = dir ? ((x >> 16) | (x << 16)) : x; }
              LAS unsigned char* dst = B + GS_KT + d * 72 + (dir ? 16 * (1 - rh) : 16 * rh) * 2;
#pragma unroll
              for (int i = 0; i < 4; ++i) { u32x2 v; v.x = w[2 * i]; v.y = w[2 * i + 1]; *(LAS u32x2*)(dst + 8 * i) = v; } }
            { const int id = h & 127, i = id >> 2, c = id & 3; LAS unsigned char* dst = B + (h < 128 ? GS_TI : GS_QK) + i * 72 + c * 16;
              u32x2 a; a.x = R.rt.x; a.y = R.rt.y; u32x2 c2; c2.x = R.rt.z; c2.y = R.rt.w; *(LAS u32x2*)dst = a; *(LAS u32x2*)(dst + 8) = c2; }
            if (h < 32) *(LAS u32x4*)(B + GS_SC + h * 16) = R.rs; };
        HSet R0, R1, R2;
        __syncthreads();
        issue(R0, 0); put(R0, lds); issue(R1, 1); issue(R2, 2); issue(R0, 3);
        __syncthreads();
#define GS_BAR() do { asm volatile("s_waitcnt lgkmcnt(0)" ::: "memory"); __builtin_amdgcn_s_barrier(); asm volatile("" ::: "memory"); } while (0)
        for (int s = 0; s < 72; s += 3) {
            put(R1, lds + ((s + 1) & 1) * GS_BUF); issue(R1, s + 4);
            GS_BAR();
            put(R2, lds + ((s + 2) & 1) * GS_BUF); issue(R2, s + 5);
            GS_BAR();
            if (s + 3 < 72) put(R0, lds + ((s + 3) & 1) * GS_BUF); issue(R0, s + 6);
            GS_BAR();
        }
        asm volatile("s_waitcnt vmcnt(0)" ::: "memory");
    } else {
        const int eq = F.wave;
        f32x16 S[4];
#pragma unroll
        for (int m = 0; m < 4; ++m)
#pragma unroll
            for (int i = 0; i < 16; ++i) S[m][i] = 0.f;
        __syncthreads();
        __syncthreads();
#pragma unroll 1
        for (int s = 0; s < 72; ++s) {
            int ln_ = F.lane; asm volatile("" : "+v"(ln_));
            const int l31 = ln_ & 31, hh = ln_ >> 5;
            const LAS unsigned char* B = lds + (s & 1) * GS_BUF;
            const int c32 = chunk_of(s);
            f32x16 ks, oq;
#pragma unroll
            for (int i = 0; i < 16; ++i) { ks[i] = 0.f; oq[i] = 0.f; }
#pragma unroll
            for (int m = 0; m < 4; ++m)
#pragma unroll
                for (int t = 0; t < 2; ++t) { const bf16x8 Sp = pack8v(S[m], t);
                    ks = MFMA32(frag8(B + GS_KI, l31 * 264 + (32 * m + 16 * t + 4 * hh) * 2), Sp, ks);
                    oq = MFMA32(frag8(B + GS_QI, l31 * 264 + (32 * m + 16 * t + 4 * hh) * 2), Sp, oq); }
            f32x16 X;
#pragma unroll
            for (int i = 0; i < 16; ++i) { const int pos = 8 * (i >> 2) + 4 * hh + (i & 3); const f32x4 s4 = *(const LAS f32x4*)(B + GS_SC + pos * 16);
                const float v = bf2f(*(const LAS bf16_t*)(B + GS_VI + pos * 264 + (32 * eq + l31) * 2));
                X[i] = s4[0] * (v - s4[1] * ks[i]); oq[i] *= s4[1]; }
            f32x16 vn;
#pragma unroll
            for (int i = 0; i < 16; ++i) vn[i] = 0.f;
#pragma unroll
            for (int t = 0; t < 2; ++t) vn = MFMA32(frag8(B + GS_TI, l31 * 72 + (16 * t + 4 * hh) * 2), pack8v(X, t), vn);
            { const bf16x8 vp0 = pack8v(vn, 0), vp1 = pack8v(vn, 1);
              oq = MFMA32(frag8(B + GS_QK, l31 * 72 + (4 * hh) * 2), vp0, oq); oq = MFMA32(frag8(B + GS_QK, l31 * 72 + (16 + 4 * hh) * 2), vp1, oq); }
            { bf16_t* dst = og + ((size_t)b * TT + (size_t)c32 * 32) * 512 + hd * 128 + 32 * eq + l31;
#pragma unroll
              for (int i = 0; i < 16; ++i) { const int pos = 8 * (i >> 2) + 4 * hh + (i & 3), tk = dir ? 31 - pos : pos; dst[(size_t)tk * 512] = f2bf(oq[i]); } }
            const float gl = (*(const LAS f32x4*)(B + GS_SC + 31 * 16))[1];
#pragma unroll
            for (int i = 0; i < 16; ++i) { const int pos = 8 * (i >> 2) + 4 * hh + (i & 3); vn[i] *= (*(const LAS f32x4*)(B + GS_SC + pos * 16))[2]; }
            const bf16x8 wp0 = pack8v(vn, 0), wp1 = pack8v(vn, 1);
#pragma unroll
            for (int m = 0; m < 4; ++m) {
#pragma unroll
                for (int i = 0; i < 16; ++i) S[m][i] *= gl;
                S[m] = MFMA32(frag8(B + GS_KT, (32 * m + l31) * 72 + (4 * hh) * 2), wp0, S[m]);
                S[m] = MFMA32(frag8(B + GS_KT, (32 * m + l31) * 72 + (16 + 4 * hh) * 2), wp1, S[m]); }
            GS_BAR();
        }
    }
#undef GS_BAR
}

DI void gdn_post(const Frame& F, int L) {
    const int G = F.G; const bf16_t* of = F.slot(12); const bf16_t* obk = F.slot(13); const bf16_t* Pz = F.slot(3); bf16_t* Ya = F.slot(4);
    const float* gain = F.inp(12) + L * 128;
    for (int r = F.bid * 8 + F.wave; r < MROWS; r += G * 8) {
        const size_t off = (size_t)r * 512 + F.lane * 8;
        const u32x4 a = *(const u32x4*)(of + off), c = *(const u32x4*)(obk + off), z = *(const u32x4*)(Pz + off);
        const unsigned aa[4] = {a.x, a.y, a.z, a.w}, cc[4] = {c.x, c.y, c.z, c.w}, zz[4] = {z.x, z.y, z.z, z.w};
        float o[8]; float ss = 0.f;
#pragma unroll
        for (int q = 0; q < 4; ++q) { o[2 * q] = __uint_as_float(aa[q] << 16) + __uint_as_float(cc[q] << 16); o[2 * q + 1] = __uint_as_float(aa[q] & 0xffff0000u) + __uint_as_float(cc[q] & 0xffff0000u);
            ss += o[2 * q] * o[2 * q] + o[2 * q + 1] * o[2 * q + 1]; }
        ss = row16_sum_dpp(ss);
        const float rstd = rsqrtf(ss * (1.f / 128.f) + EPS);
        const int e0 = (F.lane & 15) * 8;
        float y[8];
#pragma unroll
        for (int q = 0; q < 4; ++q) { y[2 * q] = o[2 * q] * rstd * gain[e0 + 2 * q] * silu_f(__uint_as_float(zz[q] << 16)); y[2 * q + 1] = o[2 * q + 1] * rstd * gain[e0 + 2 * q + 1] * silu_f(__uint_as_float(zz[q] & 0xffff0000u)); }
        u32x4 w; w.x = pack2(y[0], y[1]); w.y = pack2(y[2], y[3]); w.z = pack2(y[4], y[5]); w.w = pack2(y[6], y[7]);
        *(u32x4*)(Ya + off) = w;
    }
}
DI bf16x8 pack8(const f32x16& x, int s) {
    u32x4 p; p.x = pack2(x[8 * s], x[8 * s + 1]); p.y = pack2(x[8 * s + 2], x[8 * s + 3]); p.z = pack2(x[8 * s + 4], x[8 * s + 5]); p.w = pack2(x[8 * s + 6], x[8 * s + 7]);
    return __builtin_bit_cast(bf16x8, p);
}
constexpr int AK_PITCH = 272, AV_PITCH = 136, AK_BYTES = 64 * AK_PITCH, AV_BYTES = 128 * AV_PITCH;

DI void attn_item(const Frame& F, int L, int b, int hd, int q128, float lam, float lam_init, float bound2, LAS unsigned char* lds) {
    const bf16_t* Qn = F.slot(9); const bf16_t* Kn = F.slot(10); const bf16_t* Vt = F.slot(11); bf16_t* Yb = F.slot(5);
    const int qbase = q128 < 16 ? CTX + q128 * 128 : (q128 - 16) * 128, nit = q128 < 16 ? 18 : 2;
    int tid_ = F.tid; asm volatile("" : "+v"(tid_));
    const int lane_ = tid_ & 63, l31 = lane_ & 31, hh = lane_ >> 5;
    const int qg = F.wave & 3, half = F.wave >> 2;
    const int tq = qbase + 32 * qg + l31;
    LAS unsigned char* Kl = lds + half * 2 * AK_BYTES; LAS unsigned char* Vl = Kl + AK_BYTES;
    LAS unsigned char* Ql = lds + 4 * AK_BYTES + qg * 8192 + lane_ * 16;
    __syncthreads();
    if (half == 0) {
#pragma unroll
        for (int c = 0; c < 2; ++c)
#pragma unroll
            for (int s = 0; s < 4; ++s) *(LAS bf16x8*)(Ql + (c * 4 + s) * 1024) = *(const bf16x8*)(Qn + ((size_t)((b * 4 + hd) * 2 + c) * TT + tq) * 64 + 16 * s + 8 * hh);
    }
    f32x16 O[2][4];
#pragma unroll
    for (int c = 0; c < 2; ++c)
#pragma unroll
        for (int e = 0; e < 4; ++e)
#pragma unroll
            for (int i = 0; i < 16; ++i) O[c][e][i] = 0.f;
    float lsum[2] = {0.f, 0.f};
    const int ht = tid_ & 255;
    const bf16_t* kb = Kn + (size_t)((b * 4 + hd) * 2) * TT * 64;
    const bf16_t* vbs = Vt + (size_t)(b * 4 + hd) * 128 * TT;
    const unsigned koff = (unsigned)((ht >> 3) * 64 + (ht & 7) * 8);
    const unsigned voff = (unsigned)((ht >> 3) * TT + (ht & 7) * 8);
    u32x4 rk[4], rv[4];
    auto issue = [&](int it) { const int kt = 2 * it + half; const bf16_t* kn = kb + kt * 4096; const bf16_t* vn = vbs + kt * 64;
#pragma unroll
        for (int j = 0; j < 2; ++j) { rk[j] = *(const u32x4*)(kn + j * 2048 + koff); rk[2 + j] = *(const u32x4*)(kn + TT * 64 + j * 2048 + koff); }
#pragma unroll
        for (int j = 0; j < 4; ++j) rv[j] = *(const u32x4*)(vn + j * 32 * TT + voff); };
    issue(0);
    for (int it = 0; it < nit; ++it) {
        __syncthreads();
        { const int key = ht >> 3, ch = ht & 7;
#pragma unroll
          for (int j = 0; j < 2; ++j) { *(LAS u32x4*)(Kl + (key + 32 * j) * AK_PITCH + ch * 16) = rk[j]; *(LAS u32x4*)(Kl + (key + 32 * j) * AK_PITCH + 128 + ch * 16) = rk[2 + j]; }
#pragma unroll
          for (int j = 0; j < 4; ++j) { u32x2 a; a.x = rv[j].x; a.y = rv[j].y; u32x2 c; c.x = rv[j].z; c.y = rv[j].w;
              *(LAS u32x2*)(Vl + (key + 32 * j) * AV_PITCH + ch * 16) = a; *(LAS u32x2*)(Vl + (key + 32 * j) * AV_PITCH + ch * 16 + 8) = c; } }
        __syncthreads();
        if (it + 1 < nit) issue(it + 1);
#pragma unroll 1
        for (int u = 0; u < 2; ++u) {
            bf16x8 Pf[2][2];
#pragma unroll
            for (int c = 0; c < 2; ++c) {
                f32x16 S;
#pragma unroll
                for (int i = 0; i < 16; ++i) S[i] = 0.f;
#pragma unroll
                for (int s = 0; s < 4; ++s) { const bf16x8 A = *(const LAS bf16x8*)(Kl + (32 * u + l31) * AK_PITCH + c * 128 + (16 * s + 8 * hh) * 2); const bf16x8 Bq = *(const LAS bf16x8*)(Ql + (c * 4 + s) * 1024); S = MFMA32(A, Bq, S); }
#pragma unroll
                for (int i = 0; i < 16; ++i) { S[i] = __builtin_amdgcn_exp2f(S[i] - bound2); lsum[c] += S[i]; }
                Pf[c][0] = pack8(S, 0); Pf[c][1] = pack8(S, 1);
            }
#pragma unroll
            for (int s = 0; s < 2; ++s) {
                __builtin_amdgcn_sched_barrier(0);
#pragma unroll
                for (int e = 0; e < 4; ++e) {
                    const LAS unsigned char* vb = Vl + (32 * e + l31) * AV_PITCH + (32 * u + 16 * s + 4 * hh) * 2;
                    const s16x4 lo = *(const LAS s16x4*)vb, hi = *(const LAS s16x4*)(vb + 16);
                    const bf16x8 A = __builtin_shufflevector(lo, hi, 0, 1, 2, 3, 4, 5, 6, 7);
                    O[0][e] = MFMA32(A, Pf[0][s], O[0][e]); O[1][e] = MFMA32(A, Pf[1][s], O[1][e]);
                }
            }
            __builtin_amdgcn_sched_barrier(0);
        }
    }
    LAS float* lex = (LAS float*)(lds + 4 * AK_BYTES + 32768);
    LAS float* ox = (LAS float*)lds;
    const float l0p = lsum[0] + __shfl_xor(lsum[0], 32), l1p = lsum[1] + __shfl_xor(lsum[1], 32);
    __syncthreads();
    if (hh == 0) { lex[((half * 4 + qg) * 2 + 0) * 32 + l31] = l0p; lex[((half * 4 + qg) * 2 + 1) * 32 + l31] = l1p; }
    __syncthreads();
    const float l0 = l0p + lex[(((half ^ 1) * 4 + qg) * 2 + 0) * 32 + l31], l1 = l1p + lex[(((half ^ 1) * 4 + qg) * 2 + 1) * 32 + l31];
    const float i0 = 1.f / l0, i1 = lam / l1;
#pragma unroll
    for (int e = 0; e < 4; ++e)
#pragma unroll
        for (int i = 0; i < 16; ++i) O[0][e][i] = O[0][e][i] * i0 - O[1][e][i] * i1;
    if (half == 1) {
#pragma unroll
        for (int e = 0; e < 4; ++e)
#pragma unroll
            for (int i = 0; i < 16; ++i) ox[(qg * 64 + e * 16 + i) * 64 + lane_] = O[0][e][i];
    }
    __syncthreads();
    if (half == 0) {
        float ss = 0.f;
#pragma unroll
        for (int e = 0; e < 4; ++e)
#pragma unroll
            for (int i = 0; i < 16; ++i) { const float o = O[0][e][i] + ox[(qg * 64 + e * 16 + i) * 64 + lane_]; O[0][e][i] = o; ss += o * o; }
        ss += __shfl_xor(ss, 32);
        const float rstd = rsqrtf(ss * (1.f / 128.f) + EPS) * (1.f - lam_init);
        const float* og = F.inp(16) + L * 128;
        bf16_t* dst = Yb + ((size_t)b * TT + tq) * 512 + hd * 128;
#pragma unroll
        for (int e = 0; e < 4; ++e)
#pragma unroll
            for (int g = 0; g < 4; ++g) { const int e0 = 32 * e + 8 * g + 4 * hh; const f32x4 gv = *(const f32x4*)(og + e0);
                u32x2 w; w.x = pack2(O[0][e][4 * g] * rstd * gv[0], O[0][e][4 * g + 1] * rstd * gv[1]); w.y = pack2(O[0][e][4 * g + 2] * rstd * gv[2], O[0][e][4 * g + 3] * rstd * gv[3]);
                *(u32x2*)(dst + e0) = w; }
    }
}

__global__ void __launch_bounds__(NT) mk_fwd(Params p) {
    extern __shared__ __attribute__((aligned(16))) unsigned char lds_raw[];
    LAS unsigned char* lds = (LAS unsigned char*)lds_raw;
    cg::grid_group grid = cg::this_grid();
    LAS int* tb = (LAS int*)(lds + LDS_MISC);
    LAS unsigned long long* itab = (LAS unsigned long long*)(lds + LDS_MISC + 256);
    LAS unsigned* scal = (LAS unsigned*)(lds + LDS_MISC + 512);
    volatile LAS unsigned* xbst = (volatile LAS unsigned*)(lds + LDS_MISC + 640);
    if (threadIdx.x < 4) xbst[threadIdx.x] = 0u;
    if (threadIdx.x < 28) itab[threadIdx.x] = (unsigned long long)p.in[threadIdx.x];
    if (threadIdx.x == 0) { const unsigned long long w = (unsigned long long)p.ws, o = (unsigned long long)p.out;
        scal[0] = (unsigned)w; scal[1] = (unsigned)(w >> 32); scal[2] = (unsigned)o; scal[3] = (unsigned)(o >> 32); scal[4] = gridDim.x; scal[5] = blockIdx.x; }
    __syncthreads();
    XcdBarrier xbar = xcd_barrier_post((unsigned*)(__attribute__((address_space(1))) unsigned*)(p.ws + WS_CTL + 4096), xbst);
#ifndef PROBE_TSET
#define PROBE_TSET 0
#endif
    unsigned long long t_acc = 0ull;
    for (int ph = p.ph_lo; ph < p.ph_hi; ++ph) {
        const unsigned long long t_ph0 = PROBE_TSET ? __builtin_amdgcn_s_memrealtime() : 0ull;
        int tid_ = threadIdx.x; asm volatile("" : "+v"(tid_));
        const unsigned w0 = __builtin_amdgcn_readfirstlane(scal[0]), w1 = __builtin_amdgcn_readfirstlane(scal[1]), o0 = __builtin_amdgcn_readfirstlane(scal[2]), o1 = __builtin_amdgcn_readfirstlane(scal[3]);
        unsigned char* ws_ = (unsigned char*)(__attribute__((address_space(1))) unsigned char*)(((unsigned long long)w1 << 32) | w0); float* out_ = (float*)(__attribute__((address_space(1))) float*)(((unsigned long long)o1 << 32) | o0);
        const int G = __builtin_amdgcn_readfirstlane(scal[4]), bid = __builtin_amdgcn_readfirstlane(scal[5]);
        Frame F; F.itab = itab; F.out = out_; F.ws = ws_; F.tid = tid_; F.lane = tid_ & 63; F.wave = __builtin_amdgcn_readfirstlane(tid_ >> 6); F.G = G; F.bid = bid;
        if (ph == 0) { phase0(F, lds); convert_weights(F, 0, lds); }
        else if (ph == 23) final_phase(F);
        else {
            int L = (ph - 1) / 11; const int k = (ph - 1) % 11;
            if (tid_ == 0) scal[6] = (unsigned)L;
            bf16_t* wb = F.wb(L);
            const bool dry = (p.sub & 8) != 0;
            if (k == 0) { norm_phase(F, L, 1, lds, dry); if (L == 1 && !(p.sub & 16)) convert_weights(F, 1, lds); }
            else if (k == 1) {
                pg8::Gemm g{F.h(), wb + W_IN, 1024}; pg8::StaticOrder S{72, 19, G, bid, 0};
                pg8::EpiSlots E{F.slot(0), {0, 1, 2, 3, 4, 5, 6, 7, 8}, (float*)(F.ws + WS_BA), false};
                pg8::gemm_phase(lds, g, S, E, F.tid);
            } else if (k == 2) {
                const int sub = p.sub;
                for (;;) {
                    LAS int* slot = (LAS int*)(lds + LDS_MISC + 192);
                    __syncthreads(); if (F.tid == 0) *slot = (int)atomicAdd(F.ctl() + 64 + ph + (p.sub & 32), 1u); __syncthreads();
                    const int it = __builtin_amdgcn_readfirstlane(*slot);
                    if (it >= 2016) break;
                    { int t_ = threadIdx.x; asm volatile("" : "+v"(t_)); F.tid = t_; F.lane = t_ & 63; F.wave = __builtin_amdgcn_readfirstlane(t_ >> 6);
                      const unsigned a0 = __builtin_amdgcn_readfirstlane(scal[0]), a1 = __builtin_amdgcn_readfirstlane(scal[1]); F.ws = (unsigned char*)(__attribute__((address_space(1))) unsigned char*)(((unsigned long long)a1 << 32) | a0);
                      L = __builtin_amdgcn_readfirstlane(scal[6]); }
                    if (it < 1152) { if (sub & 1) { const int rem = it % 144; gdn_prep_item(F, L, it / 144, rem / 36, rem % 36, lds); } }
                    else if (it < 1440) { if (sub & 2) { const int i2 = it - 1152; rope_table(F, lds); attn_prep_item(F, L, i2 / 36, i2 % 36, lds); } }
                    else if (sub & 4) { const int i2 = it - 1440; lru_chunk(F, L, i2 / NLC, i2 % NLC, 0, lds); }
                }
            } else if (k == 3) {
                const int sub = p.sub;
                LAS float* lamv = (LAS float*)(lds + LDS_MISC + 208);
                if (F.tid == 0) { const float* lv = F.inp(15) + L * 256; float s01 = 0.f, s23 = 0.f;
                    for (int i = 0; i < 64; ++i) { s01 += lv[i] * lv[64 + i]; s23 += lv[128 + i] * lv[192 + i]; }
                    const float lam_init = 0.8f - 0.6f * expf(-0.3f * (float)L);
                    float mq = 0.f, mk = 0.f;
                    for (int i = 0; i < 64; ++i) { mq = fmaxf(mq, fabsf(F.inp(13)[L * 64 + i])); mk = fmaxf(mk, fabsf(F.inp(14)[L * 64 + i])); }
                    lamv[0] = expf(s01) - expf(s23) + lam_init; lamv[1] = lam_init; lamv[2] = 8.f * mq * mk * 1.4426950408889634f; }
                for (;;) {
                    LAS int* slot = (LAS int*)(lds + LDS_MISC + 192);
                    __syncthreads(); if (F.tid == 0) *slot = (int)atomicAdd(F.ctl() + 64 + ph + (p.sub & 32), 1u); __syncthreads();
                    const int it = __builtin_amdgcn_readfirstlane(*slot);
                    const int nat = L == 0 ? 576 : 512, ntot = 80 + nat + NB * NLC;
                    if (it >= ntot) break;
                    { int t_ = threadIdx.x; asm volatile("" : "+v"(t_)); F.tid = t_; F.lane = t_ & 63; F.wave = __builtin_amdgcn_readfirstlane(t_ >> 6);
                      const unsigned a0 = __builtin_amdgcn_readfirstlane(scal[0]), a1 = __builtin_amdgcn_readfirstlane(scal[1]); F.ws = (unsigned char*)(__attribute__((address_space(1))) unsigned char*)(((unsigned long long)a1 << 32) | a0);
                      L = __builtin_amdgcn_readfirstlane(scal[6]); }
                    const float lam = lamv[0], lam_init = lamv[1], bound2 = lamv[2];
                    unsigned* done = F.ctl() + 128 + L + ((p.sub & 32) >> 4);
                    if (it < 64) { if (sub & 1) gdn_scan_item(F, L, it >> 3, (it >> 1) & 3, it & 1, lds); }
                    else if (it < 80) { if (sub & 4) { const int i2 = it - 64; lru_carry_item(F, i2 >> 1, i2 & 1, done); } }
                    else if (it < 80 + nat) { if (sub & 2) { const int i2 = it - 80;
                        if (i2 < 512) attn_item(F, L, i2 >> 6, (i2 >> 4) & 3, i2 & 15, lam, lam_init, bound2, lds);
                        else { const int i3 = i2 - 512; attn_item(F, L, i3 >> 3, (i3 >> 1) & 3, 16 + (i3 & 1), lam, lam_init, bound2, lds); } } }
                    else if (sub & 4) { const int i2 = it - 80 - nat;
                        if (!(L == 1 && i2 % NLC < 8)) { lru_wait_carries(F, done); lru_chunk(F, L, i2 / NLC, i2 % NLC, 1, lds); } }
                }
            } else if (k == 4) {
                gdn_post(F, L);
                pg8::Gemm g{F.h(), wb + W_IN + (size_t)4864 * 1024, 1024}; pg8::StaticOrder S{72, 12, G, bid, L == 1};
                pg8::EpiSlots E{F.slot(0), {0, 1, 2, 9, 10, 11, 0, 0, 0}, nullptr, true};
                pg8::gemm_phase(lds, g, S, E, F.tid);
            } else if (k == 5) {
                pg8::Gemm g{F.slot(4), wb + W_BR, 512}; pg8::MergeOrder S{G, bid, L == 1};
                pg8::EpiMerge E{F.h(), F.slot(0)};
                pg8::gemm_phase(lds, g, S, E, F.tid);
            } else if (k == 6) {
                pg8::Gemm g{F.h(), wb + W_OUT, 1024}; pg8::StaticOrder S{72, 4, G, bid, L == 1};
                pg8::EpiResid E{F.xs(), F.mod(L, 0), dry};
                pg8::gemm_phase(lds, g, S, E, F.tid);
            } else if (k == 7) norm_phase(F, L, 2, lds, dry);
            else if (k == 8) sort_phase(F, L, tb);
            else if (k == 9) {
                moe_tile_bases(F, L, tb);
                pg8::Gemm g{F.slot(0), wb + W_GU, 1024}; pg8::MoeOrder S{tb, G, bid};
                pg8::EpiMoe1 E{F.slot(5)};
                pg8::gemm_phase(lds, g, S, E, F.tid);
            } else {
                moe_tile_bases(F, L, tb);
                pg8::Gemm g{F.slot(5), wb + W_DN, 512}; pg8::MoeOrder S{tb, G, bid};
                pg8::EpiMoe2 E{F.slot(8), dry};
                pg8::gemm_phase(lds, g, S, E, F.tid);
            }
        }
        if (ph + 1 < p.ph_hi) { if (ph == 0) grid.sync(); else xcd_barrier(xbar); }
        if (PROBE_TSET) { const int kk = ph == 0 ? 11 : (ph == 23 ? 12 : (ph - 1) % 11); if ((PROBE_TSET >> kk) & 1) t_acc += __builtin_amdgcn_s_memrealtime() - t_ph0; }
    }
    if (PROBE_TSET && blockIdx.x == 0 && threadIdx.x == 0) { const unsigned long long t0 = __builtin_amdgcn_s_memrealtime(); while (__builtin_amdgcn_s_memrealtime() - t0 < 4ull * t_acc) __builtin_amdgcn_s_sleep(32); }
}

extern "C" void kernel_launch(void* const* d_in, const int* in_sizes, int n_in, void* d_out, int out_size, void* d_ws, size_t ws_size, hipStream_t stream) {
    static int grid = 0;
    if (grid == 0) {
        if (n_in != 28 || out_size != NB * SEQ * DM || ws_size < WS_END) { fprintf(stderr, "kernel_launch: unexpected shapes (n_in %d out %d ws %zu need %zu)\n", n_in, out_size, ws_size, (size_t)WS_END); grid = -1; return; }
        int dev = 0, cus = 0, per_cu = 0;
        hipGetDevice(&dev); hipDeviceGetAttribute(&cus, hipDeviceAttributeMultiprocessorCount, dev);
        hipFuncSetAttribute((const void*)mk_fwd, hipFuncAttributeMaxDynamicSharedMemorySize, LDS_BYTES);
        hipOccupancyMaxActiveBlocksPerMultiprocessor(&per_cu, (const void*)mk_fwd, NT, LDS_BYTES);
        if (per_cu < 1) { fprintf(stderr, "kernel_launch: occupancy query says %d blocks per CU\n", per_cu); per_cu = 1; }
        grid = cus;
        (void)hipGetLastError();
    }
    if (grid < 0) return;
    hipMemsetAsync((char*)d_ws + WS_CTL, 0, ZERO_BYTES, stream);
    Params p{};
    for (int i = 0; i < 28; ++i) p.in[i] = (const float*)d_in[i];
    p.out = (float*)d_out; p.ws = (unsigned char*)d_ws;
#if defined(MK_PER_PHASE)
#ifndef MK_SUB
#define MK_SUB 7
#endif
    for (int ph = 0; ph < 24; ++ph) { p.ph_lo = ph; p.ph_hi = ph + 1;
        int nrep = (ph >= 1 && ph < 23 && ((MK_PER_PHASE >> ((ph - 1) % 11)) & 2)) ? 2 : 1;
        if (ph == 0 && (MK_PER_PHASE & (1 << 13))) nrep = 2; if (ph == 23 && (MK_PER_PHASE & (1 << 14))) nrep = 2; if (ph == 1 && (MK_PER_PHASE & (1 << 15))) nrep = 2;
        for (int rep = 0; rep < nrep; ++rep) { p.sub = rep == 0 ? 7 : (MK_SUB | 32); hipLaunchKernelGGL(mk_fwd, dim3(grid), dim3(NT), LDS_BYTES, stream, p); } }
#else
    p.ph_lo = 0; p.ph_hi = 24; p.sub = 7;
    void* args[] = {&p};
    hipError_t e = hipLaunchCooperativeKernel((const void*)mk_fwd, dim3(grid), dim3(NT), args, LDS_BYTES, stream);
    if (e != hipSuccess) fprintf(stderr, "cooperative launch failed: %s (grid %d)\n", hipGetErrorString(e), grid);
#endif
}
```
